# Optimizing an MI355X kernel written in HIP

```python
import math
import jax, jax.numpy as jnp
from jax import lax
import numpy as np

D_MODEL = 1024
BATCH = 8
SEQ = 4096
DEPTH = 4

HEAD_DIM = 64
N_HEADS_DIL = D_MODEL // 128
N_HEADS_FOX = D_MODEL // 128
BRANCH_W = N_HEADS_DIL * HEAD_DIM
D_SSM = BRANCH_W
SSM_GROUP = 16
N_SSM_GROUPS = D_SSM // SSM_GROUP
SSM_STATE = 64
DT_MIN = 1e-3
DT_MAX = 1e-1
DIL_PATTERNS = ((128, 1), (512, 4), (2048, 16))
ROPE_THETA = 500000.0
ROPE_DIM = HEAD_DIM // 4
Q_BLOCK = 128
N_MEM = 256
N_HEADS_X = 4
HEAD_DIM_X = D_MODEL // N_HEADS_X
D_FF = 2816
N_EXPERTS = 8
TOP_K = 2
D_FF_EXPERT = 1408
N_DENSE = (DEPTH + 1) // 2
N_MOE = DEPTH // 2
N_BRANCH = 3
DEEPNORM_ALPHA = (2 * DEPTH) ** 0.25
DEEPNORM_BETA = (8 * DEPTH) ** -0.25
LN_EPS = 1e-5
IN_SPLITS = (D_SSM, 3 * BRANCH_W, 3 * BRANCH_W, N_HEADS_FOX, N_BRANCH * D_MODEL)
N_IN = sum(IN_SPLITS)

kernel_name = "hybrid_s5_dilated_fox_moe_deepnorm"

F32 = jnp.float32


def layer_norm(x, g, b):
    xf = x.astype(F32)
    mu = jnp.mean(xf, axis=-1, keepdims=True)
    var = jnp.mean(jnp.square(xf - mu), axis=-1, keepdims=True)
    y = (xf - mu) * lax.rsqrt(var + LN_EPS) * g.astype(F32) + b.astype(F32)
    return y.astype(x.dtype)


def rope_tables(positions):
    inv_freq = ROPE_THETA ** (-jnp.arange(0, ROPE_DIM, 2, dtype=F32) / ROPE_DIM)
    ang = positions.astype(F32)[..., None] * inv_freq
    return jnp.cos(ang)[:, :, None, :], jnp.sin(ang)[:, :, None, :]


def partial_rotary(t, cos, sin):
    half = ROPE_DIM // 2
    t1 = t[..., :half].astype(F32)
    t2 = t[..., half:ROPE_DIM].astype(F32)
    rot = jnp.concatenate([t1 * cos - t2 * sin, t2 * cos + t1 * sin], axis=-1).astype(t.dtype)
    return jnp.concatenate([rot, t[..., ROPE_DIM:]], axis=-1)


def s5_mixer(u, lam_re, lam_im, log_dt, b_re, b_im, c_re, c_im, d_skip, w_glu):
    B_, S_, _ = u.shape
    uf = u.astype(F32).reshape(B_, S_, N_SSM_GROUPS, SSM_GROUP)
    lam = lax.complex(lam_re.astype(F32), lam_im.astype(F32))
    dt = jnp.exp(log_dt.astype(F32))[:, None]
    lam_bar = jnp.exp(lam * dt)
    b_bar = ((lam_bar - 1.0) / lam)[..., None] * lax.complex(b_re.astype(F32), b_im.astype(F32))
    bu = lax.complex(jnp.einsum('bsgc,gpc->sbgp', uf, jnp.real(b_bar)),
                     jnp.einsum('bsgc,gpc->sbgp', uf, jnp.imag(b_bar)))
    a = jnp.broadcast_to(lam_bar, (S_, 1) + lam_bar.shape)

    def combine(e1, e2):
        a1, b1 = e1
        a2, b2 = e2
        return a1 * a2, a2 * b1 + b2

    _, states = lax.associative_scan(combine, (a, bu), axis=0)
    y = (jnp.einsum('sbgp,gcp->bsgc', jnp.real(states), c_re.astype(F32))
         - jnp.einsum('sbgp,gcp->bsgc', jnp.imag(states), c_im.astype(F32)))
    y = y.reshape(B_, S_, D_SSM) + d_skip.astype(F32) * u.astype(F32)
    y = jax.nn.gelu(y).astype(u.dtype)
    return y * jax.nn.sigmoid(y @ w_glu)


def dilated_band_attention(q, k, v, dil, window):
    B_, S_, H, E = q.shape
    w = window // dil
    L = S_ // dil
    nblk = -(-L // w)
    Lp = nblk * w

    def to_blocks(t):
        t = t.reshape(B_, L, dil, H, E).transpose(0, 2, 3, 1, 4)
        t = jnp.pad(t, ((0, 0), (0, 0), (0, 0), (0, Lp - L), (0, 0)))
        return t.reshape(B_, dil, H, nblk, w, E)

    def with_prev(t):
        prev = jnp.pad(t, ((0, 0), (0, 0), (0, 0), (1, 0), (0, 0), (0, 0)))[:, :, :, :-1]
        return jnp.concatenate([prev, t], axis=-2)

    qb = to_blocks(q)
    kk = with_prev(to_blocks(k))
    vv = with_prev(to_blocks(v))
    s = jnp.einsum('bdhnqe,bdhnke->bdhnqk', qb, kk, preferred_element_type=F32)
    i = jnp.arange(w)[:, None]
    j = jnp.arange(2 * w)[None, :]
    dist = i - j + w
    blk = jnp.arange(nblk)[:, None, None]
    mask = (dist >= 0) & (dist <= w) & ((blk > 0) | (j >= w))
    s = jnp.where(mask, s, -jnp.inf)
    m = jnp.max(s, axis=-1, keepdims=True)
    p = jnp.exp(s - m)
    den = jnp.sum(p, axis=-1, keepdims=True)
    o = jnp.einsum('bdhnqk,bdhnke->bdhnqe', (p / den).astype(v.dtype), vv, preferred_element_type=F32)
    lse = (m + jnp.log(den))[..., 0]

    def from_blocks(t):
        t = t.reshape((B_, dil, H, Lp) + t.shape[5:])[:, :, :, :L]
        t = jnp.moveaxis(t, 3, 1)
        return t.reshape((B_, S_, H) + t.shape[4:])

    return from_blocks(o), from_blocks(lse)


def dilated_mixture(q, k, v):
    res = [dilated_band_attention(q, k, v, dil, win) for (win, dil) in DIL_PATTERNS]
    outs = jnp.stack([r[0] for r in res], axis=0)
    lse = jnp.stack([r[1] for r in res], axis=0)
    wts = jax.nn.softmax(lse, axis=0)
    return jnp.sum(wts[..., None] * outs, axis=0)


def forgetting_attention(q, k, v, log_f):
    B_, S_, H, E = q.shape
    nblk = S_ // Q_BLOCK
    c = lax.cumsum(log_f, axis=1).transpose(0, 2, 1)
    kt = k.transpose(0, 2, 1, 3)
    vt = v.transpose(0, 2, 1, 3)
    qb = q.reshape(B_, nblk, Q_BLOCK, H, E).transpose(1, 0, 3, 2, 4)
    cq = c.reshape(B_, H, nblk, Q_BLOCK).transpose(2, 0, 1, 3)
    starts = jnp.arange(nblk, dtype=jnp.int32) * Q_BLOCK
    kpos = jnp.arange(S_, dtype=jnp.int32)

    def block(args):
        qi, ci, st = args
        s = jnp.einsum('bhqe,bhke->bhqk', qi, kt, preferred_element_type=F32)
        s = s + (ci[..., None] - c[:, :, None, :])
        qpos = st + jnp.arange(Q_BLOCK, dtype=jnp.int32)
        s = jnp.where(kpos[None, :] <= qpos[:, None], s, -jnp.inf)
        p = jax.nn.softmax(s, axis=-1)
        return jnp.einsum('bhqk,bhke->bhqe', p.astype(vt.dtype), vt, preferred_element_type=F32)

    o = lax.map(block, (qb, cq, starts))
    return o.transpose(1, 0, 3, 2, 4).reshape(B_, S_, H, E)


def hybrid_mixer(x, cos, sin, w_in, b_forget, lam_re, lam_im, log_dt, b_re, b_im,
                 c_re, c_im, d_skip, w_glu, w_branch, w_out):
    B_, S_, _ = x.shape
    proj = x @ w_in
    offsets = np.cumsum(IN_SPLITS)[:-1].tolist()
    u, qkv_dil, qkv_fox, f_logit, g_logit = jnp.split(proj, offsets, axis=-1)
    scale = HEAD_DIM ** -0.5

    y_ssm = s5_mixer(u, lam_re, lam_im, log_dt, b_re, b_im, c_re, c_im, d_skip, w_glu)

    qd, kd, vd = [t.reshape(B_, S_, N_HEADS_DIL, HEAD_DIM) for t in jnp.split(qkv_dil, 3, axis=-1)]
    qd = partial_rotary(qd, cos, sin) * scale
    kd = partial_rotary(kd, cos, sin)
    y_dil = dilated_mixture(qd, kd, vd).astype(x.dtype).reshape(B_, S_, BRANCH_W)

    qf, kf, vf = [t.reshape(B_, S_, N_HEADS_FOX, HEAD_DIM) for t in jnp.split(qkv_fox, 3, axis=-1)]
    log_f = jax.nn.log_sigmoid(f_logit.astype(F32) + b_forget.astype(F32))
    y_fox = forgetting_attention(qf * scale, kf, vf, log_f).astype(x.dtype).reshape(B_, S_, BRANCH_W)

    ys = jnp.stack([y_ssm, y_dil, y_fox], axis=2)
    gates = jax.nn.sigmoid(g_logit.reshape(B_, S_, N_BRANCH, D_MODEL))
    merged = jnp.sum(gates * jnp.einsum('bsnc,ncd->bsnd', ys, w_branch), axis=2)
    return merged @ w_out


def memory_cross_attention(x, mem, wq, wk, wv, wo):
    B_, S_, _ = x.shape
    q = (x @ wq).reshape(B_, S_, N_HEADS_X, HEAD_DIM_X) * HEAD_DIM_X ** -0.5
    k = (mem @ wk).reshape(B_, -1, N_HEADS_X, HEAD_DIM_X)
    v = (mem @ wv).reshape(B_, -1, N_HEADS_X, HEAD_DIM_X)
    s = jnp.einsum('bshe,bmhe->bhsm', q, k, preferred_element_type=F32)
    p = jax.nn.softmax(s, axis=-1).astype(v.dtype)
    o = jnp.einsum('bhsm,bmhe->bshe', p, v).reshape(B_, S_, D_MODEL)
    return o @ wo


def swiglu(x, wg, wu, wd):
    return (jax.nn.silu(x @ wg) * (x @ wu)) @ wd


def moe_ffn(x, w_router, b_router, wg, wu, wd):
    logits = (x @ w_router).astype(F32) + b_router.astype(F32)
    top_v, top_i = lax.top_k(logits, TOP_K)
    top_w = jax.nn.softmax(top_v, axis=-1)
    gate = jnp.sum(jax.nn.one_hot(top_i, N_EXPERTS, dtype=F32) * top_w[..., None], axis=-2)
    out = jnp.zeros_like(x)
    for e in range(N_EXPERTS):
        out = out + gate[..., e:e + 1].astype(x.dtype) * swiglu(x, wg[e], wu[e], wd[e])
    return out


def setup_inputs(seed: int = 0) -> dict:
    key = jax.random.key(seed)
    keys = iter(jax.random.split(key, 48))

    def nrm(shape, scale=1.0):
        return jax.random.normal(next(keys), shape, F32) * scale

    def gain(shape):
        return 1.0 + nrm(shape, 0.02)

    G, P, C = N_SSM_GROUPS, SSM_STATE, SSM_GROUP
    n_idx = jnp.arange(P, dtype=F32)
    beta = DEEPNORM_BETA
    return {
        "x": nrm((BATCH, SEQ, D_MODEL)),
        "mem": nrm((BATCH, N_MEM, D_MODEL)),
        "positions": jax.random.randint(next(keys), (BATCH, 1), 0, 1024, dtype=jnp.int32)
                     + jnp.arange(SEQ, dtype=jnp.int32)[None, :],
        "w_in": nrm((DEPTH, D_MODEL, N_IN), D_MODEL ** -0.5),
        "b_forget": jax.random.uniform(next(keys), (DEPTH, N_HEADS_FOX), F32, 1.0, 6.0),
        "ssm_lambda_re": -0.5 + nrm((DEPTH, G, P), 0.02),
        "ssm_lambda_im": math.pi * n_idx + nrm((DEPTH, G, P), 0.02),
        "ssm_log_dt": jax.random.uniform(next(keys), (DEPTH, G), F32, math.log(DT_MIN), math.log(DT_MAX)),
        "ssm_b_re": nrm((DEPTH, G, P, C), (2 * C) ** -0.5),
        "ssm_b_im": nrm((DEPTH, G, P, C), (2 * C) ** -0.5),
        "ssm_c_re": nrm((DEPTH, G, C, P), P ** -0.5),
        "ssm_c_im": nrm((DEPTH, G, C, P), P ** -0.5),
        "ssm_d": nrm((DEPTH, D_SSM), 0.5),
        "w_glu": nrm((DEPTH, D_SSM, D_SSM), D_SSM ** -0.5),
        "w_branch": nrm((DEPTH, N_BRANCH, BRANCH_W, D_MODEL), BRANCH_W ** -0.5),
        "w_mix_out": nrm((DEPTH, D_MODEL, D_MODEL), beta * D_MODEL ** -0.5),
        "ln_mix_g": gain((DEPTH, D_MODEL)),
        "ln_mix_b": nrm((DEPTH, D_MODEL), 0.02),
        "w_xq": nrm((DEPTH, D_MODEL, D_MODEL), D_MODEL ** -0.5),
        "w_xk": nrm((DEPTH, D_MODEL, D_MODEL), D_MODEL ** -0.5),
        "w_xv": nrm((DEPTH, D_MODEL, D_MODEL), D_MODEL ** -0.5),
        "w_xo": nrm((DEPTH, D_MODEL, D_MODEL), beta * D_MODEL ** -0.5),
        "ln_x_g": gain((DEPTH, D_MODEL)),
        "ln_x_b": nrm((DEPTH, D_MODEL), 0.02),
        "ffn_w_gate": nrm((N_DENSE, D_MODEL, D_FF), D_MODEL ** -0.5),
        "ffn_w_up": nrm((N_DENSE, D_MODEL, D_FF), D_MODEL ** -0.5),
        "ffn_w_down": nrm((N_DENSE, D_FF, D_MODEL), beta * D_FF ** -0.5),
        "moe_w_router": nrm((N_MOE, D_MODEL, N_EXPERTS), D_MODEL ** -0.5),
        "moe_b_router": nrm((N_MOE, N_EXPERTS), 0.01),
        "moe_w_gate": nrm((N_MOE, N_EXPERTS, D_MODEL, D_FF_EXPERT), D_MODEL ** -0.5),
        "moe_w_up": nrm((N_MOE, N_EXPERTS, D_MODEL, D_FF_EXPERT), D_MODEL ** -0.5),
        "moe_w_down": nrm((N_MOE, N_EXPERTS, D_FF_EXPERT, D_MODEL), beta * D_FF_EXPERT ** -0.5),
        "ln_ffn_g": gain((DEPTH, D_MODEL)),
        "ln_ffn_b": nrm((DEPTH, D_MODEL), 0.02),
    }


def reference(x, mem, positions, w_in, b_forget, ssm_lambda_re, ssm_lambda_im, ssm_log_dt,
              ssm_b_re, ssm_b_im, ssm_c_re, ssm_c_im, ssm_d, w_glu, w_branch, w_mix_out,
              ln_mix_g, ln_mix_b, w_xq, w_xk, w_xv, w_xo, ln_x_g, ln_x_b,
              ffn_w_gate, ffn_w_up, ffn_w_down, moe_w_router, moe_b_router,
              moe_w_gate, moe_w_up, moe_w_down, ln_ffn_g, ln_ffn_b):
    cos, sin = rope_tables(positions)
    for l in range(DEPTH):
        mix = hybrid_mixer(x, cos, sin, w_in[l], b_forget[l], ssm_lambda_re[l], ssm_lambda_im[l],
                           ssm_log_dt[l], ssm_b_re[l], ssm_b_im[l], ssm_c_re[l], ssm_c_im[l],
                           ssm_d[l], w_glu[l], w_branch[l], w_mix_out[l])
        x = layer_norm(DEEPNORM_ALPHA * x + mix, ln_mix_g[l], ln_mix_b[l])
        xa = memory_cross_attention(x, mem, w_xq[l], w_xk[l], w_xv[l], w_xo[l])
        x = layer_norm(DEEPNORM_ALPHA * x + xa, ln_x_g[l], ln_x_b[l])
        i = l // 2
        if l % 2 == 0:
            ff = swiglu(x, ffn_w_gate[i], ffn_w_up[i], ffn_w_down[i])
        else:
            ff = moe_ffn(x, moe_w_router[i], moe_b_router[i], moe_w_gate[i], moe_w_up[i], moe_w_down[i])
        x = layer_norm(DEEPNORM_ALPHA * x + ff, ln_ffn_g[l], ln_ffn_b[l])
    return x
```

```cpp
#include <hip/hip_runtime.h>
#include <cstdio>
#include <cstdint>

#define GAS __attribute__((address_space(1)))
#define LAS __attribute__((address_space(3)))
typedef unsigned short bf16_t;
typedef short bf16x8 __attribute__((ext_vector_type(8)));
typedef short s16x4 __attribute__((ext_vector_type(4)));
typedef float f32x2 __attribute__((ext_vector_type(2)));
typedef float f32x4 __attribute__((ext_vector_type(4)));
typedef float f32x16 __attribute__((ext_vector_type(16)));
typedef unsigned u32x2 __attribute__((ext_vector_type(2)));
typedef unsigned u32x4 __attribute__((ext_vector_type(4)));

constexpr int NB = 8, SEQ = 4096, T = NB * SEQ, D = 1024;
constexpr int DEPTH = 4, NIN = 6664, NQKV = 3072, NGATE = 3072;
constexpr int DFF = 2816, DFFE = 1408, NEXP = 8, NMEM = 256;
constexpr int XG_ROWS = 2 * T + 8 * 256;
constexpr float LOG2E = 1.4426950408889634f;
constexpr float C2_64 = 0.125f * LOG2E;
constexpr float C2_256 = 0.0625f * LOG2E;
constexpr float ALPHA = 1.681792830507429f;
constexpr float LN_EPS = 1e-5f;

typedef __bf16 bf16x2_t __attribute__((ext_vector_type(2)));
__device__ __forceinline__ unsigned cvt_pk_bf16(float lo, float hi) { const f32x2 v = {lo, hi}; const bf16x2_t b = __builtin_convertvector(v, bf16x2_t); return __builtin_bit_cast(unsigned, b); }
typedef _Float16 h16x2_t __attribute__((ext_vector_type(2)));
__device__ __forceinline__ unsigned cvt_pk_f16(float lo, float hi) { const f32x2 v = {lo, hi}; const h16x2_t h = __builtin_convertvector(v, h16x2_t); return __builtin_bit_cast(unsigned, h); }
__device__ __forceinline__ f32x2 unpk_f16(unsigned u) { return __builtin_convertvector(__builtin_bit_cast(h16x2_t, u), f32x2); }
__device__ __forceinline__ u32x4 pack8h(const f32x4 a, const f32x4 b) { u32x4 w; w.x = cvt_pk_f16(a[0], a[1]); w.y = cvt_pk_f16(a[2], a[3]); w.z = cvt_pk_f16(b[0], b[1]); w.w = cvt_pk_f16(b[2], b[3]); return w; }
__device__ __forceinline__ void unpack8h(const u32x4 w, f32x4& a, f32x4& b) { const f32x2 p0 = unpk_f16(w.x), p1 = unpk_f16(w.y), p2 = unpk_f16(w.z), p3 = unpk_f16(w.w); a = (f32x4){p0.x, p0.y, p1.x, p1.y}; b = (f32x4){p2.x, p2.y, p3.x, p3.y}; }
__device__ __forceinline__ float bf_lo(unsigned u) { return __uint_as_float(u << 16); }
__device__ __forceinline__ float bf_hi(unsigned u) { return __uint_as_float(u & 0xffff0000u); }
__device__ __forceinline__ float fexp2(float x) { return __builtin_amdgcn_exp2f(x); }
__device__ __forceinline__ float frcp(float x) { return __builtin_amdgcn_rcpf(x); }
__device__ __forceinline__ float sigmoidf_(float x) { return frcp(1.0f + fexp2(-x * LOG2E)); }
__device__ __forceinline__ float siluf_(float x) { return x * sigmoidf_(x); }
__device__ __forceinline__ float gelu_tanh_(float x) { const float u = 0.7978845608028654f * (x + 0.044715f * x * x * x); return x * sigmoidf_(2.0f * u); }
__device__ __forceinline__ float wave_sum(float v) {
#pragma unroll
    for (int o = 1; o < 64; o <<= 1) v += __shfl_xor(v, o);
    return v;
}
__device__ __forceinline__ u32x4 pack8(const f32x4 a, const f32x4 b) { u32x4 w; w.x = cvt_pk_bf16(a[0], a[1]); w.y = cvt_pk_bf16(a[2], a[3]); w.z = cvt_pk_bf16(b[0], b[1]); w.w = cvt_pk_bf16(b[2], b[3]); return w; }
__device__ __forceinline__ void unpack8(const u32x4 w, f32x4& a, f32x4& b) { a = (f32x4){bf_lo(w.x), bf_hi(w.x), bf_lo(w.y), bf_hi(w.y)}; b = (f32x4){bf_lo(w.z), bf_hi(w.z), bf_lo(w.w), bf_hi(w.w)}; }

namespace pg8 {
constexpr int BM = 256, BK = 64, HALF = 128, HTB = HALF * BK * 2, STAGE_BYTES = 8 * HTB, NXCD = 8, WGM = 8;
__host__ __device__ __forceinline__ int lds_byte(int r, int c) { const int st = (r >> 4) * 2 + (c >> 5), rr = r & 15, cc = c & 31, ob = rr * 64 + cc * 2; return st * 1024 + (ob ^ (((ob >> 9) & 1) << 5)); }
__host__ __device__ __forceinline__ void stage_rc(int b, int& R, int& C) { const int st = b / 1024, sb = b % 1024, swz = sb ^ (((sb >> 9) & 1) << 5); R = (st >> 1) * 16 + swz / 64; C = (st & 1) * 32 + (swz % 64) / 2; }
__host__ __device__ __forceinline__ int perm32(int rho) { const int n = rho >> 4, i = rho & 15; return 8 * (i >> 2) + 4 * n + (i & 3); }

struct Unit { const char* A; const char* B; int pm, pn, aux; };

__device__ __forceinline__ bool static_order(int nM, int nN, int G, int c, int i, int& pm, int& pn) {
    const int nwg = nM * nN; const long L = (long)i * G + c; if (L >= nwg) return false;
    int wgid = (int)L; { const int q = nwg / NXCD, r = nwg % NXCD, xcd = wgid % NXCD, off = wgid / NXCD; wgid = (xcd < r ? xcd * (q + 1) : r * (q + 1) + (xcd - r) * q) + off; }
    const int nig = WGM * nN, gid = wgid / nig, fm = gid * WGM, gsz = (nM - fm) < WGM ? (nM - fm) : WGM;
    pm = fm + ((wgid % nig) % gsz); pn = (wgid % nig) / gsz; return true;
}

template <class Epi, class Sched, bool ALIGN_EPI = true, bool SP2 = true>
__device__ __forceinline__ void gemm_phase(LAS unsigned char* lds, const int lda, const int ldb, const int nt, const Sched& S, const Epi& E) {
    int tid = threadIdx.x; asm volatile("" : "+v"(tid));
    const int wid = __builtin_amdgcn_readfirstlane(tid >> 6), lane = tid & 63, wr = wid >> 2, wc = wid & 3, fr = lane & 15, fq = lane >> 4;
    constexpr bool GA = Sched::GATHER; static_assert(!GA || SP2, "gathered A: SP2 stream only");
    unsigned voffA[2], voffB[2]; int RA[2], CA[2];
#pragma unroll
    for (int i = 0; i < 2; ++i) { int R, C; stage_rc(tid * 16 + i * 8192, R, C); const int Rb = Epi::PERM ? ((R & ~31) + perm32(R & 31)) : R; RA[i] = R; CA[i] = C;
        voffA[i] = (unsigned)(R * lda + C) * 2u; voffB[i] = (unsigned)(Rb * ldb + C) * 2u; }
    unsigned vC0[2] = {0u, 0u}, vC1[2] = {0u, 0u}, vN0[2] = {0u, 0u}, vN1[2] = {0u, 0u};
    const size_t kstep = (size_t)(BK * 2);
    const size_t hstepA = (size_t)HALF * lda * 2, hstepB = (size_t)HALF * ldb * 2;
    const unsigned ldsw = (unsigned)wid * 1024u;
    const int aoff = lds_byte(wr * 64 + fr, fq * 8), boff = lds_byte(wc * 32 + fr, fq * 8);
#define PG8_SA(b, h) (((b) * 2 + (h)) * HTB)
#define PG8_SB(b, h) ((4 + (b) * 2 + (h)) * HTB)
#define PG8_STAGE(bufoff, gbase, voff) do { _Pragma("unroll") for (int _i = 0; _i < 2; ++_i) \
        __builtin_amdgcn_global_load_lds((const unsigned*)((const char*)(gbase) + (voff)[_i]), (LAS unsigned*)(lds + (bufoff) + ldsw + _i * 8192), 16, 0, 0); } while (0)
#define PG8_STAGE_A(b, h, ptr, nx) do { if constexpr (GA) { const unsigned o0_ = (nx) ? ((h) ? vN1[0] : vN0[0]) : ((h) ? vC1[0] : vC0[0]), o1_ = (nx) ? ((h) ? vN1[1] : vN0[1]) : ((h) ? vC1[1] : vC0[1]); \
        __builtin_amdgcn_global_load_lds((const unsigned*)((const char*)(ptr) + o0_), (LAS unsigned*)(lds + PG8_SA(b, h) + ldsw), 16, 0, 0); \
        __builtin_amdgcn_global_load_lds((const unsigned*)((const char*)(ptr) + o1_), (LAS unsigned*)(lds + PG8_SA(b, h) + ldsw + 8192), 16, 0, 0); } \
        else PG8_STAGE(PG8_SA(b, h), (ptr) + ((h) ? hstepA : (size_t)0), voffA); } while (0)
#define PG8_LDA(dst, b, h) do { _Pragma("unroll") for (int m = 0; m < 4; ++m) _Pragma("unroll") for (int k = 0; k < 2; ++k) dst[m][k] = *(const LAS bf16x8*)(lds + PG8_SA(b, h) + aoff + m * 2048 + k * 1024); } while (0)
#define PG8_LDB(dst, b, h) do { _Pragma("unroll") for (int n = 0; n < 2; ++n) _Pragma("unroll") for (int k = 0; k < 2; ++k) dst[n][k] = *(const LAS bf16x8*)(lds + PG8_SB(b, h) + boff + n * 2048 + k * 1024); } while (0)
#define PG8_MMA(ai, bj, At, Bt) do { __builtin_amdgcn_s_setprio(1); _Pragma("unroll") for (int m = 0; m < 4; ++m) _Pragma("unroll") for (int n = 0; n < 2; ++n) _Pragma("unroll") for (int k = 0; k < 2; ++k) \
        acc[ai][bj][m][n] = __builtin_amdgcn_mfma_f32_16x16x32_bf16(Bt[n][k], At[m][k], acc[ai][bj][m][n], 0, 0, 0); __builtin_amdgcn_s_setprio(0); } while (0)
#define PG8_WAIT_V(n) asm volatile("s_waitcnt vmcnt(" #n ")" ::: "memory")
#define PG8_WAIT_L(n) asm volatile("s_waitcnt lgkmcnt(" #n ")" ::: "memory")
#define PG8_BAR __builtin_amdgcn_s_barrier()
#define PG8_SCHED __builtin_amdgcn_sched_barrier(0)
    Unit cur, nxt; int ui = 0;
    if (!S.next(0, cur)) return;
    f32x4 acc[2][2][4][2];
#pragma unroll
    for (int a = 0; a < 2; ++a)
#pragma unroll
        for (int b = 0; b < 2; ++b)
#pragma unroll
            for (int m = 0; m < 4; ++m)
#pragma unroll
                for (int n = 0; n < 2; ++n) acc[a][b][m][n] = (f32x4){0.f, 0.f, 0.f, 0.f};
    bf16x8 At[4][2], B0[2][2], B1[2][2];
    const char* cA = cur.A; const char* cB = cur.B;
    if constexpr (GA) S.gather(0, RA, CA, vC0, vC1);
    if constexpr (SP2) {
        PG8_STAGE(PG8_SB(0, 0), cB, voffB); PG8_STAGE(PG8_SB(0, 1), cB + hstepB, voffB); PG8_STAGE_A(0, 0, cA, false); PG8_STAGE_A(0, 1, cA, false);
        if (wr == 1) PG8_BAR;
        PG8_WAIT_V(2); PG8_BAR;
        PG8_STAGE(PG8_SB(1, 0), cB + kstep, voffB); PG8_STAGE_A(1, 0, cA + kstep, false); PG8_STAGE(PG8_SB(1, 1), cB + hstepB + kstep, voffB);
        PG8_WAIT_V(6); PG8_BAR;
    } else {
        PG8_STAGE(PG8_SB(0, 0), cB, voffB); PG8_STAGE(PG8_SA(0, 0), cA, voffA); PG8_STAGE(PG8_SB(0, 1), cB + hstepB, voffB); PG8_STAGE(PG8_SA(0, 1), cA + hstepA, voffA);
        if (wr == 1) PG8_BAR;
        PG8_WAIT_V(4); PG8_BAR;
        PG8_STAGE(PG8_SB(1, 0), cB + kstep, voffB); PG8_STAGE(PG8_SA(1, 0), cA + kstep, voffA); PG8_STAGE(PG8_SB(1, 1), cB + hstepB + kstep, voffB);
        PG8_WAIT_V(6); PG8_BAR;
    }
    for (;;) {
        const bool has_next = S.next(ui + 1, nxt);
        const char* nA = has_next ? nxt.A : cA; const char* nB = has_next ? nxt.B : cB;
        if constexpr (GA) { if (has_next) S.gather(ui + 1, RA, CA, vN0, vN1); else { vN0[0] = vC0[0]; vN0[1] = vC0[1]; vN1[0] = vC1[0]; vN1[1] = vC1[1]; } }
        for (int t = 0; t < nt; t += 2) {
            const bool last = (t == nt - 2);
            const char* a1 = cA + (size_t)(t + 1) * kstep;
            const char* a2 = last ? nA : cA + (size_t)(t + 2) * kstep; const char* b2 = last ? nB : cB + (size_t)(t + 2) * kstep;
            const char* a3 = a2 + kstep; const char* b3 = b2 + kstep;
            if constexpr (SP2) {
            PG8_LDB(B0, 0, 0); PG8_LDB(B1, 0, 1); PG8_SCHED; PG8_LDA(At, 0, 0); PG8_STAGE_A(1, 1, a1, false);
            PG8_WAIT_V(8); PG8_WAIT_L(0); PG8_BAR; PG8_MMA(0, 0, At, B0); PG8_MMA(0, 1, At, B1); PG8_BAR; PG8_SCHED;
            PG8_LDA(At, 0, 1); PG8_STAGE(PG8_SB(0, 0), b2, voffB); PG8_STAGE(PG8_SB(0, 1), b2 + hstepB, voffB); PG8_STAGE_A(0, 0, a2, last);
            PG8_WAIT_V(8); PG8_WAIT_L(0); PG8_BAR; PG8_MMA(1, 0, At, B0); PG8_MMA(1, 1, At, B1); PG8_BAR; PG8_SCHED;
            PG8_LDB(B0, 1, 0); PG8_LDB(B1, 1, 1); PG8_SCHED; PG8_LDA(At, 1, 0); PG8_STAGE_A(0, 1, a2, last);
            PG8_WAIT_V(8); PG8_WAIT_L(0); PG8_BAR; PG8_MMA(0, 0, At, B0); PG8_MMA(0, 1, At, B1); PG8_BAR; PG8_SCHED;
            PG8_LDA(At, 1, 1); PG8_STAGE(PG8_SB(1, 0), b3, voffB); PG8_STAGE(PG8_SB(1, 1), b3 + hstepB, voffB); PG8_STAGE_A(1, 0, a3, last);
            PG8_WAIT_V(8); PG8_WAIT_L(0); PG8_BAR; PG8_MMA(1, 0, At, B0); PG8_MMA(1, 1, At, B1); PG8_BAR; PG8_SCHED;
            } else {
            PG8_LDB(B0, 0, 0); PG8_SCHED; PG8_LDA(At, 0, 0); PG8_STAGE(PG8_SA(1, 1), a1 + hstepA, voffA);
            PG8_WAIT_L(8); PG8_BAR; PG8_WAIT_L(0); PG8_MMA(0, 0, At, B0); PG8_BAR; PG8_SCHED;
            PG8_LDB(B1, 0, 1); PG8_STAGE(PG8_SB(0, 0), b2, voffB);
            PG8_BAR; PG8_WAIT_L(0); PG8_MMA(0, 1, At, B1); PG8_BAR;
            PG8_LDA(At, 0, 1); PG8_STAGE(PG8_SA(0, 0), a2, voffA);
            PG8_BAR; PG8_WAIT_L(0); PG8_MMA(1, 0, At, B0); PG8_BAR; PG8_SCHED;
            PG8_STAGE(PG8_SB(0, 1), b2 + hstepB, voffB);
            PG8_WAIT_V(6); PG8_BAR; PG8_MMA(1, 1, At, B1); PG8_BAR;
            PG8_LDB(B0, 1, 0); PG8_SCHED; PG8_LDA(At, 1, 0); PG8_STAGE(PG8_SA(0, 1), a2 + hstepA, voffA);
            PG8_WAIT_L(8); PG8_BAR; PG8_WAIT_L(0); PG8_MMA(0, 0, At, B0); PG8_BAR; PG8_SCHED;
            PG8_LDB(B1, 1, 1); PG8_STAGE(PG8_SB(1, 0), b3, voffB);
            PG8_BAR; PG8_WAIT_L(0); PG8_MMA(0, 1, At, B1); PG8_BAR;
            PG8_LDA(At, 1, 1); PG8_STAGE(PG8_SA(1, 0), a3, voffA);
            PG8_BAR; PG8_WAIT_L(0); PG8_MMA(1, 0, At, B0); PG8_BAR; PG8_SCHED;
            PG8_STAGE(PG8_SB(1, 1), b3 + hstepB, voffB);
            PG8_WAIT_V(6); PG8_BAR; PG8_MMA(1, 1, At, B1); PG8_BAR;
            }
        }
        if constexpr (ALIGN_EPI) { if (wr == 0) PG8_BAR; }
        { int fr2 = fr, fq2 = fq; asm volatile("" : "+v"(fr2), "+v"(fq2)); E(acc, cur, wr, wc, fr2, fq2); }
        if (!has_next) break;
        if (!Epi::keep_acc(cur)) {
#pragma unroll
        for (int a = 0; a < 2; ++a)
#pragma unroll
            for (int b = 0; b < 2; ++b)
#pragma unroll
                for (int m = 0; m < 4; ++m)
#pragma unroll
                    for (int n = 0; n < 2; ++n) acc[a][b][m][n] = (f32x4){0.f, 0.f, 0.f, 0.f};
        }
        cur = nxt; cA = nA; cB = nB; ++ui;
        if constexpr (GA) { vC0[0] = vN0[0]; vC0[1] = vN0[1]; vC1[0] = vN1[0]; vC1[1] = vN1[1]; }
        if constexpr (ALIGN_EPI) { if (wr == 1) PG8_BAR; }
    }
    PG8_WAIT_V(0);
    if constexpr (!ALIGN_EPI) { if (wr == 0) PG8_BAR; }
    PG8_BAR;
#undef PG8_SA
#undef PG8_SB
#undef PG8_STAGE
#undef PG8_STAGE_A
#undef PG8_LDA
#undef PG8_LDB
#undef PG8_MMA
#undef PG8_WAIT_V
#undef PG8_WAIT_L
#undef PG8_BAR
#undef PG8_SCHED
}
}
using pg8::Unit;
typedef f32x4 Acc[2][2][4][2];

struct SchedBatched { static constexpr bool GATHER = false;
    const char* Abase; const char* Bbase; size_t strideA, strideB; int lda, ldb, nM, nN, nbatch, G, c;
    __device__ __forceinline__ bool next(int i, Unit& u) const {
        if (nbatch == 1) { int pm, pn; if (!pg8::static_order(nM, nN, G, c, i, pm, pn)) return false;
            u.pm = pm; u.pn = pn; u.aux = 0; u.A = Abase + (size_t)pm * 256 * lda * 2; u.B = Bbase + (size_t)pn * 256 * ldb * 2; return true; }
        const long L = (long)i * G + c; const int per = nM * nN; if (L >= (long)per * nbatch) return false;
        const int g = (int)(L / per), r = (int)(L % per); u.pm = r / nN; u.pn = r % nN; u.aux = g;
        u.A = Abase + (size_t)g * strideA + (size_t)u.pm * 256 * lda * 2; u.B = Bbase + (size_t)g * strideB + (size_t)u.pn * 256 * ldb * 2; return true;
    }
};
struct SchedOne { static constexpr bool GATHER = false; Unit u; __device__ __forceinline__ bool next(int i, Unit& o) const { if (i != 0) return false; o = u; return true; } };
struct SchedMerge { static constexpr bool GATHER = false;
    const char* A0; const char* A1; const char* A2; const char* Bbase; int G, c;
    __device__ __forceinline__ bool next(int i, Unit& u) const {
        const int n = i % 3; int pm, pn; if (!pg8::static_order(128, 4, G, c, i / 3, pm, pn)) return false;
        u.pm = pm; u.pn = pn; u.aux = n;
        const char* a = n == 0 ? A0 : (n == 1 ? A1 : A2);
        u.A = a + (size_t)pm * 256 * 512 * 2; u.B = Bbase + (size_t)n * (1024 * 512 * 2) + (size_t)pn * 256 * 512 * 2; return true;
    }
};
struct SchedMoe { static constexpr bool GATHER = false;
    const char* Abase; const char* Bbase; size_t strideB; int lda, ldb, nN, G, c; int toff[9];
    __device__ __forceinline__ bool next(int i, Unit& u) const {
        const long L = (long)i * G + c; if (L >= (long)toff[8] * nN) return false;
        const int pm = (int)(L / nN), pn = (int)(L % nN); int e = 0;
#pragma unroll
        for (int k = 1; k < 8; ++k) e += (pm >= toff[k]) ? 1 : 0;
        u.pm = pm; u.pn = pn; u.aux = e; u.A = Abase + (size_t)pm * 256 * lda * 2; u.B = Bbase + (size_t)e * strideB + (size_t)pn * 256 * ldb * 2; return true;
    }
};

struct SchedMoeG { static constexpr bool GATHER = true;
    static constexpr int nN = 11; const char* Abase; const char* Bbase; size_t strideB; int lda, ldb, G, c; int toff[9]; const LAS unsigned short* linv;
    __device__ __forceinline__ bool next(int i, Unit& u) const {
        const long L = (long)i * G + c; if (L >= (long)toff[8] * nN) return false;
        const int pm = (int)(L / nN), pn = (int)(L % nN); int e = 0;
#pragma unroll
        for (int k = 1; k < 8; ++k) e += (pm >= toff[k]) ? 1 : 0;
        u.pm = pm; u.pn = pn; u.aux = e; u.A = Abase; u.B = Bbase + (size_t)e * strideB + (size_t)pn * 256 * ldb * 2; return true;
    }
    __device__ __forceinline__ void gather(int ord, const int* R, const int* C, unsigned* v0, unsigned* v1) const {
#pragma unroll
        for (int i = 0; i < 2; ++i) { const unsigned t0 = linv[ord * 256 + R[i]], t1 = linv[ord * 256 + 128 + R[i]];
            v0[i] = (t0 * (unsigned)lda + (unsigned)C[i]) * 2u; v1[i] = (t1 * (unsigned)lda + (unsigned)C[i]) * 2u; }
    }
};

#define FOR_ROWS _Pragma("unroll") for (int ai = 0; ai < 2; ++ai) _Pragma("unroll") for (int m = 0; m < 4; ++m)
#define ROW_T (ai * 128 + wr * 64 + m * 16 + fr)

struct EpiScale {
    static __device__ __forceinline__ bool keep_acc(const Unit&) { return false; } static constexpr bool PERM = true;
    bf16_t* O; int ldc; float scale; size_t auxstride;
    __device__ __forceinline__ void operator()(const Acc& acc, const Unit& u, int wr, int wc, int fr, int fq) const {
        bf16_t* base = O + (size_t)u.aux * auxstride + (size_t)u.pm * 256 * ldc + u.pn * 256 + wc * 32 + 8 * fq;
        FOR_ROWS { const int rt = ROW_T;
#pragma unroll
            for (int bj = 0; bj < 2; ++bj) { __builtin_nontemporal_store(pack8(acc[ai][bj][m][0] * scale, acc[ai][bj][m][1] * scale), (u32x4*)(base + (size_t)rt * ldc + bj * 128)); } }
    }
};
struct EpiInProj {
    static __device__ __forceinline__ bool keep_acc(const Unit&) { return false; } static constexpr bool PERM = true;
    bf16_t* UG; bf16_t* QKV; const float* ROPE; unsigned* NORM;
    __device__ __forceinline__ void operator()(const Acc& acc, const Unit& u, int wr, int wc, int fr, int fq) const {
        if (u.pn < 2) {
            FOR_ROWS { const int rt = ROW_T; const int row = u.pm * 256 + rt, b = row >> 12, t = row & 4095, j = t >> 5, ti = t & 31;
#pragma unroll
                for (int bj = 0; bj < 2; ++bj) { const int c0 = u.pn * 256 + bj * 128 + wc * 32 + 8 * fq, g = c0 >> 4, ci = c0 & 15;
                    __builtin_nontemporal_store(pack8(acc[ai][bj][m][0], acc[ai][bj][m][1]), (u32x4*)(UG + ((size_t)(g * 1024 + b * 128 + j) * 640 + ti * 16 + ci))); } }
        } else {
            const int seg = (u.pn - 2) >> 1; const float sc = (seg == 0 || seg == 3) ? C2_64 : 1.0f; const bool rope = (seg < 2) && ((wc & 1) == 0);
            const int colbase = (u.pn - 2) * 256 + wc * 32 + 8 * fq;
            const bool nrm = (seg == 3 || seg == 4); float hm0 = 0.f, hm1 = 0.f;
            FOR_ROWS { const int rt = ROW_T; const int row = u.pm * 256 + rt;
#pragma unroll
                for (int bj = 0; bj < 2; ++bj) { f32x4 v0 = acc[ai][bj][m][0], v1 = acc[ai][bj][m][1];
                    if (nrm) { const f32x4 w0 = v0 * sc, w1 = v1 * sc; const f32x4 q2 = w0 * w0 + w1 * w1; float ss = (q2[0] + q2[1]) + (q2[2] + q2[3]);
                        ss += __shfl_xor(ss, 16); ss += __shfl_xor(ss, 32);
                        if (bj == 0) hm0 = fmaxf(hm0, ss); else hm1 = fmaxf(hm1, ss); }
                    if (rope) {
                        f32x4 p0, p1;
#pragma unroll
                        for (int k = 0; k < 4; ++k) { p0[k] = __shfl_xor(v0[k], 16); p1[k] = __shfl_xor(v1[k], 16); }
                        if (fq < 2) { const f32x4 c0 = *(const f32x4*)(ROPE + (size_t)row * 16), c1 = *(const f32x4*)(ROPE + (size_t)row * 16 + 4), s0 = *(const f32x4*)(ROPE + (size_t)row * 16 + 8), s1 = *(const f32x4*)(ROPE + (size_t)row * 16 + 12);
                            const float sg = fq == 0 ? -1.0f : 1.0f;
                            v0 = v0 * c0 + (p0 * s0) * sg; v1 = v1 * c1 + (p1 * s1) * sg; }
                    }
                    __builtin_nontemporal_store(pack8(v0 * sc, v1 * sc), (u32x4*)(QKV + (size_t)row * NQKV + colbase + bj * 128)); } }
            if (nrm) {
#pragma unroll
                for (int o = 1; o < 16; o <<= 1) { hm0 = fmaxf(hm0, __shfl_xor(hm0, o)); hm1 = fmaxf(hm1, __shfl_xor(hm1, o)); }
                if ((threadIdx.x & 63) == 0) { const int b = (u.pm * 256) >> 12, c0 = (u.pn - 2) * 256 + wc * 32;
                    __hip_atomic_fetch_max(NORM + ((b * 8 + ((c0 >> 6) & 7)) * 4 + (seg == 4 ? 2 : 0) + (wc & 1)), __float_as_uint(hm0 * 1.01f), __ATOMIC_RELAXED, __HIP_MEMORY_SCOPE_AGENT);
                    __hip_atomic_fetch_max(NORM + ((b * 8 + (((c0 + 128) >> 6) & 7)) * 4 + (seg == 4 ? 2 : 0) + (wc & 1)), __float_as_uint(hm1 * 1.01f), __ATOMIC_RELAXED, __HIP_MEMORY_SCOPE_AGENT); } }
        }
    }
};
struct EpiGates {
    static __device__ __forceinline__ bool keep_acc(const Unit&) { return false; } static constexpr bool PERM = true;
    bf16_t* G;
    __device__ __forceinline__ void operator()(const Acc& acc, const Unit& u, int wr, int wc, int fr, int fq) const {
        bf16_t* base = G + (size_t)u.pm * 256 * NGATE + u.pn * 256 + wc * 32 + 8 * fq;
        FOR_ROWS { const int rt = ROW_T;
#pragma unroll
            for (int bj = 0; bj < 2; ++bj) { f32x4 a = acc[ai][bj][m][0], b = acc[ai][bj][m][1];
#pragma unroll
                for (int k = 0; k < 4; ++k) { a[k] = sigmoidf_(a[k]); b[k] = sigmoidf_(b[k]); }
                __builtin_nontemporal_store(pack8(a, b), (u32x4*)(base + (size_t)rt * NGATE + bj * 128)); } }
    }
};
struct EpiGlu {
    static constexpr bool F16 = false; static __device__ __forceinline__ bool keep_acc(const Unit&) { return false; } static constexpr bool PERM = true; static constexpr int NVMEM = 0;
    const bf16_t* Y; bf16_t* O;
    __device__ __forceinline__ void operator()(const Acc& acc, const Unit& u, int wr, int wc, int fr, int fq) const {
        const size_t off0 = (size_t)u.pm * 256 * 512 + u.pn * 256 + wc * 32 + 8 * fq;
#pragma unroll
        for (int ai = 0; ai < 2; ++ai) {
            u32x4 yz[4][2];
#pragma unroll
            for (int m = 0; m < 4; ++m)
#pragma unroll
                for (int bj = 0; bj < 2; ++bj) yz[m][bj] = *(const u32x4*)(Y + off0 + (size_t)ROW_T * 512 + bj * 128);
#pragma unroll
            for (int m = 0; m < 4; ++m)
#pragma unroll
                for (int bj = 0; bj < 2; ++bj) { f32x4 ya, yb; unpack8(yz[m][bj], ya, yb); f32x4 a = acc[ai][bj][m][0], b = acc[ai][bj][m][1];
#pragma unroll
                    for (int k = 0; k < 4; ++k) { a[k] = ya[k] * sigmoidf_(a[k]); b[k] = yb[k] * sigmoidf_(b[k]); }
                    *(u32x4*)(O + off0 + (size_t)ROW_T * 512 + bj * 128) = pack8(a, b); }
            asm volatile("" ::: "memory");
        }
    }

};
struct EpiMerge {
    static constexpr bool F16 = false; static __device__ __forceinline__ bool keep_acc(const Unit& u) { return u.aux < 2; } static constexpr bool PERM = true; static constexpr int NVMEM = 0;
    const bf16_t* G; bf16_t* M;
    __device__ __forceinline__ void operator()(Acc& acc, const Unit& u, int wr, int wc, int fr, int fq) const {
        const int col0 = u.pn * 256 + wc * 32 + 8 * fq; const int n = u.aux;
#pragma unroll
        for (int ai = 0; ai < 2; ++ai)
#pragma unroll
            for (int mp = 0; mp < 2; ++mp) {
                u32x4 gz[2][2], hz[2][2];
#pragma unroll
                for (int mm = 0; mm < 2; ++mm) { const int m = 2 * mp + mm; const size_t row = (size_t)u.pm * 256 + ROW_T;
#pragma unroll
                    for (int bj = 0; bj < 2; ++bj) { gz[mm][bj] = *(const u32x4*)(G + row * NGATE + n * 1024 + col0 + bj * 128); if (n < 2) hz[mm][bj] = *(const u32x4*)(G + row * NGATE + (n + 1) * 1024 + col0 + bj * 128); } }
#pragma unroll
                for (int mm = 0; mm < 2; ++mm) { const int m = 2 * mp + mm; const size_t row = (size_t)u.pm * 256 + ROW_T;
#pragma unroll
                    for (int bj = 0; bj < 2; ++bj) { f32x4 ga, gb; unpack8(gz[mm][bj], ga, gb);
#pragma unroll
                        for (int k = 0; k < 4; ++k) { ga[k] = fmaxf(ga[k], 1.0e-30f); gb[k] = fmaxf(gb[k], 1.0e-30f); }
                        if (n < 2) { f32x4 ha, hb; unpack8(hz[mm][bj], ha, hb);
#pragma unroll
                            for (int k = 0; k < 4; ++k) { ga[k] *= frcp(fmaxf(ha[k], 1.0e-30f)); gb[k] *= frcp(fmaxf(hb[k], 1.0e-30f)); }
                            acc[ai][bj][m][0] *= ga; acc[ai][bj][m][1] *= gb; }
                        else *(u32x4*)(M + row * 1024 + col0 + bj * 128) = pack8(acc[ai][bj][m][0] * ga, acc[ai][bj][m][1] * gb); } }
                asm volatile("" ::: "memory");
            }
    }

};
template <bool INF32> struct EpiResT {
    static __device__ __forceinline__ bool keep_acc(const Unit&) { return false; } static constexpr bool PERM = true; static constexpr int NVMEM = 0;
    unsigned short* ZH; const float* X32; const float* ST; const float* g; const float* b;
    __device__ __forceinline__ void operator()(const Acc& acc, const Unit& u, int wr, int wc, int fr, int fq) const {
        const int col0 = u.pn * 256 + wc * 32 + 8 * fq;
        f32x4 g4[2][2], b4[2][2];
#pragma unroll
        for (int bj = 0; bj < 2; ++bj)
#pragma unroll
            for (int n = 0; n < 2; ++n) { g4[bj][n] = *(const f32x4*)(g + col0 + bj * 128 + n * 4); b4[bj][n] = *(const f32x4*)(b + col0 + bj * 128 + n * 4) * ALPHA; }
#pragma unroll
        for (int ai = 0; ai < 2; ++ai) {
            u32x4 zr[4][2]; f32x2 stv[4];
#pragma unroll
            for (int m = 0; m < 4; ++m) { const size_t row = (size_t)u.pm * 256 + ROW_T; stv[m] = *(const f32x2*)(ST + row * 2);
                if (!INF32) {
#pragma unroll
                    for (int bj = 0; bj < 2; ++bj) zr[m][bj] = *(const u32x4*)(ZH + row * D + col0 + bj * 128); } }
#pragma unroll
            for (int m = 0; m < 4; ++m) { const size_t row = (size_t)u.pm * 256 + ROW_T; const f32x2 st = stv[m]; const float sc = st.y * ALPHA;
#pragma unroll
                for (int bj = 0; bj < 2; ++bj) { const size_t off = row * D + col0 + bj * 128; f32x4 x0, x1;
                    if (INF32) { x0 = *(const f32x4*)(X32 + off); x1 = *(const f32x4*)(X32 + off + 4); } else unpack8h(zr[m][bj], x0, x1);
                    x0 = ((x0 - st.x) * sc) * g4[bj][0] + b4[bj][0] + acc[ai][bj][m][0]; x1 = ((x1 - st.x) * sc) * g4[bj][1] + b4[bj][1] + acc[ai][bj][m][1];
                    *(u32x4*)(ZH + off) = pack8h(x0, x1); } }
            asm volatile("" ::: "memory");
        }
    }
};
struct EpiSwiglu {
    static __device__ __forceinline__ bool keep_acc(const Unit&) { return false; } static constexpr bool PERM = true;
    bf16_t* H; int ldh;
    __device__ __forceinline__ void operator()(const Acc& acc, const Unit& u, int wr, int wc, int fr, int fq) const {
        bf16_t* base = H + (size_t)u.pm * 256 * ldh + u.pn * 128 + wc * 32 + 8 * fq;
        FOR_ROWS { const int rt = ROW_T; f32x4 a = acc[ai][0][m][0], b = acc[ai][0][m][1]; const f32x4 ua = acc[ai][1][m][0], ub = acc[ai][1][m][1];
#pragma unroll
            for (int k = 0; k < 4; ++k) { a[k] = siluf_(a[k]) * ua[k]; b[k] = siluf_(b[k]) * ub[k]; }
            __builtin_nontemporal_store(pack8(a, b), (u32x4*)(base + (size_t)rt * ldh)); }
    }
};
struct EpiS1 {
    static __device__ __forceinline__ bool keep_acc(const Unit&) { return false; } static constexpr bool PERM = false;
    float* SLOC;
    __device__ __forceinline__ void operator()(const Acc& acc, const Unit& u, int wr, int wc, int fr, int fq) const {
        float* base = SLOC + ((size_t)u.aux * 1024 + u.pm * 256) * 128 + wc * 32 + 4 * fq;
        FOR_ROWS { const int rt = ROW_T;
#pragma unroll
            for (int n = 0; n < 2; ++n) *(f32x4*)(base + (size_t)rt * 128 + n * 16) = acc[ai][0][m][n]; }
    }
};
struct EpiS3 {
    static constexpr bool F16 = false; static __device__ __forceinline__ bool keep_acc(const Unit&) { return false; } static constexpr bool PERM = true; static constexpr int NVMEM = 0;
    const bf16_t* UG; const float* dskip; bf16_t* Y;
    __device__ __forceinline__ void operator()(const Acc& acc, const Unit& u, int wr, int wc, int fr, int fq) const {
        const int g = u.aux;
        f32x4 da[2], db[2]; int to[2], co[2];
#pragma unroll
        for (int bj = 0; bj < 2; ++bj) { const int n0 = u.pn * 256 + bj * 128 + wc * 32 + 8 * fq; to[bj] = n0 >> 4; co[bj] = n0 & 15; da[bj] = *(const f32x4*)(dskip + g * 16 + co[bj]); db[bj] = *(const f32x4*)(dskip + g * 16 + co[bj] + 4); }
#pragma unroll
        for (int ai = 0; ai < 2; ++ai) {
            u32x4 uz[4][2];
#pragma unroll
            for (int m = 0; m < 4; ++m)
#pragma unroll
                for (int bj = 0; bj < 2; ++bj) uz[m][bj] = *(const u32x4*)(UG + ((size_t)(g * 1024 + u.pm * 256 + ROW_T) * 640 + to[bj] * 16 + co[bj]));
#pragma unroll
            for (int m = 0; m < 4; ++m) { const int R = u.pm * 256 + ROW_T, b = R >> 7, j = R & 127;
#pragma unroll
                for (int bj = 0; bj < 2; ++bj) { f32x4 ua, ub; unpack8(uz[m][bj], ua, ub);
                    f32x4 a = acc[ai][bj][m][0] + da[bj] * ua, bb = acc[ai][bj][m][1] + db[bj] * ub;
#pragma unroll
                    for (int k = 0; k < 4; ++k) { a[k] = gelu_tanh_(a[k]); bb[k] = gelu_tanh_(bb[k]); }
                    *(u32x4*)(Y + ((size_t)(b * 4096 + j * 32 + to[bj]) * 512 + g * 16 + co[bj])) = pack8(a, bb); } }
            asm volatile("" ::: "memory");
        }
    }

};

namespace att {
__device__ __forceinline__ int crow(int r, int hi) { return (r & 3) + 8 * (r >> 2) + 4 * hi; }
__device__ __forceinline__ float swap_max(float m) { auto rr = __builtin_amdgcn_permlane32_swap(__float_as_uint(m), __float_as_uint(m), false, false); return fmaxf(__uint_as_float(rr[0]), __uint_as_float(rr[1])); }
__device__ __forceinline__ float swap_add(float m) { auto rr = __builtin_amdgcn_permlane32_swap(__float_as_uint(m), __float_as_uint(m), false, false); return __uint_as_float(rr[0]) + __uint_as_float(rr[1]); }
__device__ __forceinline__ float rowmax(const f32x16& p0, const f32x16& p1) {
    float a = fmaxf(p0[0], p1[0]);
#pragma unroll
    for (int r = 1; r < 16; ++r) a = fmaxf(a, fmaxf(p0[r], p1[r]));
    return swap_max(a);
}
__device__ __forceinline__ float max3f(float a, float b, float c) { float r; asm("v_max3_f32 %0, %1, %2, %3" : "=v"(r) : "v"(a), "v"(b), "v"(c)); return r; }
__device__ __forceinline__ float rowmax_fast(const f32x16& p0, const f32x16& p1) {
    float a = max3f(p0[0], p0[1], p1[0]), b = max3f(p0[2], p0[3], p1[1]); a = max3f(a, p1[2], p1[3]);
#pragma unroll
    for (int r = 4; r < 16; r += 4) { a = max3f(a, p0[r], p0[r + 1]); b = max3f(b, p0[r + 2], p0[r + 3]); a = max3f(a, p1[r], p1[r + 1]); b = max3f(b, p1[r + 2], p1[r + 3]); }
    float m; asm("v_max_f32_e32 %0, %1, %2" : "=v"(m) : "v"(a), "v"(b));
    auto rr = __builtin_amdgcn_permlane32_swap(__float_as_uint(m), __float_as_uint(m), false, false);
    float o; asm("v_max_f32_e32 %0, %1, %2" : "=v"(o) : "v"(__uint_as_float(rr[0])), "v"(__uint_as_float(rr[1]))); return o;
}
template <int NK> __device__ __forceinline__ void qkt(f32x16& p0, f32x16& p1, const LAS unsigned char* Kslot, const bf16x8* qr, int r32, int hi) {
    const LAS unsigned char* kb = Kslot + hi * 1024 + r32 * 16;
#pragma unroll
    for (int d0 = 0; d0 < NK; ++d0) {
        const bf16x8 b0 = *(const LAS bf16x8*)(kb + d0 * 2048);
        const bf16x8 b1 = *(const LAS bf16x8*)(kb + d0 * 2048 + 512);
        p0 = __builtin_amdgcn_mfma_f32_32x32x16_bf16(b0, qr[d0], p0, 0, 0, 0);
        p1 = __builtin_amdgcn_mfma_f32_32x32x16_bf16(b1, qr[d0], p1, 0, 0, 0);
    }
}
template <int ND> __device__ __forceinline__ void pv(f32x16* o, unsigned vb, bf16x8 pa0, bf16x8 pa1, bf16x8 pa2, bf16x8 pa3) {
#pragma unroll
    for (int d0 = 0; d0 < ND; ++d0) { s16x4 lo[4], hi[4];
#pragma unroll
        for (int ks = 0; ks < 4; ++ks) {
            asm volatile("ds_read_b64_tr_b16 %0, %1 offset:%c2" : "=&v"(lo[ks]) : "v"(vb), "i"(d0 * 4096 + ks * 1024) : "memory");
            asm volatile("ds_read_b64_tr_b16 %0, %1 offset:%c2" : "=&v"(hi[ks]) : "v"(vb), "i"(d0 * 4096 + ks * 1024 + 512) : "memory"); }
        asm volatile("s_waitcnt lgkmcnt(0)" ::: "memory"); __builtin_amdgcn_sched_barrier(0);
#define ATT_PK(k) (bf16x8){lo[k][0], lo[k][1], lo[k][2], lo[k][3], hi[k][0], hi[k][1], hi[k][2], hi[k][3]}
        o[d0] = __builtin_amdgcn_mfma_f32_32x32x16_bf16(pa0, ATT_PK(0), o[d0], 0, 0, 0);
        o[d0] = __builtin_amdgcn_mfma_f32_32x32x16_bf16(pa1, ATT_PK(1), o[d0], 0, 0, 0);
        o[d0] = __builtin_amdgcn_mfma_f32_32x32x16_bf16(pa2, ATT_PK(2), o[d0], 0, 0, 0);
        o[d0] = __builtin_amdgcn_mfma_f32_32x32x16_bf16(pa3, ATT_PK(3), o[d0], 0, 0, 0);
#undef ATT_PK
    }
}
__device__ __forceinline__ void glds16(const void* gsrc, unsigned lds_dst) { unsigned keep;
    asm volatile("s_mov_b32 %0, m0\n\ts_mov_b32 m0, %2\n\ts_nop 0\n\tglobal_load_lds_dwordx4 %1, off\n\ts_mov_b32 m0, %0" : "=&s"(keep) : "v"(gsrc), "s"(lds_dst) : "memory"); }
#define ATT_WAITBAR() do { asm volatile("s_waitcnt vmcnt(0) lgkmcnt(0)" ::: "memory"); __builtin_amdgcn_s_barrier(); asm volatile("" ::: "memory"); } while (0)
#define ATT_LDSBAR() do { asm volatile("s_waitcnt lgkmcnt(0)" ::: "memory"); __builtin_amdgcn_s_barrier(); asm volatile("" ::: "memory"); } while (0)
constexpr float NEG = -1.0e30f;

constexpr int ATT_NS = 4, ATT_KSLOT = 10240, ATT_VOFF = ATT_NS * ATT_KSLOT, ATT_OST = ATT_VOFF + ATT_NS * 8192;
template <int MODE>
__device__ __forceinline__ void attn64_unit(LAS unsigned char* lds, LAS float* wsf_all, const bf16_t* Qp, const bf16_t* Kp, const bf16_t* Vp, const long rs,
                                            const int i0, const int t_lo, const int t_hi, const bf16_t* kbias, bf16_t* Op, const long os, float* lsep, const long ls) {
    int tid = threadIdx.x; asm volatile("" : "+v"(tid));
    const int lane = tid & 63, r32 = lane & 31, hi = lane >> 5, wid = __builtin_amdgcn_readfirstlane(tid >> 6);
    LAS float* wsf = wsf_all + wid * 64;
    const int qw0 = i0 + wid * 32, qi = qw0 + r32;
    constexpr float THR = 30.0f;
    int w_lo = t_lo; const int w_hi = ((qw0 + 31) >> 6) + 1;
    if (MODE == 1) { const int lo = (qw0 - 128) >> 6; w_lo = lo > t_lo ? lo : t_lo; }
    float mhat = 0.f, lrun = 0.f; bool started = false; f32x16 o[2]; o[0] = f32x16{}; o[1] = f32x16{};
    f32x16 negm = f32x16{};
    const bf16_t* ksrc = Kp + (long)lane * rs + wid * 8;
    const bf16_t* vsrc = Vp + (long)(16 * (wid & 3) + (lane >> 2)) * rs + (wid >> 2) * 32 + (lane & 3) * 8;
    const unsigned vb0 = (unsigned)(uintptr_t)(lds + ATT_VOFF) + ((lane >> 4) & 1) * 32 + (lane & 3) * 8 + (4 * hi + ((lane & 15) >> 2)) * 64;
#define ATT_ISSUE(tt) do { const int t_ = (tt) < t_hi ? (tt) : t_hi - 1; const int s_ = (tt) & (ATT_NS - 1); const unsigned l0_ = (unsigned)(uintptr_t)lds; \
        glds16(ksrc + (long)t_ * 64 * rs, (unsigned)__builtin_amdgcn_readfirstlane((int)(l0_ + s_ * ATT_KSLOT + wid * 1024))); \
        glds16(vsrc + (long)t_ * 64 * rs, (unsigned)__builtin_amdgcn_readfirstlane((int)(l0_ + ATT_VOFF + s_ * 8192 + wid * 1024))); \
        if (MODE == 0 && wid == 0) glds16(kbias + (long)(t_ * 64 + lane) * 64, (unsigned)__builtin_amdgcn_readfirstlane((int)(l0_ + s_ * ATT_KSLOT + 8192))); } while (0)
#define ATT_QK(tt) do { const LAS unsigned char* Ks_ = lds + ((tt) & (ATT_NS - 1)) * ATT_KSLOT; const LAS unsigned char* kb_ = Ks_ + hi * 1024 + r32 * 16; bf16x8 kf[10]; \
        _Pragma("unroll") for (int d0_ = 0; d0_ < 4; ++d0_) { kf[2 * d0_] = *(const LAS bf16x8*)(kb_ + d0_ * 2048); kf[2 * d0_ + 1] = *(const LAS bf16x8*)(kb_ + d0_ * 2048 + 512); } \
        if (MODE == 0) { const LAS unsigned char* kx_ = Ks_ + 8192 + r32 * 16; kf[8] = *(const LAS bf16x8*)(kx_); kf[9] = *(const LAS bf16x8*)(kx_ + 512); \
            asm volatile("s_waitcnt lgkmcnt(0)" : "+v"(kf[0]), "+v"(kf[1]), "+v"(kf[2]), "+v"(kf[3]), "+v"(kf[4]), "+v"(kf[5]), "+v"(kf[6]), "+v"(kf[7]), "+v"(kf[8]), "+v"(kf[9]) :: "memory"); } \
        else asm volatile("s_waitcnt lgkmcnt(0)" : "+v"(kf[0]), "+v"(kf[1]), "+v"(kf[2]), "+v"(kf[3]), "+v"(kf[4]), "+v"(kf[5]), "+v"(kf[6]), "+v"(kf[7]) :: "memory"); \
        p0 = __builtin_amdgcn_mfma_f32_32x32x16_bf16(kf[0], qr[0], negm, 0, 0, 0); \
        p1 = __builtin_amdgcn_mfma_f32_32x32x16_bf16(kf[1], qr[0], negm, 0, 0, 0); \
        _Pragma("unroll") for (int d0_ = 1; d0_ < 4; ++d0_) { \
            p0 = __builtin_amdgcn_mfma_f32_32x32x16_bf16(kf[2 * d0_], qr[d0_], p0, 0, 0, 0); \
            p1 = __builtin_amdgcn_mfma_f32_32x32x16_bf16(kf[2 * d0_ + 1], qr[d0_], p1, 0, 0, 0); } \
        if (MODE == 0) { p0 = __builtin_amdgcn_mfma_f32_32x32x16_bf16(kf[8], qr[4], p0, 0, 0, 0); p1 = __builtin_amdgcn_mfma_f32_32x32x16_bf16(kf[9], qr[4], p1, 0, 0, 0); } \
        asm volatile("s_nop 15\n\ts_nop 7" : "+v"(p0), "+v"(p1)); } while (0)
#define ATT_WAIT_TILES(n2, n3) do { if (MODE == 0 && wid == 0) asm volatile("s_waitcnt vmcnt(" #n3 ") lgkmcnt(0)" ::: "memory"); else asm volatile("s_waitcnt vmcnt(" #n2 ") lgkmcnt(0)" ::: "memory"); \
        __builtin_amdgcn_s_barrier(); asm volatile("" ::: "memory"); } while (0)
    ATT_ISSUE(t_lo); ATT_ISSUE(t_lo + 1); ATT_ISSUE(t_lo + 2);
    bf16x8 qr[5];
#pragma unroll
    for (int d0 = 0; d0 < 4; ++d0) qr[d0] = *(const bf16x8*)(Qp + (long)qi * rs + d0 * 16 + hi * 8);
    { const short one = hi == 0 ? (short)0x3F80 : (short)0; qr[4] = (bf16x8){one, one, one, 0, 0, 0, 0, 0}; }
    asm volatile("s_waitcnt vmcnt(0)" : "+v"(qr[0]), "+v"(qr[1]), "+v"(qr[2]), "+v"(qr[3]) :: "memory");
    const bool stag = wid >= 4;
    f32x16 p0 = f32x16{}, p1 = f32x16{};
    ATT_WAIT_TILES(4, 6);
    if (stag && t_lo >= w_lo && t_lo < w_hi) ATT_QK(t_lo);
    for (int t = t_lo; t < t_hi; ++t) {
        ATT_WAIT_TILES(2, 3);
        ATT_ISSUE(t + 3);
        const bool a0 = (t >= w_lo && t < w_hi), a1 = (t + 1 >= w_lo && t + 1 < w_hi);
        if (!stag && a0) ATT_QK(t);
        if (a0) {
            const int kvb = 64 * t + 4 * hi;
            if (MODE == 0) {
                if (64 * t + 63 > qw0) {
#pragma unroll
                    for (int r = 0; r < 16; ++r) { const int kv = kvb + (r & 3) + 8 * (r >> 2); if (kv > qi) p0[r] = -INFINITY; if (kv + 32 > qi) p1[r] = -INFINITY; }
                }
            } else {
                if (64 * t + 63 > qw0 || 64 * t < qw0 + 31 - 128) {
#pragma unroll
                    for (int r = 0; r < 16; ++r) { const int dd = qi - (kvb + (r & 3) + 8 * (r >> 2)); if (dd < 0 || dd > 128) p0[r] = -INFINITY; if (dd - 32 < 0 || dd - 32 > 128) p1[r] = -INFINITY; }
                }
            }
            const float rm = rowmax_fast(p0, p1);
            const bool need = started ? (rm > THR) : (rm > -1.0e30f);
            bool resc = false;
            if (__any(need)) {
                const float dl = need ? rm : 0.f; mhat += dl;
#pragma unroll
                for (int r = 0; r < 16; ++r) { p0[r] -= dl; p1[r] -= dl; }
#pragma unroll
                for (int r = 0; r < 16; ++r) negm[r] = -mhat;
                const float f = (need && started) ? fexp2(-dl) : 1.0f; lrun *= f; started = started || need;
                if (hi == 0) wsf[r32] = f; resc = true;
            }
            float ps = 0.f;
#pragma unroll
            for (int r = 0; r < 16; ++r) { p0[r] = fexp2(p0[r]); p1[r] = fexp2(p1[r]); ps += p0[r] + p1[r]; }
            lrun += ps;
            if (resc) {
                asm volatile("s_waitcnt lgkmcnt(0)" ::: "memory");
#pragma unroll
                for (int g = 0; g < 4; ++g) { const f32x4 fv = *(const LAS f32x4*)(wsf + 8 * g + 4 * hi);
#pragma unroll
                    for (int k = 0; k < 4; ++k) { o[0][4 * g + k] *= fv[k]; o[1][4 * g + k] *= fv[k]; } }
            }
            u32x4 pw0, pw1, pw2, pw3;
            pw0 = (u32x4){cvt_pk_bf16(p0[0], p0[1]), cvt_pk_bf16(p0[2], p0[3]), cvt_pk_bf16(p0[4], p0[5]), cvt_pk_bf16(p0[6], p0[7])};
            pw1 = (u32x4){cvt_pk_bf16(p0[8], p0[9]), cvt_pk_bf16(p0[10], p0[11]), cvt_pk_bf16(p0[12], p0[13]), cvt_pk_bf16(p0[14], p0[15])};
            pw2 = (u32x4){cvt_pk_bf16(p1[0], p1[1]), cvt_pk_bf16(p1[2], p1[3]), cvt_pk_bf16(p1[4], p1[5]), cvt_pk_bf16(p1[6], p1[7])};
            pw3 = (u32x4){cvt_pk_bf16(p1[8], p1[9]), cvt_pk_bf16(p1[10], p1[11]), cvt_pk_bf16(p1[12], p1[13]), cvt_pk_bf16(p1[14], p1[15])};
            pv<2>(o, vb0 + (t & (ATT_NS - 1)) * 8192, __builtin_bit_cast(bf16x8, pw0), __builtin_bit_cast(bf16x8, pw1), __builtin_bit_cast(bf16x8, pw2), __builtin_bit_cast(bf16x8, pw3));
        }
        if (stag && a1) ATT_QK(t + 1);
    }
#undef ATT_ISSUE
#undef ATT_QK
#undef ATT_WAIT_TILES
    const float ltot = swap_add(lrun);
    if (hi == 0) { wsf[32 + r32] = ltot; if (MODE == 1) lsep[(long)qi * ls] = mhat + __builtin_amdgcn_logf(ltot); }
    asm volatile("s_waitcnt lgkmcnt(0)" ::: "memory");
    LAS bf16_t* stg = (LAS bf16_t*)(lds + ATT_OST) + wid * 2048;
#pragma unroll
    for (int g = 0; g < 4; ++g) { const f32x4 lv = *(const LAS f32x4*)(wsf + 32 + 8 * g + 4 * hi);
#pragma unroll
        for (int k = 0; k < 4; ++k) { const int r = 4 * g + k; const float rl = frcp(lv[k]); LAS bf16_t* srow = stg + crow(r, hi) * 64 + r32;
            srow[0] = (bf16_t)(cvt_pk_bf16(o[0][r] * rl, 0.f) & 0xffffu); srow[32] = (bf16_t)(cvt_pk_bf16(o[1][r] * rl, 0.f) & 0xffffu); } }
    asm volatile("s_waitcnt lgkmcnt(0)" ::: "memory");
#pragma unroll
    for (int i = 0; i < 4; ++i) { const int row = i * 8 + (lane >> 3), ch = lane & 7; const u32x4 v = *(const LAS u32x4*)(stg + row * 64 + ch * 8); *(u32x4*)(Op + (long)(qw0 + row) * os + ch * 8) = v; }
    ATT_WAITBAR();
}

__device__ __forceinline__ s16x4 vtr(const LAS unsigned char* p) { return __builtin_amdgcn_ds_read_tr16_b64_v4i16((LAS s16x4*)p); }
#define FX_MX3(a, b, c) __builtin_fmaxf(__builtin_fmaxf((a), (b)), (c))
__device__ __forceinline__ float rowmax_b(const f32x16& p0, const f32x16& p1) {
    float a = FX_MX3(p0[0], p0[1], p1[0]), b = FX_MX3(p0[2], p0[3], p1[1]); a = FX_MX3(a, p1[2], p1[3]);
#pragma unroll
    for (int r = 4; r < 16; r += 4) { a = FX_MX3(a, p0[r], p0[r + 1]); b = FX_MX3(b, p0[r + 2], p0[r + 3]); a = FX_MX3(a, p1[r], p1[r + 1]); b = FX_MX3(b, p1[r + 2], p1[r + 3]); }
    const float m = __builtin_fmaxf(a, b); auto rr = __builtin_amdgcn_permlane32_swap(__float_as_uint(m), __float_as_uint(m), false, false);
    return __builtin_fmaxf(__uint_as_float(rr[0]), __uint_as_float(rr[1])); }
__device__ __forceinline__ void fox_unit(LAS unsigned char* lds, LAS float* wsf_all, const bf16_t* Qp, const bf16_t* Kp, const bf16_t* Vp, const long rs,
                                         const int i0, const int t_lo, const int t_hi, const bf16_t* kbias, bf16_t* Op, const long os) {
    int tid = threadIdx.x; asm volatile("" : "+v"(tid));
    const int lane = tid & 63, r32 = lane & 31, hi = lane >> 5, wid = __builtin_amdgcn_readfirstlane(tid >> 6);
    LAS float* wsf = wsf_all + wid * 64;
    const int qw0 = i0 + wid * 32, qi = qw0 + r32;
    constexpr float THR = 30.0f;
#define FX_SBAR() __builtin_amdgcn_sched_barrier(0)
#define FX_PIN(x) asm volatile("" : "+v"(x))
#define FX_MF(a, b, c) __builtin_amdgcn_mfma_f32_32x32x16_bf16(a, b, c, 0, 0, 0)
    float mhat = 0.f, lrun = 0.f; f32x16 o[2]; o[0] = f32x16{}; o[1] = f32x16{};
    const bf16_t* ksrc = Kp + (long)lane * rs + wid * 8;
    const bf16_t* vsrc = Vp + (long)(16 * (wid & 3) + (lane >> 2)) * rs + (wid >> 2) * 32 + (lane & 3) * 8;
    const LAS unsigned char* vp0 = lds + ATT_VOFF + ((lane >> 4) & 1) * 32 + (lane & 3) * 8 + (4 * hi + ((lane & 15) >> 2)) * 64;
    const LAS unsigned char* kp0 = lds + hi * 1024 + r32 * 16;
    const LAS unsigned char* kx0 = lds + 8192 + r32 * 16;
#define FX_DMA_K(tt) do { const int t_ = (tt) < t_hi ? (tt) : t_hi - 1; const int s_ = (tt) & (ATT_NS - 1); const unsigned l0_ = (unsigned)(uintptr_t)lds; \
        glds16(ksrc + (long)t_ * 64 * rs, (unsigned)__builtin_amdgcn_readfirstlane((int)(l0_ + s_ * ATT_KSLOT + wid * 1024))); \
        if (wid == 0) glds16(kbias + (long)(t_ * 64 + lane) * 64, (unsigned)__builtin_amdgcn_readfirstlane((int)(l0_ + s_ * ATT_KSLOT + 8192))); } while (0)
#define FX_DMA_V(tt) do { const int t_ = (tt) < t_hi ? (tt) : t_hi - 1; const int s_ = (tt) & (ATT_NS - 1); const unsigned l0_ = (unsigned)(uintptr_t)lds; \
        glds16(vsrc + (long)t_ * 64 * rs, (unsigned)__builtin_amdgcn_readfirstlane((int)(l0_ + ATT_VOFF + s_ * 8192 + wid * 1024))); } while (0)
#define FX_WAIT_BAR() do { if (wid == 0) asm volatile("s_waitcnt vmcnt(4) lgkmcnt(0)\n\ts_barrier" ::: "memory"); else asm volatile("s_waitcnt vmcnt(3) lgkmcnt(0)\n\ts_barrier" ::: "memory"); } while (0)
#define FX_KLOAD2(kp_, d0) do { kf[2 * (d0)] = *(const LAS bf16x8*)((kp_) + (d0) * 2048); kf[2 * (d0) + 1] = *(const LAS bf16x8*)((kp_) + (d0) * 2048 + 512); } while (0)
#define FX_KLOADX(kx_) do { kf[8] = *(const LAS bf16x8*)(kx_); kf[9] = *(const LAS bf16x8*)((kx_) + 512); } while (0)
#define FX_MASK(C0, C1, tt) do { if (64 * (tt) + 63 > qw0) { const int kvb_ = 64 * (tt) + 4 * hi; \
        _Pragma("unroll") for (int r = 0; r < 16; ++r) { const int kv = kvb_ + (r & 3) + 8 * (r >> 2); if (kv > qi) C0[r] = -INFINITY; if (kv + 32 > qi) C1[r] = -INFINITY; } } } while (0)
#define FX_SETREF() do { const float nm_ = -mhat; const unsigned h1_ = cvt_pk_bf16(nm_, 0.f) & 0xffffu; const float r1_ = nm_ - bf_lo(h1_); const unsigned h2_ = cvt_pk_bf16(r1_, 0.f) & 0xffffu; \
        const float r2_ = r1_ - bf_lo(h2_); const unsigned h3_ = cvt_pk_bf16(r2_, 0.f) & 0xffffu; \
        u32x4 q4_; q4_.x = q4d0; q4_.y = hi == 0 ? (0x3F80u | (h1_ << 16)) : 0u; q4_.z = hi == 0 ? (h2_ | (h3_ << 16)) : 0u; q4_.w = 0u; qr[4] = __builtin_bit_cast(bf16x8, q4_); } while (0)
    FX_DMA_K(t_lo); FX_DMA_K(t_lo + 1); FX_DMA_V(t_lo); FX_DMA_K(t_lo + 2); FX_DMA_V(t_lo + 1); FX_DMA_K(t_lo + 3); FX_DMA_V(t_lo + 2);
    bf16x8 qr[5];
#pragma unroll
    for (int d0 = 0; d0 < 4; ++d0) qr[d0] = *(const bf16x8*)(Qp + (long)qi * rs + d0 * 16 + hi * 8);
    unsigned q4d0 = hi == 0 ? 0x3F803F80u : 0u; asm volatile("" : "+v"(q4d0));
    { u32x4 q4_; q4_.x = q4d0; q4_.y = hi == 0 ? 0x3F80u : 0u; q4_.z = 0u; q4_.w = 0u; qr[4] = __builtin_bit_cast(bf16x8, q4_); }
    asm volatile("s_waitcnt vmcnt(0)" : "+v"(qr[0]), "+v"(qr[1]), "+v"(qr[2]), "+v"(qr[3]) :: "memory");
    asm volatile("s_barrier" ::: "memory");
    f32x16 pA0, pA1, pB0, pB1; bf16x8 kf[10]; s16x4 vlo[8], vhi[8]; u32x4 pw0, pw1, pw2, pw3; bool resc = false;
    { const LAS unsigned char* kp_ = kp0 + (t_lo & (ATT_NS - 1)) * ATT_KSLOT;
      FX_KLOAD2(kp_, 0); FX_KLOAD2(kp_, 1); FX_KLOAD2(kp_, 2); FX_KLOAD2(kp_, 3); FX_KLOADX(kx0 + (t_lo & (ATT_NS - 1)) * ATT_KSLOT); }
    pA0 = FX_MF(kf[8], qr[4], (f32x16){}); pA1 = FX_MF(kf[9], qr[4], (f32x16){});
#pragma unroll
    for (int d0 = 0; d0 < 4; ++d0) { pA0 = FX_MF(kf[2 * d0], qr[d0], pA0); pA1 = FX_MF(kf[2 * d0 + 1], qr[d0], pA1); }
    FX_MASK(pA0, pA1, t_lo);
    { const float rm = rowmax_b(pA0, pA1); mhat = rm;
#pragma unroll
      for (int r = 0; r < 16; ++r) { pA0[r] = fexp2(pA0[r] - rm); pA1[r] = fexp2(pA1[r] - rm); }
      FX_SETREF(); }
    { const LAS unsigned char* kp_ = kp0 + ((t_lo + 1) & (ATT_NS - 1)) * ATT_KSLOT;
      FX_KLOAD2(kp_, 0); FX_KLOAD2(kp_, 1); FX_KLOAD2(kp_, 2); FX_KLOAD2(kp_, 3); FX_KLOADX(kx0 + ((t_lo + 1) & (ATT_NS - 1)) * ATT_KSLOT); }
    asm volatile("s_waitcnt lgkmcnt(0)\n\ts_barrier" ::: "memory");
#define FX_PKW(P, i) cvt_pk_bf16(P[i], P[(i) + 1])
#define FX_PAF(k) __builtin_bit_cast(bf16x8, pw##k)
#define FX_VFR(i) (bf16x8){vlo[i][0], vlo[i][1], vlo[i][2], vlo[i][3], vhi[i][0], vhi[i][1], vhi[i][2], vhi[i][3]}
#define FX_VRD(i) do { vlo[i] = vtr(vp_ + (((i) >> 2) * 4096 + ((i) & 3) * 1024)); vhi[i] = vtr(vp_ + (((i) >> 2) * 4096 + ((i) & 3) * 1024 + 512)); } while (0)
#define FX_GAPA(MF, a0, a1, a2, W0, W1, PW) do { MF; sacc += a0; sacc += a1; sacc += a2; W0; W1; FX_PIN(PW); FX_PIN(sacc); FX_SBAR(); } while (0)
#define FX_GAPA3(MF, a0, a1, a2) do { MF; sacc += a0; sacc += a1; sacc += a2; FX_PIN(sacc); FX_SBAR(); } while (0)
#define FX_GAPB(MF, X, i) do { MF; X[i] = fexp2(X[i]); X[(i) + 1] = fexp2(X[(i) + 1]); X[(i) + 2] = fexp2(X[(i) + 2]); X[(i) + 3] = fexp2(X[(i) + 3]); FX_PIN(X); FX_SBAR(); } while (0)
#define FX_STEP(C0, C1, P0, P1, t, MASK) do { FX_SBAR(); \
    const LAS unsigned char* vp_ = vp0 + (((t) - 1) & (ATT_NS - 1)) * 8192; \
    FX_VRD(0); FX_SBAR(); float sacc = P0[0] + P0[1]; \
                       FX_GAPA(C0 = FX_MF(kf[8], qr[4], (f32x16){}), P0[2], P0[3], P0[4],    pw0[0] = FX_PKW(P0, 0),  pw0[1] = FX_PKW(P0, 2),  pw0); \
    FX_VRD(4); FX_SBAR(); FX_GAPA(C1 = FX_MF(kf[9], qr[4], (f32x16){}), P0[5], P0[6], P0[7],    pw0[2] = FX_PKW(P0, 4),  pw0[3] = FX_PKW(P0, 6),  pw0); \
    FX_VRD(1); FX_SBAR(); FX_GAPA(C0 = FX_MF(kf[0], qr[0], C0),   P0[8], P0[9], P0[10],   pw1[0] = FX_PKW(P0, 8),  pw1[1] = FX_PKW(P0, 10), pw1); \
    FX_VRD(5); FX_SBAR(); FX_GAPA(C1 = FX_MF(kf[1], qr[0], C1),   P0[11], P0[12], P0[13], pw1[2] = FX_PKW(P0, 12), pw1[3] = FX_PKW(P0, 14), pw1); \
    FX_VRD(2); FX_SBAR(); FX_GAPA(C0 = FX_MF(kf[2], qr[1], C0),   P0[14], P0[15], P1[0],  pw2[0] = FX_PKW(P1, 0),  pw2[1] = FX_PKW(P1, 2),  pw2); \
    FX_VRD(6); FX_SBAR(); FX_GAPA(C1 = FX_MF(kf[3], qr[1], C1),   P1[1], P1[2], P1[3],    pw2[2] = FX_PKW(P1, 4),  pw2[3] = FX_PKW(P1, 6),  pw2); \
    FX_VRD(3); FX_SBAR(); FX_GAPA(C0 = FX_MF(kf[4], qr[2], C0),   P1[4], P1[5], P1[6],    pw3[0] = FX_PKW(P1, 8),  pw3[1] = FX_PKW(P1, 10), pw3); \
    FX_VRD(7); FX_SBAR(); FX_GAPA(C1 = FX_MF(kf[5], qr[2], C1),   P1[7], P1[8], P1[9],    pw3[2] = FX_PKW(P1, 12), pw3[3] = FX_PKW(P1, 14), pw3); \
    FX_GAPA3(C0 = FX_MF(kf[6], qr[3], C0), P1[10], P1[11], P1[12]); \
    FX_GAPA3(C1 = FX_MF(kf[7], qr[3], C1), P1[13], P1[14], P1[15]); \
    lrun += sacc; \
    FX_DMA_K((t) + 3); FX_DMA_V((t) + 2);                                  \
    if (MASK) FX_MASK(C0, C1, t); \
    { const float rm = rowmax_b(C0, C1); resc = false;                     \
      if (__builtin_expect(__any(rm > THR), 0)) { const float dl = __builtin_fmaxf(rm, 0.f); mhat += dl;        \
          _Pragma("unroll") for (int r = 0; r < 16; ++r) { C0[r] -= dl; C1[r] -= dl; } \
          FX_SETREF(); \
          const float f = fexp2(-dl); lrun *= f; if (hi == 0) wsf[r32] = f; resc = true; } } \
    FX_SBAR(); \
    const LAS unsigned char* kp_ = kp0 + (((t) + 1) & (ATT_NS - 1)) * ATT_KSLOT; \
    FX_GAPB(o[0] = FX_MF(FX_PAF(0), FX_VFR(0), o[0]), C0, 0);                              FX_GAPB(o[1] = FX_MF(FX_PAF(0), FX_VFR(4), o[1]), C0, 4); \
    FX_KLOAD2(kp_, 0); FX_SBAR(); FX_GAPB(o[0] = FX_MF(FX_PAF(1), FX_VFR(1), o[0]), C0, 8);   FX_KLOAD2(kp_, 1); FX_SBAR(); FX_GAPB(o[1] = FX_MF(FX_PAF(1), FX_VFR(5), o[1]), C0, 12); \
    FX_KLOAD2(kp_, 2); FX_SBAR(); FX_GAPB(o[0] = FX_MF(FX_PAF(2), FX_VFR(2), o[0]), C1, 0);   FX_KLOAD2(kp_, 3); FX_SBAR(); FX_GAPB(o[1] = FX_MF(FX_PAF(2), FX_VFR(6), o[1]), C1, 4); \
    FX_KLOADX(kx0 + (((t) + 1) & (ATT_NS - 1)) * ATT_KSLOT); FX_SBAR(); FX_GAPB(o[0] = FX_MF(FX_PAF(3), FX_VFR(3), o[0]), C1, 8);   FX_GAPB(o[1] = FX_MF(FX_PAF(3), FX_VFR(7), o[1]), C1, 12); \
    FX_WAIT_BAR(); \
    if (resc) { _Pragma("unroll") for (int g = 0; g < 4; ++g) { const f32x4 fv = *(const LAS f32x4*)(wsf + 8 * g + 4 * hi); \
        _Pragma("unroll") for (int k = 0; k < 4; ++k) { o[0][4 * g + k] *= fv[k]; o[1][4 * g + k] *= fv[k]; } } } \
    } while (0)
#define FX_DRAIN(P0, P1) do { float sacc = P0[0] + P0[1]; \
      _Pragma("unroll") for (int r = 2; r < 16; ++r) sacc += P0[r]; \
      _Pragma("unroll") for (int r = 0; r < 16; ++r) sacc += P1[r]; \
      lrun += sacc; \
      pw0 = (u32x4){FX_PKW(P0, 0), FX_PKW(P0, 2), FX_PKW(P0, 4), FX_PKW(P0, 6)}; pw1 = (u32x4){FX_PKW(P0, 8), FX_PKW(P0, 10), FX_PKW(P0, 12), FX_PKW(P0, 14)}; \
      pw2 = (u32x4){FX_PKW(P1, 0), FX_PKW(P1, 2), FX_PKW(P1, 4), FX_PKW(P1, 6)}; pw3 = (u32x4){FX_PKW(P1, 8), FX_PKW(P1, 10), FX_PKW(P1, 12), FX_PKW(P1, 14)}; \
      const LAS unsigned char* vp_ = vp0 + ((t_hi - 1) & (ATT_NS - 1)) * 8192; _Pragma("unroll") for (int i = 0; i < 8; ++i) FX_VRD(i); \
      o[0] = FX_MF(FX_PAF(0), FX_VFR(0), o[0]); o[1] = FX_MF(FX_PAF(0), FX_VFR(4), o[1]); o[0] = FX_MF(FX_PAF(1), FX_VFR(1), o[0]); o[1] = FX_MF(FX_PAF(1), FX_VFR(5), o[1]); \
      o[0] = FX_MF(FX_PAF(2), FX_VFR(2), o[0]); o[1] = FX_MF(FX_PAF(2), FX_VFR(6), o[1]); o[0] = FX_MF(FX_PAF(3), FX_VFR(3), o[0]); o[1] = FX_MF(FX_PAF(3), FX_VFR(7), o[1]); } while (0)
    int t = t_lo + 1; const int t_band = t_hi - 4;
    for (; t + 1 < t_band; t += 2) {
        FX_STEP(pB0, pB1, pA0, pA1, t, false);
        FX_STEP(pA0, pA1, pB0, pB1, t + 1, false);
    }
    for (; t + 1 < t_hi; t += 2) {
        FX_STEP(pB0, pB1, pA0, pA1, t, true);
        FX_STEP(pA0, pA1, pB0, pB1, t + 1, true);
    }
    if (t < t_hi) { FX_STEP(pB0, pB1, pA0, pA1, t, true); FX_DRAIN(pB0, pB1); } else FX_DRAIN(pA0, pA1);
    const float ltot = swap_add(lrun);
    if (hi == 0) wsf[32 + r32] = ltot;
    asm volatile("s_waitcnt lgkmcnt(0)" ::: "memory");
    LAS bf16_t* stg = (LAS bf16_t*)(lds + ATT_OST) + wid * 2048;
#pragma unroll
    for (int g = 0; g < 4; ++g) { const f32x4 lv = *(const LAS f32x4*)(wsf + 32 + 8 * g + 4 * hi);
#pragma unroll
        for (int k = 0; k < 4; ++k) { const int r = 4 * g + k; const float rl = frcp(lv[k]); LAS bf16_t* srow = stg + crow(r, hi) * 64 + r32;
            srow[0] = (bf16_t)(cvt_pk_bf16(o[0][r] * rl, 0.f) & 0xffffu); srow[32] = (bf16_t)(cvt_pk_bf16(o[1][r] * rl, 0.f) & 0xffffu); } }
    asm volatile("s_waitcnt lgkmcnt(0)" ::: "memory");
#pragma unroll
    for (int i = 0; i < 4; ++i) { const int row = i * 8 + (lane >> 3), ch = lane & 7; const u32x4 v = *(const LAS u32x4*)(stg + row * 64 + ch * 8); *(u32x4*)(Op + (long)(qw0 + row) * os + ch * 8) = v; }
    ATT_LDSBAR();
#undef FX_SBAR
#undef FX_SETREF
#undef FX_PIN
#undef FX_MF
#undef FX_DMA_K
#undef FX_DMA_V
#undef FX_WAIT_BAR
#undef FX_KLOAD2
#undef FX_KLOADX
#undef FX_MASK
#undef FX_PKW
#undef FX_PAF
#undef FX_VFR
#undef FX_VRD
#undef FX_GAPA
#undef FX_GAPA3
#undef FX_GAPB
#undef FX_STEP
#undef FX_DRAIN
}

template <bool ISO>
__device__ __forceinline__ void dil_sweep(LAS unsigned char* lds, LAS float* wsf_all, const bf16_t* Qp, const bf16_t* Kp, const bf16_t* Vp, const long rs, const int B0, const int NB,
                                          bf16_t* Op, const long os, float* lsep, const long ls, const long bst, const long obst, const long lbst) {
    int tid = threadIdx.x; asm volatile("" : "+v"(tid));
    const int lane = tid & 63, r32 = lane & 31, hi = lane >> 5, wid = __builtin_amdgcn_readfirstlane(tid >> 6);
    LAS float* wsf = wsf_all + wid * 64;
    const int NT = 4 * (B0 + NB), T0 = ISO ? 4 * B0 : (B0 > 0 ? 4 * B0 - 2 : 0), wh = wid >> 1;
    constexpr float THR = 30.0f;
    float mhat = 0.f, lrun = 0.f; bool started = false; f32x16 o[2]; o[0] = f32x16{}; o[1] = f32x16{};
    f32x16 negm = f32x16{};
    const bf16_t* ksrc = Kp + (long)lane * rs + wid * 8;
    const bf16_t* vsrc = Vp + (long)(16 * (wid & 3) + (lane >> 2)) * rs + (wid >> 2) * 32 + (lane & 3) * 8;
    const LAS unsigned char* vp0 = lds + ATT_VOFF + ((lane >> 4) & 1) * 32 + (lane & 3) * 8 + (4 * hi + ((lane & 15) >> 2)) * 64;
    LAS bf16_t* stg = (LAS bf16_t*)(lds + ATT_OST) + wid * 2048;
#define DS_ISSUE(tt) do { const int t_ = (tt) < NT ? (tt) : NT - 1; const int s_ = (tt) & (ATT_NS - 1); const unsigned l0_ = (unsigned)(uintptr_t)lds; \
        const long to_ = ISO ? (long)(t_ >> 2) * bst + (long)(t_ & 3) * 64 * rs : (long)t_ * 64 * rs; \
        glds16(ksrc + to_, (unsigned)__builtin_amdgcn_readfirstlane((int)(l0_ + s_ * ATT_KSLOT + wid * 1024))); \
        glds16(vsrc + to_, (unsigned)__builtin_amdgcn_readfirstlane((int)(l0_ + ATT_VOFF + s_ * 8192 + wid * 1024))); } while (0)
#define DS_QDMA(bq) do { const unsigned sb_ = (unsigned)(uintptr_t)stg; \
        _Pragma("unroll") for (int i_ = 0; i_ < 4; ++i_) glds16(Qp + (ISO ? (long)(bq) * bst : (long)256 * (bq) * rs) + (long)(32 * wid + 8 * i_ + (lane >> 3)) * rs + (lane & 7) * 8, (unsigned)__builtin_amdgcn_readfirstlane((int)(sb_ + i_ * 1024))); } while (0)
#define DS_WAITBAR(n) do { asm volatile("s_waitcnt vmcnt(" #n ") lgkmcnt(0)" ::: "memory"); __builtin_amdgcn_s_barrier(); asm volatile("" ::: "memory"); } while (0)
    DS_ISSUE(T0); DS_ISSUE(T0 + 1); DS_ISSUE(T0 + 2); DS_QDMA(B0);
    DS_WAITBAR(0);
    bf16x8 qr[4]; f32x16 p0 = f32x16{}, p1 = f32x16{};
#pragma unroll
    for (int d0 = 0; d0 < 4; ++d0) qr[d0] = bf16x8{};
    for (int t = T0; t <= NT; ++t) {
        const int u = t - 4 * B0 - wh + 2, rel = u & 3, blk = B0 + (u >> 2);
        const bool act = (u >= 0) && (rel != 3) && (blk < B0 + NB) && (!ISO || t >= 4 * blk);
        if (rel == 0) DS_WAITBAR(2); else DS_WAITBAR(4);
        if (rel == 3 && u > 0 && blk < B0 + NB) {
            const int qw0 = (ISO ? 0 : 256 * blk) + 32 * wid, qi = qw0 + r32;
            bf16_t* Ob_ = Op + (ISO ? (long)blk * obst : 0L); float* lb_ = lsep + (ISO ? (long)blk * lbst : 0L);
            const float ltot = swap_add(lrun);
            if (hi == 0) { wsf[32 + r32] = ltot; lb_[(long)qi * ls] = mhat + __builtin_amdgcn_logf(ltot); }
            asm volatile("s_waitcnt lgkmcnt(0)" ::: "memory");
#pragma unroll
            for (int g = 0; g < 4; ++g) { const f32x4 lv = *(const LAS f32x4*)(wsf + 32 + 8 * g + 4 * hi);
#pragma unroll
                for (int k = 0; k < 4; ++k) { const int r = 4 * g + k; const float rl = frcp(lv[k]); LAS bf16_t* srow = stg + crow(r, hi) * 64 + r32;
                    srow[0] = (bf16_t)(cvt_pk_bf16(o[0][r] * rl, 0.f) & 0xffffu); srow[32] = (bf16_t)(cvt_pk_bf16(o[1][r] * rl, 0.f) & 0xffffu); } }
            asm volatile("s_waitcnt lgkmcnt(0)" ::: "memory");
#pragma unroll
            for (int i = 0; i < 4; ++i) { const int row = i * 8 + (lane >> 3), ch = lane & 7; const u32x4 v = *(const LAS u32x4*)(stg + row * 64 + ch * 8); *(u32x4*)(Ob_ + (long)(qw0 + row) * os + ch * 8) = v; }
            if (blk + 1 < B0 + NB) DS_QDMA(blk + 1);
        }
        DS_ISSUE(t + 3);
        if (act) {
            const int qw0 = (ISO ? 0 : 256 * blk) + 32 * wid, qi = qw0 + r32, tk = ISO ? t - 4 * blk : t;
            if (ISO ? (t == 4 * blk + (wh > 2 ? wh - 2 : 0)) : (rel == 0 || t == 0)) {
#pragma unroll
                for (int d0 = 0; d0 < 4; ++d0) qr[d0] = *(const LAS bf16x8*)((const LAS unsigned char*)stg + r32 * 128 + d0 * 32 + hi * 16);
                asm volatile("s_waitcnt lgkmcnt(0)" : "+v"(qr[0]), "+v"(qr[1]), "+v"(qr[2]), "+v"(qr[3]) :: "memory");
                o[0] = f32x16{}; o[1] = f32x16{}; negm = f32x16{}; mhat = 0.f; lrun = 0.f; started = false;
            }
            { const LAS unsigned char* Ks_ = lds + (t & (ATT_NS - 1)) * ATT_KSLOT; const LAS unsigned char* kb_ = Ks_ + hi * 1024 + r32 * 16; bf16x8 kf[8];
#pragma unroll
              for (int d0_ = 0; d0_ < 4; ++d0_) { kf[2 * d0_] = *(const LAS bf16x8*)(kb_ + d0_ * 2048); kf[2 * d0_ + 1] = *(const LAS bf16x8*)(kb_ + d0_ * 2048 + 512); }
              asm volatile("s_waitcnt lgkmcnt(0)" : "+v"(kf[0]), "+v"(kf[1]), "+v"(kf[2]), "+v"(kf[3]), "+v"(kf[4]), "+v"(kf[5]), "+v"(kf[6]), "+v"(kf[7]) :: "memory");
              p0 = __builtin_amdgcn_mfma_f32_32x32x16_bf16(kf[0], qr[0], negm, 0, 0, 0);
              p1 = __builtin_amdgcn_mfma_f32_32x32x16_bf16(kf[1], qr[0], negm, 0, 0, 0);
#pragma unroll
              for (int d0_ = 1; d0_ < 4; ++d0_) {
                  p0 = __builtin_amdgcn_mfma_f32_32x32x16_bf16(kf[2 * d0_], qr[d0_], p0, 0, 0, 0);
                  p1 = __builtin_amdgcn_mfma_f32_32x32x16_bf16(kf[2 * d0_ + 1], qr[d0_], p1, 0, 0, 0); }
              asm volatile("s_nop 15\n\ts_nop 7" : "+v"(p0), "+v"(p1)); }
            s16x4 vlo[8], vhi[8];
            { const LAS unsigned char* vp_ = vp0 + (t & (ATT_NS - 1)) * 8192;
#pragma unroll
              for (int i = 0; i < 8; ++i) { vlo[i] = vtr(vp_ + ((i >> 2) * 4096 + (i & 3) * 1024)); vhi[i] = vtr(vp_ + ((i >> 2) * 4096 + (i & 3) * 1024 + 512)); } }
            __builtin_amdgcn_sched_barrier(0);
            if (64 * tk + 63 > qw0 || 64 * tk < qw0 + 31 - 128) { const int kvb = 64 * tk + 4 * hi;
#pragma unroll
                for (int r = 0; r < 16; ++r) { const int dd = qi - (kvb + (r & 3) + 8 * (r >> 2)); if (dd < 0 || dd > 128) p0[r] = -INFINITY; if (dd - 32 < 0 || dd - 32 > 128) p1[r] = -INFINITY; }
            }
            const float rm = rowmax_fast(p0, p1);
            const bool need = started ? (rm > THR) : (rm > -1.0e30f);
            bool resc = false;
            if (__any(need)) {
                const float dl = need ? rm : 0.f; mhat += dl;
#pragma unroll
                for (int r = 0; r < 16; ++r) { p0[r] -= dl; p1[r] -= dl; }
#pragma unroll
                for (int r = 0; r < 16; ++r) negm[r] = -mhat;
                const float f = (need && started) ? fexp2(-dl) : 1.0f; lrun *= f; started = started || need;
                if (hi == 0) wsf[r32] = f; resc = true;
            }
#pragma unroll
            for (int r = 0; r < 16; ++r) { p0[r] = fexp2(p0[r]); p1[r] = fexp2(p1[r]); }
            if (resc) {
                asm volatile("s_waitcnt lgkmcnt(0)" ::: "memory");
#pragma unroll
                for (int g = 0; g < 4; ++g) { const f32x4 fv = *(const LAS f32x4*)(wsf + 8 * g + 4 * hi);
#pragma unroll
                    for (int k = 0; k < 4; ++k) { o[0][4 * g + k] *= fv[k]; o[1][4 * g + k] *= fv[k]; } }
            }
            u32x4 pw0, pw1, pw2, pw3;
            pw0 = (u32x4){cvt_pk_bf16(p0[0], p0[1]), cvt_pk_bf16(p0[2], p0[3]), cvt_pk_bf16(p0[4], p0[5]), cvt_pk_bf16(p0[6], p0[7])};
            pw1 = (u32x4){cvt_pk_bf16(p0[8], p0[9]), cvt_pk_bf16(p0[10], p0[11]), cvt_pk_bf16(p0[12], p0[13]), cvt_pk_bf16(p0[14], p0[15])};
            pw2 = (u32x4){cvt_pk_bf16(p1[0], p1[1]), cvt_pk_bf16(p1[2], p1[3]), cvt_pk_bf16(p1[4], p1[5]), cvt_pk_bf16(p1[6], p1[7])};
            pw3 = (u32x4){cvt_pk_bf16(p1[8], p1[9]), cvt_pk_bf16(p1[10], p1[11]), cvt_pk_bf16(p1[12], p1[13]), cvt_pk_bf16(p1[14], p1[15])};
#define DS_VF(i) (bf16x8){vlo[i][0], vlo[i][1], vlo[i][2], vlo[i][3], vhi[i][0], vhi[i][1], vhi[i][2], vhi[i][3]}
#define DS_GP(d, PW, i, P, r0) do { o[d] = __builtin_amdgcn_mfma_f32_32x32x16_bf16(__builtin_bit_cast(bf16x8, PW), DS_VF(i), o[d], 0, 0, 0); \
        ps += P[r0]; ps += P[(r0) + 1]; ps += P[(r0) + 2]; ps += P[(r0) + 3]; asm volatile("" : "+v"(ps)); __builtin_amdgcn_sched_barrier(0); } while (0)
            { float ps = 0.f; __builtin_amdgcn_sched_barrier(0);
              DS_GP(0, pw0, 0, p0, 0); DS_GP(1, pw0, 4, p0, 4); DS_GP(0, pw1, 1, p0, 8); DS_GP(1, pw1, 5, p0, 12);
              DS_GP(0, pw2, 2, p1, 0); DS_GP(1, pw2, 6, p1, 4); DS_GP(0, pw3, 3, p1, 8); DS_GP(1, pw3, 7, p1, 12);
              lrun += ps; }
#undef DS_VF
#undef DS_GP
        }
    }
    ATT_LDSBAR();
#undef DS_ISSUE
#undef DS_QDMA
#undef DS_WAITBAR
}

__device__ __forceinline__ void xattn_unit(LAS unsigned char* lds, LAS float* wsf_all, const bf16_t* Qp, const bf16_t* Kp, const bf16_t* Vp, bf16_t* Op) {
    int tid = threadIdx.x; asm volatile("" : "+v"(tid));
    const int lane = tid & 63, r32 = lane & 31, hi = lane >> 5, wid = __builtin_amdgcn_readfirstlane(tid >> 6);
    LAS float* wsf = wsf_all + wid * 64;
    const int qi = wid * 32 + r32;
#define XA_ISSUE(s_) do { const unsigned sl_ = (unsigned)(uintptr_t)lds + ((s_) & 3) * 32768; \
        if ((s_) < 4) { _Pragma("unroll") for (int i_ = 0; i_ < 4; ++i_) { const int c_ = wid + 8 * i_; \
            glds16(Kp + (long)((s_) * 64 + lane) * D + c_ * 8, (unsigned)__builtin_amdgcn_readfirstlane((int)(sl_ + c_ * 1024))); } } \
        else { _Pragma("unroll") for (int i_ = 0; i_ < 4; ++i_) { const int pi_ = wid + 8 * i_, db_ = pi_ >> 2, kg_ = pi_ & 3; \
            glds16(Vp + (long)(((s_) - 4) * 64 + 16 * kg_ + (lane >> 2)) * D + db_ * 32 + (lane & 3) * 8, (unsigned)__builtin_amdgcn_readfirstlane((int)(sl_ + pi_ * 1024))); } } } while (0)
#define XA_WAITBAR(n) do { asm volatile("s_waitcnt vmcnt(" #n ") lgkmcnt(0)" ::: "memory"); __builtin_amdgcn_s_barrier(); asm volatile("" ::: "memory"); } while (0)
    XA_ISSUE(0);
    bf16x8 qr[16];
#pragma unroll
    for (int d0 = 0; d0 < 16; ++d0) qr[d0] = *(const bf16x8*)(Qp + (long)qi * D + d0 * 16 + hi * 8);
    asm volatile("s_waitcnt vmcnt(0)" : "+v"(qr[0]), "+v"(qr[1]), "+v"(qr[2]), "+v"(qr[3]), "+v"(qr[4]), "+v"(qr[5]), "+v"(qr[6]), "+v"(qr[7]),
                 "+v"(qr[8]), "+v"(qr[9]), "+v"(qr[10]), "+v"(qr[11]), "+v"(qr[12]), "+v"(qr[13]), "+v"(qr[14]), "+v"(qr[15]) :: "memory");
    XA_ISSUE(1); XA_ISSUE(2); XA_ISSUE(3);
    __builtin_amdgcn_s_barrier(); asm volatile("" ::: "memory");
    f32x16 p[4][2];
#pragma unroll
    for (int s = 0; s < 4; ++s) {
        if (s > 0) { XA_WAITBAR(8);
                     XA_ISSUE(s + 3); }
        p[s][0] = f32x16{}; p[s][1] = f32x16{};
        qkt<16>(p[s][0], p[s][1], lds + (s & 3) * 32768, qr, r32, hi);
    }
    float a = NEG;
#pragma unroll
    for (int s = 0; s < 4; ++s)
#pragma unroll
        for (int r = 0; r < 16; ++r) a = fmaxf(a, fmaxf(p[s][0][r], p[s][1][r]));
    const float mx = swap_max(a);
    float ps = 0.f; u32x4 pw[4][4];
#pragma unroll
    for (int s = 0; s < 4; ++s) {
#pragma unroll
        for (int r = 0; r < 16; ++r) { p[s][0][r] = fexp2(p[s][0][r] - mx); p[s][1][r] = fexp2(p[s][1][r] - mx); ps += p[s][0][r] + p[s][1][r]; }
#pragma unroll
        for (int h2 = 0; h2 < 2; ++h2) {
            pw[s][2 * h2] = (u32x4){cvt_pk_bf16(p[s][h2][0], p[s][h2][1]), cvt_pk_bf16(p[s][h2][2], p[s][h2][3]), cvt_pk_bf16(p[s][h2][4], p[s][h2][5]), cvt_pk_bf16(p[s][h2][6], p[s][h2][7])};
            pw[s][2 * h2 + 1] = (u32x4){cvt_pk_bf16(p[s][h2][8], p[s][h2][9]), cvt_pk_bf16(p[s][h2][10], p[s][h2][11]), cvt_pk_bf16(p[s][h2][12], p[s][h2][13]), cvt_pk_bf16(p[s][h2][14], p[s][h2][15])}; }
    }
    const float ltot = swap_add(ps);
    f32x16 o[8];
#pragma unroll
    for (int d0 = 0; d0 < 8; ++d0) o[d0] = f32x16{};
    const unsigned vb0 = (unsigned)(uintptr_t)lds + ((lane >> 4) & 1) * 32 + (lane & 3) * 8 + (4 * hi + ((lane & 15) >> 2)) * 64;
#pragma unroll
    for (int s = 4; s < 8; ++s) {
        if (s < 6) XA_WAITBAR(8); else if (s == 6) XA_WAITBAR(4); else XA_WAITBAR(0);
        if (s == 4) XA_ISSUE(7);
        pv<8>(o, vb0 + (s & 3) * 32768, __builtin_bit_cast(bf16x8, pw[s - 4][0]), __builtin_bit_cast(bf16x8, pw[s - 4][1]), __builtin_bit_cast(bf16x8, pw[s - 4][2]), __builtin_bit_cast(bf16x8, pw[s - 4][3]));
    }
#undef XA_ISSUE
    if (hi == 0) wsf[32 + r32] = ltot;
    XA_WAITBAR(0);
#undef XA_WAITBAR
    LAS bf16_t* stg = (LAS bf16_t*)(lds + wid * 16384);
#pragma unroll
    for (int g = 0; g < 4; ++g) { const f32x4 lv = *(const LAS f32x4*)(wsf + 32 + 8 * g + 4 * hi);
#pragma unroll
        for (int k = 0; k < 4; ++k) { const int r = 4 * g + k; const float rl = frcp(lv[k]); LAS bf16_t* srow = stg + crow(r, hi) * 256 + r32;
#pragma unroll
            for (int d0 = 0; d0 < 8; ++d0) srow[d0 * 32] = (bf16_t)(cvt_pk_bf16(o[d0][r] * rl, 0.f) & 0xffffu); } }
    asm volatile("s_waitcnt lgkmcnt(0)" ::: "memory");
#pragma unroll
    for (int i = 0; i < 16; ++i) { const int row = i * 2 + (lane >> 5), ch = lane & 31; const u32x4 v = *(const LAS u32x4*)(stg + row * 256 + ch * 8); *(u32x4*)(Op + (long)(wid * 32 + row) * D + ch * 8) = v; }
    ATT_LDSBAR();
}
}

constexpr size_t MiB = 1u << 20;
constexpr size_t WS_CTL = 0, CTL_ZERO_BYTES = 1 * MiB;
constexpr size_t WS_ROPE = 1 * MiB;
constexpr size_t WS_FLOG = 3 * MiB;
constexpr size_t WS_CL = 4 * MiB;
constexpr size_t WS_LSE = 5 * MiB;
constexpr size_t WS_TOKE = 8 * MiB;
constexpr size_t WS_TOKW = WS_TOKE + 256 * 1024;
constexpr size_t WS_TOKP = WS_TOKW + 256 * 1024;
constexpr size_t WS_SLOC = 9 * MiB;
constexpr size_t WS_POW = 25 * MiB;
constexpr size_t WS_BBAR = 28 * MiB;
constexpr size_t WS_KMAT = 29 * MiB;
constexpr size_t WS_ONES = 33 * MiB, WS_ZEROS = 33 * MiB + 4096, WS_STATS = 33 * MiB + 65536;
constexpr size_t WS_XB = 34 * MiB;
constexpr size_t WS_WL = 98 * MiB;
constexpr size_t WL_WIN = 0, WL_WGLU = 13 * MiB, WL_WB = WL_WGLU + MiB / 2, WL_WOUT = WL_WB + 3 * MiB, WL_XQ = WL_WOUT + 2 * MiB, WL_XO = WL_XQ + 2 * MiB, WL_TF = WL_XO + 2 * MiB, WL_E = WL_TF + 20 * MiB;
constexpr size_t WS_FFNW = 148 * MiB;
constexpr size_t WS_UG = 214 * MiB;
constexpr size_t WS_QKV = 254 * MiB;
constexpr size_t WS_YS = 446 * MiB;
constexpr size_t WS_KBIAS = 606 * MiB;
constexpr size_t WS_ZH = 610 * MiB;
constexpr size_t WS_END = 674 * MiB;
static_assert(WL_E + 4 * MiB + MiB / 4 <= 50 * MiB, "WL map");
constexpr int CW_TMO = 0, CW_BAR = 4096, CW_CNT = 16384, CW_FILL = 16384 + 2048, CW_QUEUE = 16384 + 4096, CW_NORM = 32768;
constexpr int RING_BYTES = 131072, MISC_OFF = RING_BYTES, WSF_OFF = RING_BYTES + 512, LDS_BYTES = 147456;
constexpr int NWAVES = 8, PTR_OFF = RING_BYTES + 3072;
__device__ __forceinline__ const void* inptr(LAS unsigned char* lds, int k) { const unsigned long long v = ((volatile LAS unsigned long long*)(lds + PTR_OFF))[k];
    const unsigned lo = (unsigned)__builtin_amdgcn_readfirstlane((int)(unsigned)v), hi = (unsigned)__builtin_amdgcn_readfirstlane((int)(unsigned)(v >> 32)); return (const void*)(GAS const void*)(((unsigned long long)hi << 32) | lo); }

typedef GAS unsigned gu32;
#define RLX_AGENT __ATOMIC_RELAXED, __HIP_MEMORY_SCOPE_AGENT

#define XB_TMO      128
#define XB_XCNT(j)  (256  + 64 * (j))
#define XB_XSUB(j)  (1280 + 64 * (j))
#define XB_XGEN(j)  (2304 + 64 * (j))
#define XB_TOP      3328
#define XB_TOPGEN   3392
#define XCD_BAR_WORDS 3456
#define XB_SPIN_CAP (1u << 22)
__device__ __forceinline__ unsigned xb_ld(unsigned* p)              { return __hip_atomic_load(p, __ATOMIC_RELAXED, __HIP_MEMORY_SCOPE_AGENT); }
__device__ __forceinline__ unsigned xb_add(unsigned* p, unsigned v) { return __hip_atomic_fetch_add(p, v, __ATOMIC_RELAXED, __HIP_MEMORY_SCOPE_AGENT); }
__device__ __forceinline__ unsigned xb_xcc_id() { return (unsigned)__builtin_amdgcn_s_getreg((3 << 11) | 20) & 0xFu; }
#define XB_SPIN(cond, bar) do { unsigned _sp = 0; while (cond) { __builtin_amdgcn_s_sleep(1); \
    if ((++_sp & 255u) == 0u) { if (xb_ld(&(bar)[XB_TMO])) break; if (_sp > XB_SPIN_CAP) { atomicAdd(&(bar)[XB_TMO], 1u); break; } } } } while (0)
struct XcdBarrier { unsigned* bar; unsigned x; volatile LAS unsigned* st; };
__device__ __forceinline__ XcdBarrier xcd_barrier_post(unsigned* bar, volatile LAS unsigned* st) {
    XcdBarrier b; b.bar = bar; b.x = xb_xcc_id(); b.st = st;
    if (threadIdx.x == 0) (void)xb_add(&bar[XB_XCNT(b.x)], 1u);
    return b;
}
__device__ __forceinline__ void xcd_barrier_complete(unsigned* bar, unsigned x, unsigned& nloc, unsigned& nx) {
    const unsigned G = gridDim.x * gridDim.y * gridDim.z;
    unsigned sum, cnt, mine, sp = 0u;
    for (;;) {
        sum = 0u; cnt = 0u; mine = 0u;
#pragma unroll
        for (unsigned j = 0; j < 16; ++j) { const unsigned c = xb_ld(&bar[XB_XCNT(j)]); sum += c; cnt += (c > 0u) ? 1u : 0u; mine = (j == x) ? c : mine; }
        if (sum == G) break;
        __builtin_amdgcn_s_sleep(1);
        if ((++sp & 255u) == 0u) { if (xb_ld(&bar[XB_TMO])) break; if (sp > XB_SPIN_CAP) { atomicAdd(&bar[XB_TMO], 1u); break; } }
    }
    nloc = mine > 0u ? mine : 1u; nx = cnt > 0u ? cnt : 1u;
}
__device__ __forceinline__ void xcd_barrier(const XcdBarrier& b) {
    asm volatile("s_waitcnt vmcnt(0)" ::: "memory");
    __syncthreads();
    if (threadIdx.x == 0) {
        unsigned* bar = b.bar;
        __builtin_amdgcn_s_waitcnt(0);
        unsigned nloc = b.st[0], nx = b.st[1];
        if (nloc == 0u) { xcd_barrier_complete(bar, b.x, nloc, nx); b.st[0] = nloc; b.st[1] = nx; }
        const unsigned old = xb_add(&bar[XB_XSUB(b.x)], 1u);
        const unsigned gen = old / nloc;
        if (old + 1u == (gen + 1u) * nloc) {
            __builtin_amdgcn_fence(__ATOMIC_RELEASE, "agent");
            asm volatile("s_waitcnt vmcnt(0)" ::: "memory");
            const unsigned og = xb_add(&bar[XB_TOP], 1u);
            const unsigned tg = og / nx;
            if (og + 1u == (tg + 1u) * nx) xb_add(&bar[XB_TOPGEN], 1u);
            else XB_SPIN(xb_ld(&bar[XB_TOPGEN]) == tg, bar);
            __builtin_amdgcn_fence(__ATOMIC_ACQUIRE, "agent");
            xb_add(&bar[XB_XGEN(b.x)], 1u);
            asm volatile("s_waitcnt vmcnt(0)" ::: "memory");
        } else {
            XB_SPIN(xb_ld(&bar[XB_XGEN(b.x)]) == gen, bar);
            __builtin_amdgcn_fence(__ATOMIC_ACQUIRE, "agent");
            asm volatile("s_waitcnt vmcnt(0)" ::: "memory");
        }
    }
    __syncthreads();
}

__device__ __forceinline__ void conv_mat(int& rot, int gw, int NGW, LAS float* scr, int lane, const float* W, int K, int ldn, int nblk, int mode, bf16_t* WT, int dstrow0) {
    asm volatile("" : "+v"(lane));
    const int nitems = (K / 64) * nblk;
    int it = gw - rot; if (it < 0) it += NGW;
    rot += nitems % NGW; if (rot >= NGW) rot -= NGW;
    const int kr = lane >> 3, n4 = (lane & 7) * 4;
    f32x4 v[8];
#define CM_COL(it_) ((mode == 1 && 32 * ((it_) % nblk) >= 3584) ? 32 * ((it_) % nblk) + 8 : 32 * ((it_) % nblk))
    if (it < nitems) { const float* sp = W + (size_t)(64 * (it / nblk) + kr) * ldn + CM_COL(it) + n4;
#pragma unroll
        for (int i = 0; i < 8; ++i) v[i] = *(const f32x4*)(sp + (size_t)(8 * i) * ldn); }
    while (it < nitems) {
        const int kb = it / nblk, n0 = 32 * (it % nblk), k0 = 64 * kb;
        const int drow = (mode == 2) ? dstrow0 + 256 * (n0 >> 7) + (n0 & 127) : dstrow0 + n0;
#pragma unroll
        for (int i = 0; i < 8; ++i)
#pragma unroll
            for (int q = 0; q < 4; ++q) scr[(8 * i + kr) * 33 + n4 + q] = v[i][q];
        const int nx = it + NGW;
        if (nx < nitems) { const float* sp = W + (size_t)(64 * (nx / nblk) + kr) * ldn + CM_COL(nx) + n4;
#pragma unroll
            for (int i = 0; i < 8; ++i) v[i] = *(const f32x4*)(sp + (size_t)(8 * i) * ldn); }
        asm volatile("" ::: "memory");
        const int c = lane & 7;
#pragma unroll
        for (int j = 0; j < 4; ++j) { const int n = (lane >> 3) + 8 * j; const LAS float* sl = scr + (8 * c) * 33 + n;
            u32x4 o; o.x = cvt_pk_bf16(sl[0 * 33], sl[1 * 33]); o.y = cvt_pk_bf16(sl[2 * 33], sl[3 * 33]); o.z = cvt_pk_bf16(sl[4 * 33], sl[5 * 33]); o.w = cvt_pk_bf16(sl[6 * 33], sl[7 * 33]);
            *(u32x4*)(WT + (size_t)(drow + n) * K + k0 + 8 * c) = o; }
        asm volatile("s_waitcnt lgkmcnt(0)" ::: "memory");
        it = nx;
    }
#undef CM_COL
}
__device__ __forceinline__ void dsincos(double x, double& s, double& c) {
    const double q = __builtin_rint(x * 0.63661977236758134308);
    const double r = (x - q * 1.57079632679489655800) - q * 6.12323399573676603587e-17;
    const double r2 = r * r;
    double sp = 1.0 / 6227020800.0; sp = sp * r2 - 1.0 / 39916800.0; sp = sp * r2 + 1.0 / 362880.0; sp = sp * r2 - 1.0 / 5040.0; sp = sp * r2 + 1.0 / 120.0; sp = sp * r2 - 1.0 / 6.0; sp = sp * r2 + 1.0; sp = sp * r;
    double cp = -1.0 / 87178291200.0; cp = cp * r2 + 1.0 / 479001600.0; cp = cp * r2 - 1.0 / 3628800.0; cp = cp * r2 + 1.0 / 40320.0; cp = cp * r2 - 1.0 / 720.0; cp = cp * r2 + 1.0 / 24.0; cp = cp * r2 - 0.5; cp = cp * r2 + 1.0;
    const int qi = (int)((long long)q & 3);
    s = (qi == 0) ? sp : (qi == 1) ? cp : (qi == 2) ? -sp : -cp;
    c = (qi == 0) ? cp : (qi == 1) ? -sp : (qi == 2) ? -cp : sp;
}

template <int SRC, bool ROUTER, bool FLOG, bool WF32>
__device__ __forceinline__ void ln_pass(int gw, int NGW, int lane, unsigned short* ZH, float* OUT32, const float* xin, bf16_t* XB, float* ST, const float* gam, const float* bet, const float* gp, const float* bp,
                                        const bf16_t* Y2, const int* TOKP, const float* TOKW_in,
                                        const float* wrt, int wrt_ld, const float* brt, int* TOKE, float* TOKW, LAS unsigned* hist, float* FLOGo) {
    f32x4 g4[4], b4[4];
    if (SRC != 2) {
#pragma unroll
        for (int j = 0; j < 4; ++j) { g4[j] = *(const f32x4*)(gam + 4 * lane + 256 * j); b4[j] = *(const f32x4*)(bet + 4 * lane + 256 * j); }
    }
    f32x4 wq[16][2];
    if (ROUTER || FLOG) {
#pragma unroll
        for (int j = 0; j < 4; ++j)
#pragma unroll
            for (int k = 0; k < 4; ++k) { const float* wp = wrt + (size_t)(4 * lane + 256 * j + k) * wrt_ld; wq[4 * j + k][0] = *(const f32x4*)wp; wq[4 * j + k][1] = *(const f32x4*)(wp + 4); }
    }
    f32x4 xN[4]; u32x2 hN[4]; f32x2 stN; int p0N, p1N; float w0N, w1N; u32x2 yaC[4], ybC[4];
#define LN_LOAD1(r_) do { if (SRC == 2) { _Pragma("unroll") for (int j = 0; j < 4; ++j) xN[j] = *(const f32x4*)(xin + (size_t)(r_) * D + 4 * lane + 256 * j); } \
        else { _Pragma("unroll") for (int j = 0; j < 4; ++j) hN[j] = *(const u32x2*)(ZH + (size_t)(r_) * D + 4 * lane + 256 * j); \
            if (SRC == 1) { stN = *(const f32x2*)(ST + (size_t)(r_) * 2); p0N = TOKP[2 * (r_)]; p1N = TOKP[2 * (r_) + 1]; w0N = TOKW_in[2 * (r_)]; w1N = TOKW_in[2 * (r_) + 1]; } } } while (0)
#define LN_LOAD2() do { if (SRC == 1) { _Pragma("unroll") for (int j = 0; j < 4; ++j) { yaC[j] = *(const u32x2*)(Y2 + (size_t)p0N * D + 4 * lane + 256 * j); ybC[j] = *(const u32x2*)(Y2 + (size_t)p1N * D + 4 * lane + 256 * j); } } } while (0)
    LN_LOAD1(gw); LN_LOAD2();
    for (int row = gw; row < T; row += NGW) {
        f32x4 v[4]; u32x2 hC[4]; f32x2 stp; float w0, w1; u32x2 ya[4], yb[4];
        if (SRC == 1) { stp = stN; w0 = w0N; w1 = w1N; }
#pragma unroll
        for (int j = 0; j < 4; ++j) { if (SRC == 2) v[j] = xN[j]; else hC[j] = hN[j]; if (SRC == 1) { ya[j] = yaC[j]; yb[j] = ybC[j]; } }
        const int nrow = row + NGW < T ? row + NGW : row;
        LN_LOAD1(nrow);
        if (SRC == 2) {
            if (lane == 0) *(f32x2*)(ST + (size_t)row * 2) = (f32x2){0.f, 1.f};
        } else {
#pragma unroll
            for (int j = 0; j < 4; ++j) { const u32x2 hz = hC[j]; const f32x2 h0 = unpk_f16(hz.x), h1 = unpk_f16(hz.y); v[j] = (f32x4){h0.x, h0.y, h1.x, h1.y}; }
            if (SRC == 1) {
#pragma unroll
                for (int j = 0; j < 4; ++j) { const u32x2 a = ya[j], b = yb[j];
                    const f32x4 gq = *(const f32x4*)(gp + 4 * lane + 256 * j), bq = *(const f32x4*)(bp + 4 * lane + 256 * j);
                    const f32x4 xp = ((v[j] - stp.x) * stp.y) * gq + bq;
                    v[j] = xp * ALPHA + (f32x4){bf_lo(a.x), bf_hi(a.x), bf_lo(a.y), bf_hi(a.y)} * w0 + (f32x4){bf_lo(b.x), bf_hi(b.x), bf_lo(b.y), bf_hi(b.y)} * w1;
                    if (!WF32) { u32x2 hz; hz.x = cvt_pk_f16(v[j][0], v[j][1]); hz.y = cvt_pk_f16(v[j][2], v[j][3]); *(u32x2*)(ZH + (size_t)row * D + 4 * lane + 256 * j) = hz;
                        const f32x2 h0 = unpk_f16(hz.x), h1 = unpk_f16(hz.y); v[j] = (f32x4){h0.x, h0.y, h1.x, h1.y}; } }
            }
            float s = 0.f;
#pragma unroll
            for (int j = 0; j < 4; ++j) s += (v[j][0] + v[j][1]) + (v[j][2] + v[j][3]);
            const float mean = wave_sum(s) * (1.f / D); float s2 = 0.f;
#pragma unroll
            for (int j = 0; j < 4; ++j) { v[j] = v[j] - mean; s2 += (v[j][0] * v[j][0] + v[j][1] * v[j][1]) + (v[j][2] * v[j][2] + v[j][3] * v[j][3]); }
            const float rstd = 1.f / sqrtf(wave_sum(s2) * (1.f / D) + LN_EPS);
            if (!WF32 && lane == 0) *(f32x2*)(ST + (size_t)row * 2) = (f32x2){mean, rstd};
#pragma unroll
            for (int j = 0; j < 4; ++j) v[j] = v[j] * rstd * g4[j] + b4[j];
        }
        LN_LOAD2();
#pragma unroll
        for (int j = 0; j < 4; ++j) { if (WF32) *(f32x4*)(OUT32 + (size_t)row * D + 4 * lane + 256 * j) = v[j];
            u32x2 o; o.x = cvt_pk_bf16(v[j][0], v[j][1]); o.y = cvt_pk_bf16(v[j][2], v[j][3]); *(u32x2*)(XB + (size_t)row * D + 4 * lane + 256 * j) = o; }
        if (ROUTER || FLOG) {
            f32x4 a0 = (f32x4){0.f, 0.f, 0.f, 0.f}, a1 = a0;
#pragma unroll
            for (int j = 0; j < 4; ++j)
#pragma unroll
                for (int k = 0; k < 4; ++k) { a0 += wq[4 * j + k][0] * v[j][k]; a1 += wq[4 * j + k][1] * v[j][k]; }
            float lg[8];
#pragma unroll
            for (int k = 0; k < 4; ++k) { lg[k] = wave_sum(a0[k]); lg[4 + k] = wave_sum(a1[k]); }
            if (FLOG) { if (lane == 0) { *(f32x4*)(FLOGo + (size_t)row * 8) = (f32x4){lg[0], lg[1], lg[2], lg[3]}; *(f32x4*)(FLOGo + (size_t)row * 8 + 4) = (f32x4){lg[4], lg[5], lg[6], lg[7]}; } }
            if (ROUTER) {
#pragma unroll
                for (int k = 0; k < 8; ++k) lg[k] += brt[k];
                int i1 = 0; float v1 = lg[0];
#pragma unroll
                for (int k = 1; k < 8; ++k) if (lg[k] > v1) { v1 = lg[k]; i1 = k; }
                int i2 = -1; float v2 = -3.0e38f;
#pragma unroll
                for (int k = 0; k < 8; ++k) if (k != i1 && lg[k] > v2) { v2 = lg[k]; i2 = k; }
                const float w2 = 1.0f / (1.0f + expf(v1 - v2)), w1 = 1.0f - w2;
                if (lane == 0) { TOKE[2 * row] = i1; TOKE[2 * row + 1] = i2; TOKW[2 * row] = w1; TOKW[2 * row + 1] = w2;
                    __hip_atomic_fetch_add(hist + i1, 1u, __ATOMIC_RELAXED, __HIP_MEMORY_SCOPE_WORKGROUP); __hip_atomic_fetch_add(hist + i2, 1u, __ATOMIC_RELAXED, __HIP_MEMORY_SCOPE_WORKGROUP); }
            }
        }
    }
#undef LN_LOAD1
#undef LN_LOAD2
}

struct Args { const void* in[34]; float* out; unsigned char* ws; int ph_lo, ph_hi; };
constexpr int NPH_TOTAL = 2 + 2 * 13 + 2 * 14;

__global__ void __launch_bounds__(NWAVES * 64, 2) hybrid_fwd(Args args) {
    extern __shared__ __attribute__((aligned(16))) unsigned char lds_raw[];
    LAS unsigned char* lds = (LAS unsigned char*)lds_raw;
    volatile LAS unsigned* MISC = (volatile LAS unsigned*)(lds + MISC_OFF);
    LAS unsigned* hist = (LAS unsigned*)(lds + MISC_OFF + 64);
    LAS float* wsf_all = (LAS float*)(lds + WSF_OFF);
    const int G = gridDim.x; const int bx = blockIdx.x; const int vcu = (G % 8 == 0) ? (bx % 8) * (G / 8) + bx / 8 : bx;
    const int NGW = G * NWAVES, NGT = G * NWAVES * 64;
    unsigned char* ws = args.ws;
    unsigned* ctl = (unsigned*)(ws + WS_CTL);
    for (int u = threadIdx.x; u < (LDS_BYTES - MISC_OFF) / 4; u += NWAVES * 64) ((LAS unsigned*)(lds + MISC_OFF))[u] = 0u;
    __syncthreads();
    const int lo = args.ph_lo, hi = args.ph_hi;
    XcdBarrier bar; bar.bar = ctl + CW_BAR; bar.x = 0; bar.st = nullptr;
    if (hi - lo > 1) bar = xcd_barrier_post(ctl + CW_BAR, MISC + 8);
    int pid = 0;
#define PH_BEGIN if (pid >= lo && pid < hi) { int tid = threadIdx.x; asm volatile("" : "+v"(tid)); const int lane = tid & 63, wave = __builtin_amdgcn_readfirstlane(tid >> 6); \
        const int gw = vcu * NWAVES + wave, gt = vcu * (NWAVES * 64) + tid; LAS float* scr = (LAS float*)(lds + wave * 16384); int rot = 0; (void)rot; unsigned long long wsl_ = (unsigned long long)(uintptr_t)ws; asm volatile("" : "+s"(wsl_)); unsigned char* wsl = (unsigned char*)(GAS unsigned char*)wsl_; (void)lane; (void)gw; (void)gt; (void)scr;
#define PH_END } if (pid >= lo && pid + 1 < hi) xcd_barrier(bar); ++pid;
#define LOAD_TOFF() int toff[9]; { int acc_t = 0; _Pragma("unroll") for (int e = 0; e < 8; ++e) { toff[e] = acc_t; \
        const unsigned c = (unsigned)__builtin_amdgcn_readfirstlane((int)__hip_atomic_load(ctl + CW_CNT + (li2 * 8 + e) * 64, RLX_AGENT)); acc_t += (int)((c + 255u) >> 8); } toff[8] = acc_t; }
#define CONVERT_MIXER(LL) do { const int LL_ = (LL); \
            conv_mat(rot, gw, NGW, scr, lane, w_in + (size_t)LL_ * D * NIN, D, NIN, 208, 1, WIN_T, 0); \
            conv_mat(rot, gw, NGW, scr, lane, w_glu + (size_t)LL_ * 512 * 512, 512, 512, 16, 0, WGLU_T, 0); \
            for (int n = 0; n < 3; ++n) conv_mat(rot, gw, NGW, scr, lane, w_branch + ((size_t)LL_ * 3 + n) * 512 * D, 512, D, 32, 0, WB_T + (size_t)n * D * 512, 0); \
            conv_mat(rot, gw, NGW, scr, lane, w_mix_out + (size_t)LL_ * D * D, D, D, 32, 0, WOUT_T, 0); \
            conv_mat(rot, gw, NGW, scr, lane, w_xq + (size_t)LL_ * D * D, D, D, 32, 0, XQ_T, 0); \
            conv_mat(rot, gw, NGW, scr, lane, w_xo + (size_t)LL_ * D * D, D, D, 32, 0, XO_T, 0); \
    } while (0)
#define CONVERT_FFN(LL) do { const int LL_ = (LL); \
            if (!(LL_ & 1)) { \
                conv_mat(rot, gw, NGW, scr, lane, ffn_wg + (size_t)(LL_ >> 1) * D * DFF, D, DFF, 88, 2, FFN_GU, 0); \
                conv_mat(rot, gw, NGW, scr, lane, ffn_wu + (size_t)(LL_ >> 1) * D * DFF, D, DFF, 88, 2, FFN_GU, 128); \
                conv_mat(rot, gw, NGW, scr, lane, ffn_wd + (size_t)(LL_ >> 1) * DFF * D, DFF, D, 32, 0, FFN_D_DENSE, 0); \
            } else { \
                for (int e = 0; e < NEXP; ++e) { \
                    conv_mat(rot, gw, NGW, scr, lane, moe_wg + ((size_t)(LL_ >> 1) * NEXP + e) * D * DFFE, D, DFFE, 44, 2, FFN_GU + (size_t)e * 2 * DFFE * D, 0); \
                    conv_mat(rot, gw, NGW, scr, lane, moe_wu + ((size_t)(LL_ >> 1) * NEXP + e) * D * DFFE, D, DFFE, 44, 2, FFN_GU + (size_t)e * 2 * DFFE * D, 128); \
                    conv_mat(rot, gw, NGW, scr, lane, moe_wd + ((size_t)(LL_ >> 1) * NEXP + e) * DFFE * D, DFFE, D, 32, 0, FFN_D_MOE + (size_t)e * D * DFFE, 0); \
                } \
            } \
    } while (0)
#define SUBSYNC() do { asm volatile("s_waitcnt vmcnt(0) lgkmcnt(0)" ::: "memory"); __syncthreads(); } while (0)

    if (threadIdx.x < 34) ((LAS unsigned long long*)(lds + PTR_OFF))[threadIdx.x] = (unsigned long long)(uintptr_t)args.in[threadIdx.x];
    __syncthreads();
#define INP(k) ((const float*)inptr(lds, (k)))
#define x_in INP(0)
#define mem_in INP(1)
#define pos_in ((const int*)inptr(lds, 2))
#define w_in INP(3)
#define b_forget INP(4)
#define lam_re INP(5)
#define lam_im INP(6)
#define log_dt INP(7)
#define ssm_bre INP(8)
#define ssm_bim INP(9)
#define ssm_cre INP(10)
#define ssm_cim INP(11)
#define ssm_d INP(12)
#define w_glu INP(13)
#define w_branch INP(14)
#define w_mix_out INP(15)
#define ln_mix_g INP(16)
#define ln_mix_b INP(17)
#define w_xq INP(18)
#define w_xk INP(19)
#define w_xv INP(20)
#define w_xo INP(21)
#define ln_x_g INP(22)
#define ln_x_b INP(23)
#define ffn_wg INP(24)
#define ffn_wu INP(25)
#define ffn_wd INP(26)
#define moe_wr INP(27)
#define moe_br INP(28)
#define moe_wg INP(29)
#define moe_wu INP(30)
#define moe_wd INP(31)
#define ln_ffn_g INP(32)
#define ln_ffn_b INP(33)
    float* OUTF = args.out;
#define ZHP ((unsigned short*)(wsl + WS_ZH))
#define ROPE ((float*)(wsl + WS_ROPE))
#define FLOG ((float*)(wsl + WS_FLOG))
#define KBIAS ((bf16_t*)(wsl + WS_KBIAS))
#define LSE ((float*)(wsl + WS_LSE))
#define TOKE ((int*)(wsl + WS_TOKE))
#define TOKW ((float*)(wsl + WS_TOKW))
#define TOKP ((int*)(wsl + WS_TOKP))
#define INV16 ((unsigned short*)(wsl + WS_TOKP + 256 * 1024))
#define SLOC ((float*)(wsl + WS_SLOC))
#define POW ((f32x2*)(wsl + WS_POW))
#define BBAR ((f32x2*)(wsl + WS_BBAR))
#define KMAT ((float*)(wsl + WS_KMAT))
#define XB ((bf16_t*)(wsl + WS_XB))
#define STATS ((float*)(wsl + WS_STATS))
#define ONESV ((const float*)(wsl + WS_ONES))
#define ZEROSV ((const float*)(wsl + WS_ZEROS))
#define XKV ((bf16_t*)OUTF)
#define WIN_T ((bf16_t*)(wsl + WS_WL + WL_WIN))
#define WGLU_T ((bf16_t*)(wsl + WS_WL + WL_WGLU))
#define WB_T ((bf16_t*)(wsl + WS_WL + WL_WB))
#define WOUT_T ((bf16_t*)(wsl + WS_WL + WL_WOUT))
#define XQ_T ((bf16_t*)(wsl + WS_WL + WL_XQ))
#define XO_T ((bf16_t*)(wsl + WS_WL + WL_XO))
#define TF ((bf16_t*)(wsl + WS_WL + WL_TF))
#define ETAB ((bf16_t*)(wsl + WS_WL + WL_E))
#define FFN_GU ((bf16_t*)(wsl + WS_FFNW))
#define FFN_D_DENSE ((bf16_t*)(wsl + WS_FFNW + 11 * MiB))
#define FFN_D_MOE ((bf16_t*)(wsl + WS_FFNW + 44 * MiB))
#define UG ((bf16_t*)(wsl + WS_UG))
#define YSSM2 ((bf16_t*)(wsl + WS_UG))
#define QKV ((bf16_t*)(wsl + WS_QKV))
#define GATES ((bf16_t*)(wsl + WS_QKV))
#define XQ ((bf16_t*)(wsl + WS_QKV))
#define HBUF ((bf16_t*)(wsl + WS_QKV))
#define WKV_T ((bf16_t*)(wsl + WS_QKV))
#define MEMB ((bf16_t*)(wsl + WS_QKV + 16 * MiB))
#define YSSM ((bf16_t*)(wsl + WS_YS))
#define O1 ((bf16_t*)(wsl + WS_YS + 32 * MiB))
#define O2 ((bf16_t*)(wsl + WS_YS + 64 * MiB))
#define O3 ((bf16_t*)(wsl + WS_YS + 96 * MiB))
#define YFOX ((bf16_t*)(wsl + WS_YS + 128 * MiB))
#define MERGED O2
#define XG ((bf16_t*)(wsl + WS_YS))
#define Y2 ((bf16_t*)(wsl + WS_YS))

    PH_BEGIN
        ln_pass<2, false, true, false>(gw, NGW, lane, ZHP, OUTF, x_in, XB, STATS, nullptr, nullptr, nullptr, nullptr, nullptr, nullptr, nullptr, w_in + 3584, NIN, nullptr, nullptr, nullptr, hist, FLOG);
        for (int it = gt; it < 1024; it += NGT) { ((float*)(wsl + WS_ONES))[it] = 1.0f; ((float*)(wsl + WS_ZEROS))[it] = 0.0f; }
        for (int it = gt; it < T * 8; it += NGT) { const int row = it >> 3, j = it & 7;
            const float inv = (float)exp(-(double)j * 0.125 * 13.122363377404328);
            const float ang = (float)pos_in[row] * inv; double s, c; dsincos((double)ang, s, c);
            ROPE[(size_t)row * 16 + j] = (float)c; ROPE[(size_t)row * 16 + 8 + j] = (float)s; }
        for (int i2 = gt; i2 < DEPTH * 32 * 64 * 33; i2 += NGT) { const int it = i2 / 33, k = i2 - it * 33, g = (it >> 6) & 31, l = it >> 11;
            const double lr = lam_re[it], li = lam_im[it], dt = exp((double)log_dt[l * 32 + g]);
            const double mg = exp(k * dt * lr); double s, c; dsincos(k * dt * li, s, c); POW[(size_t)it * 33 + k] = (f32x2){(float)(mg * c), (float)(mg * s)}; }
        for (int i2 = gt; i2 < DEPTH * 32 * 64 * 16; i2 += NGT) { const int it = i2 >> 4, cc = i2 & 15, g = (it >> 6) & 31, l = it >> 11;
            const double lr = lam_re[it], li = lam_im[it], dt = exp((double)log_dt[l * 32 + g]);
            const double mg = exp(dt * lr); double s, c; dsincos(dt * li, s, c);
            const double nr = mg * c - 1.0, ni = mg * s, den = lr * lr + li * li, qr = (nr * lr + ni * li) / den, qi = (ni * lr - nr * li) / den;
            const double br = ssm_bre[(size_t)it * 16 + cc], bi = ssm_bim[(size_t)it * 16 + cc];
            BBAR[(size_t)it * 16 + cc] = (f32x2){(float)(qr * br - qi * bi), (float)(qr * bi + qi * br)}; }
        for (int it = gt; it < NB * NMEM * D / 4; it += NGT) { const f32x4 v = *(const f32x4*)(mem_in + (size_t)it * 4); u32x2 o; o.x = cvt_pk_bf16(v[0], v[1]); o.y = cvt_pk_bf16(v[2], v[3]); *(u32x2*)(MEMB + (size_t)it * 4) = o; }
        for (int l = 0; l < DEPTH; ++l) { conv_mat(rot, gw, NGW, scr, lane, w_xk + (size_t)l * D * D, D, D, 32, 0, WKV_T + (size_t)(2 * l) * D * D, 0);
                                          conv_mat(rot, gw, NGW, scr, lane, w_xv + (size_t)l * D * D, D, D, 32, 0, WKV_T + (size_t)(2 * l + 1) * D * D, 0); }
        CONVERT_MIXER(0); CONVERT_FFN(0);
    PH_END
    PH_BEGIN
        { SchedBatched S{(const char*)MEMB, (const char*)WKV_T, 0, (size_t)D * D * 2, D, D, 8, 4, 8, G, bx};
          EpiScale E{XKV, D, 1.0f, (size_t)NB * NMEM * D};
          pg8::gemm_phase(lds, D, D, D / 64, S, E); }
        for (int i2 = gt; i2 < DEPTH * 32 * 32 * 16 * 2; i2 += NGT) { const int it = i2 >> 1, hf = i2 & 1, co = it & 15, lag = (it >> 4) & 31, lg = it >> 9;
            float acc[16];
#pragma unroll
            for (int c = 0; c < 16; ++c) acc[c] = 0.f;
            for (int p = 32 * hf; p < 32 * hf + 32; ++p) { const f32x2 pw = POW[((size_t)lg * 64 + p) * 33 + lag]; const float cr = ssm_cre[((size_t)lg * 16 + co) * 64 + p], ci = ssm_cim[((size_t)lg * 16 + co) * 64 + p];
                const float zr = cr * pw.x - ci * pw.y, zi = cr * pw.y + ci * pw.x; const f32x2* bb = BBAR + ((size_t)lg * 64 + p) * 16;
#pragma unroll
                for (int c = 0; c < 16; ++c) acc[c] += zr * bb[c].x - zi * bb[c].y; }
#pragma unroll
            for (int c = 0; c < 16; ++c) acc[c] += __shfl_xor(acc[c], 1);
            if (hf == 0) {
#pragma unroll
                for (int c = 0; c < 16; ++c) KMAT[(((size_t)lg * 32 + lag) * 16 + co) * 16 + c] = acc[c]; } }
    PH_END

    for (int l = 0; l < DEPTH; ++l) {
        const bool moe = (l & 1) != 0; const int li2 = l >> 1;
        PH_BEGIN
            for (int step = 0; step < 2; ++step) { if ((step == 0) != ((vcu & 1) != 0)) {
            { SchedBatched S{(const char*)XB, (const char*)WIN_T, 0, 0, D, D, 128, 14, 1, G, bx};
              EpiInProj E{UG, QKV, ROPE, ctl + CW_NORM + l * 256};
              pg8::gemm_phase(lds, D, D, D / 64, S, E); }
            } else {
            for (int it = gt; it < 32 * 512 * 80; it += NGT) { const int k8 = it % 80, n = (it / 80) & 511, g = it / (80 * 512); const int k0 = 8 * k8, to = n >> 4, co = n & 15; const int lg = l * 32 + g;
                f32x4 a = (f32x4){0.f, 0.f, 0.f, 0.f}, b = a;
                if (k0 < 512) { const int ti = k0 >> 4, ci0 = k0 & 15, lag = to - ti;
                    if (lag >= 0) { const float* kp = KMAT + (((size_t)lg * 32 + lag) * 16 + co) * 16 + ci0; a = *(const f32x4*)kp; b = *(const f32x4*)(kp + 4); } }
                else { const int j0 = k0 - 512, part = j0 >> 6, p0 = j0 & 63; float v[8];
#pragma unroll
                    for (int q = 0; q < 8; ++q) { const int p = p0 + q; const f32x2 pw = POW[((size_t)lg * 64 + p) * 33 + to + 1]; const float cr = ssm_cre[((size_t)lg * 16 + co) * 64 + p], ci = ssm_cim[((size_t)lg * 16 + co) * 64 + p];
                        v[q] = part == 0 ? (cr * pw.x - ci * pw.y) : -(cr * pw.y + ci * pw.x); }
                    a = (f32x4){v[0], v[1], v[2], v[3]}; b = (f32x4){v[4], v[5], v[6], v[7]}; }
                *(u32x4*)(TF + ((size_t)g * 512 + n) * 640 + k0) = pack8(a, b); }
            for (int it = gt; it < 32 * 128 * 64; it += NGT) { const int k8 = it & 63, rowi = (it >> 6) & 127, g = it >> 13; const int k0 = 8 * k8, ti = k0 >> 4, ci0 = k0 & 15, part = rowi >> 6, p = rowi & 63; const int lg = l * 32 + g;
                const f32x2 pw = POW[((size_t)lg * 64 + p) * 33 + 31 - ti]; const f32x2* bb = BBAR + ((size_t)lg * 64 + p) * 16 + ci0; float v[8];
#pragma unroll
                for (int q = 0; q < 8; ++q) v[q] = part == 0 ? (pw.x * bb[q].x - pw.y * bb[q].y) : (pw.x * bb[q].y + pw.y * bb[q].x);
                *(u32x4*)(ETAB + ((size_t)g * 128 + rowi) * 512 + k0) = pack8((f32x4){v[0], v[1], v[2], v[3]}, (f32x4){v[4], v[5], v[6], v[7]}); }
            } SUBSYNC(); }
        PH_END
        PH_BEGIN
            auto fox_pro = [&](const int b, const int h) {
                    const float bf = b_forget[l * 8 + h]; const int p0 = wave * 512 + lane * 8; float ls8[8]; float run = 0.f;
#pragma unroll
                    for (int q = 0; q < 8; ++q) { const float z = FLOG[((size_t)b * SEQ + p0 + q) * 8 + h] + bf; run += fminf(z, 0.f) - 0.6931471805599453f * __builtin_amdgcn_logf(1.0f + fexp2(-fabsf(z) * LOG2E)); ls8[q] = run; }
                    float incl = run;
#pragma unroll
                    for (int o = 1; o < 64; o <<= 1) { const float t = __shfl_up(incl, o); if (lane >= o) incl += t; }
                    LAS float* wtot = (LAS float*)(lds + 65536); LAS float* betaL = (LAS float*)lds;
                    if (lane == 63) wtot[wave] = incl;
                    const unsigned* nr_ = ctl + CW_NORM + l * 256 + (b * 8 + h) * 4;
                    float qm = __uint_as_float(__hip_atomic_load(nr_, RLX_AGENT)) + __uint_as_float(__hip_atomic_load(nr_ + 1, RLX_AGENT));
                    float km = __uint_as_float(__hip_atomic_load(nr_ + 2, RLX_AGENT)) + __uint_as_float(__hip_atomic_load(nr_ + 3, RLX_AGENT));
                    SUBSYNC();
                    float base = incl - run;
                    for (int w = 0; w < wave; ++w) base += wtot[w];
#pragma unroll
                    for (int q = 0; q < 8; ++q) { const float beta = -(base + ls8[q]) * LOG2E;
                        const unsigned b1 = cvt_pk_bf16(beta, 0.f) & 0xffffu; const float r1 = beta - bf_lo(b1); const unsigned b2 = cvt_pk_bf16(r1, 0.f) & 0xffffu; const float r2 = r1 - bf_lo(b2); const unsigned b3 = cvt_pk_bf16(r2, 0.f) & 0xffffu;
                        *(u32x4*)(KBIAS + (((size_t)b * SEQ + p0 + q) * 8 + h) * 8) = (u32x4){b1 | (b2 << 16), b3 | 0x3F800000u, 0x3F803F80u, 0u}; betaL[p0 + q] = beta; }
                    SUBSYNC();
                    { const float need_d = 2.0f * sqrtf(qm * km) + 36.0f;
#pragma unroll
                      for (int jj = 0; jj < 2; ++jj) { const int j = 2 * wave + jj; const bool cnd = (lane < 4 * j) && (betaL[256 * j] - betaL[64 * lane + 63] >= need_d);
                          const unsigned long long mk = __ballot(cnd); if (lane == 0) MISC[32 + j] = (unsigned)__popcll(mk); } }
                    SUBSYNC();
            };
            int prev_bh = -1;
            if (vcu < 1024) { const int bh0 = (vcu & 255) >> 2; fox_pro(bh0 >> 3, bh0 & 7); prev_bh = bh0; }
            for (int c0 = vcu; c0 < 256; c0 += G) { const int pq = c0 >> 1, g = pq >> 2, pm = pq & 3, pn = c0 & 1; const int lg = l * 32 + g;
                const char* Ag = (const char*)(UG + ((size_t)g * 1024 + pm * 256) * 640);
                { SchedOne S; S.u.A = Ag; S.u.B = (const char*)(ETAB + (size_t)g * 128 * 512); S.u.pm = pm; S.u.pn = 0; S.u.aux = g;
                  EpiS1 E{SLOC};
                  pg8::gemm_phase(lds, 640, 512, 512 / 64, S, E); }
                SUBSYNC();
                if (wave < 2) { const int b = 2 * pm + wave;
                    const f32x2 a = POW[((size_t)lg * 64 + lane) * 33 + 32]; float sr = 0.f, si = 0.f;
                    float lr[16], lim[16];
#pragma unroll
                    for (int q = 0; q < 16; ++q) { const float* sp = SLOC + ((size_t)g * 1024 + b * 128 + q) * 128; lr[q] = sp[lane]; lim[q] = sp[64 + lane]; }
                    for (int j0 = 0; j0 < 128; j0 += 16) { float nlr[16], nlim[16]; const int jn = j0 + 16 < 128 ? j0 + 16 : j0;
#pragma unroll
                        for (int q = 0; q < 16; ++q) { const float* sp = SLOC + ((size_t)g * 1024 + b * 128 + jn + q) * 128; nlr[q] = sp[lane]; nlim[q] = sp[64 + lane]; }
#pragma unroll
                        for (int q = 0; q < 16; ++q) { bf16_t* up = UG + ((size_t)g * 1024 + b * 128 + j0 + q) * 640 + 512;
                            up[lane] = (bf16_t)(cvt_pk_bf16(sr, 0.f) & 0xffffu); up[64 + lane] = (bf16_t)(cvt_pk_bf16(si, 0.f) & 0xffffu);
                            const float nr = a.x * sr - a.y * si + lr[q], ni = a.x * si + a.y * sr + lim[q]; sr = nr; si = ni; }
#pragma unroll
                        for (int q = 0; q < 16; ++q) { lr[q] = nlr[q]; lim[q] = nlim[q]; } } }
                SUBSYNC();
                { SchedOne S; S.u.A = Ag; S.u.B = (const char*)(TF + ((size_t)g * 512 + pn * 256) * 640); S.u.pm = pm; S.u.pn = pn; S.u.aux = g;
                  EpiS3 E{UG, ssm_d + l * 512, YSSM};
                  pg8::gemm_phase(lds, 640, 640, 640 / 64, S, E); }
            }
            {
              for (int k = vcu; k < 1024; k += G) { const int v8 = k & 255, i = k >> 8, bh = v8 >> 2, s = v8 & 3, b = bh >> 3, h = bh & 7; const int qb = (i == 0) ? s : (i == 1) ? 7 - s : (i == 2) ? 8 + s : 15 - s;
                if (bh != prev_bh) { prev_bh = bh; fox_pro(b, h); }
                const int tlo_u = (int)MISC[32 + qb];
                const size_t row0 = (size_t)b * SEQ;
                att::fox_unit(lds, wsf_all, QKV + row0 * NQKV + 1536 + h * 64, QKV + row0 * NQKV + 2048 + h * 64, QKV + row0 * NQKV + 2560 + h * 64, (long)NQKV, qb * 256, tlo_u, (qb * 256 + 256) >> 6,
                                    KBIAS + ((size_t)b * SEQ * 8 + h) * 8, YFOX + row0 * 512 + h * 64, 512); } }
            { unsigned* qctr = ctl + CW_QUEUE + l * 64; unsigned kn = 0u;
              if (tid == 0) MISC[48] = __hip_atomic_fetch_add(qctr, 1u, RLX_AGENT);
              SUBSYNC();
              int k = (int)MISC[48];
              while (k < 960) {
                if (tid == 0) kn = __hip_atomic_fetch_add(qctr, 1u, RLX_AGENT);
                {
                  if (k < 256) { const int bh = k >> 2, j = k & 3, b = bh >> 3, h = bh & 7; const size_t row0 = (size_t)b * SEQ;
                      att::dil_sweep<false>(lds, wsf_all, QKV + row0 * NQKV + h * 64, QKV + row0 * NQKV + 512 + h * 64, QKV + row0 * NQKV + 1024 + h * 64, (long)NQKV, 4 * j, 4,
                                            O1 + row0 * 512 + h * 64, 512L, LSE + row0 * 8 + h, 8L, 0L, 0L, 0L); }
                  else if (k < 512) { const int bh = (k - 256) >> 2, j = k & 3, b = bh >> 3, h = bh & 7; const size_t row0 = (size_t)b * SEQ + j;
                      att::dil_sweep<false>(lds, wsf_all, QKV + row0 * NQKV + h * 64, QKV + row0 * NQKV + 512 + h * 64, QKV + row0 * NQKV + 1024 + h * 64, 4L * NQKV, 0, 4,
                                            O2 + row0 * 512 + h * 64, 4L * 512, LSE + (size_t)T * 8 + row0 * 8 + h, 4L * 8, 0L, 0L, 0L); }
                  else { int bh, b0, nb; if (k < 704) { bh = (k - 512) / 3; b0 = 4 * ((k - 512) % 3); nb = 4; } else { bh = (k - 704) >> 2; b0 = 12 + ((k - 704) & 3); nb = 1; }
                      const int b = bh >> 3, h = bh & 7; const size_t row0 = (size_t)b * SEQ;
                      att::dil_sweep<true>(lds, wsf_all, QKV + row0 * NQKV + h * 64, QKV + row0 * NQKV + 512 + h * 64, QKV + row0 * NQKV + 1024 + h * 64, 16L * NQKV, b0, nb,
                                           O3 + row0 * 512 + h * 64, 16L * 512, LSE + (size_t)2 * T * 8 + row0 * 8 + h, 16L * 8, (long)NQKV, 512L, 8L); } }
                if (tid == 0) MISC[48] = kn;
                ATT_LDSBAR();
                k = (int)MISC[48];
              } }
        PH_END
        PH_BEGIN
            for (int step = 0; step < 2; ++step) { if ((step == 0) != ((vcu & 1) != 0)) {
            { SchedBatched S{(const char*)XB, (const char*)(WIN_T + (size_t)3584 * D), 0, 0, D, D, 128, 12, 1, G, bx};
              EpiGates E{GATES};
              pg8::gemm_phase(lds, D, D, D / 64, S, E); }
            } else {
            { SchedBatched S{(const char*)YSSM, (const char*)WGLU_T, 0, 0, 512, 512, 128, 2, 1, G, bx};
              EpiGlu E{YSSM, YSSM2};
              pg8::gemm_phase(lds, 512, 512, 512 / 64, S, E); }
            { const int h = lane >> 3; float l0n, l1n, l2n; u32x4 q1n, q2n, q3n;
#define MIX_LOAD(r_) do { const size_t off_ = (size_t)(r_) * 512 + lane * 8; l0n = LSE[(size_t)(r_) * 8 + h]; l1n = LSE[(size_t)T * 8 + (size_t)(r_) * 8 + h]; l2n = LSE[(size_t)2 * T * 8 + (size_t)(r_) * 8 + h]; \
        q1n = *(const u32x4*)(O1 + off_); q2n = *(const u32x4*)(O2 + off_); q3n = *(const u32x4*)(O3 + off_); } while (0)
              MIX_LOAD(gw);
              for (int row = gw; row < T; row += NGW) { const size_t off = (size_t)row * 512 + lane * 8;
                const float l0 = l0n, l1 = l1n, l2 = l2n; const u32x4 q1 = q1n, q2 = q2n, q3 = q3n;
                const int nrow = row + NGW < T ? row + NGW : row; MIX_LOAD(nrow);
                const float mx = fmaxf(l0, fmaxf(l1, l2)); float e0 = fexp2(l0 - mx), e1 = fexp2(l1 - mx), e2 = fexp2(l2 - mx); const float rs = frcp(e0 + e1 + e2); e0 *= rs; e1 *= rs; e2 *= rs;
                f32x4 a0, b0, a1, b1, a2, b2; unpack8(q1, a0, b0); unpack8(q2, a1, b1); unpack8(q3, a2, b2);
                *(u32x4*)(O1 + off) = pack8(a0 * e0 + a1 * e1 + a2 * e2, b0 * e0 + b1 * e1 + b2 * e2); }
#undef MIX_LOAD
            }
            } SUBSYNC(); }
        PH_END
        PH_BEGIN
            { SchedMerge S{(const char*)YSSM2, (const char*)O1, (const char*)YFOX, (const char*)WB_T, G, bx};
              EpiMerge E{GATES, MERGED};
              pg8::gemm_phase(lds, 512, 512, 512 / 64, S, E); }
        PH_END
        PH_BEGIN
            { SchedBatched S{(const char*)MERGED, (const char*)WOUT_T, 0, 0, D, D, 128, 4, 1, G, bx};
              if (l == 0) { EpiResT<true> E{ZHP, x_in, STATS, ONESV, ZEROSV}; pg8::gemm_phase(lds, D, D, D / 64, S, E); }
              else { EpiResT<false> E{ZHP, nullptr, STATS, ln_ffn_g + (l - 1) * D, ln_ffn_b + (l - 1) * D}; pg8::gemm_phase(lds, D, D, D / 64, S, E); } }
        PH_END
        PH_BEGIN
            ln_pass<0, false, false, false>(gw, NGW, lane, ZHP, OUTF, nullptr, XB, STATS, ln_mix_g + l * D, ln_mix_b + l * D, nullptr, nullptr, nullptr, nullptr, nullptr, nullptr, 0, nullptr, nullptr, nullptr, hist, nullptr);
        PH_END
        PH_BEGIN
            { SchedBatched S{(const char*)XB, (const char*)XQ_T, 0, 0, D, D, 128, 4, 1, G, bx};
              EpiScale E{XQ, D, C2_256, 0};
              pg8::gemm_phase(lds, D, D, D / 64, S, E); }
        PH_END
        PH_BEGIN
            for (int k = vcu; k < 512; k += G) { const int b = k >> 6, h = (k >> 4) & 3, qb = k & 15; const size_t qrow = (size_t)b * SEQ + qb * 256;
                const bf16_t* Kx = XKV + (size_t)(2 * l) * NB * NMEM * D + (size_t)b * NMEM * D + h * 256; const bf16_t* Vx = Kx + (size_t)NB * NMEM * D;
                att::xattn_unit(lds, wsf_all, XQ + qrow * D + h * 256, Kx, Vx, XQ + qrow * D + h * 256); }
        PH_END
        PH_BEGIN
            { SchedBatched S{(const char*)XQ, (const char*)XO_T, 0, 0, D, D, 128, 4, 1, G, bx};
              EpiResT<false> E{ZHP, nullptr, STATS, ln_mix_g + l * D, ln_mix_b + l * D};
              pg8::gemm_phase(lds, D, D, D / 64, S, E); }
        PH_END
        PH_BEGIN
            if (!moe) ln_pass<0, false, false, false>(gw, NGW, lane, ZHP, OUTF, nullptr, XB, STATS, ln_x_g + l * D, ln_x_b + l * D, nullptr, nullptr, nullptr, nullptr, nullptr, nullptr, 0, nullptr, nullptr, nullptr, hist, nullptr);
            else {
                ln_pass<0, true, false, false>(gw, NGW, lane, ZHP, OUTF, nullptr, XB, STATS, ln_x_g + l * D, ln_x_b + l * D, nullptr, nullptr, nullptr, nullptr, nullptr, moe_wr + (size_t)li2 * D * NEXP, NEXP, moe_br + li2 * NEXP, TOKE, TOKW, hist, nullptr);
                SUBSYNC();
                if (tid < NEXP) { const unsigned c = hist[tid]; if (c) __hip_atomic_fetch_add(ctl + CW_CNT + (li2 * 8 + tid) * 64, c, RLX_AGENT); hist[tid] = 0u; }
                { int stp_ = NGT; asm volatile("" : "+s"(stp_));
                  unsigned z_ = 0u; asm volatile("" : "+v"(z_));
                  for (int it = gt; it < 264 * 256 / 2; it += stp_) ((unsigned*)INV16)[it] = z_; }
            }
        PH_END
        if (!moe) {
            PH_BEGIN
                for (int step = 0; step < 2; ++step) { if ((step == 0) != ((vcu & 1) != 0)) {
                { SchedBatched S{(const char*)XB, (const char*)FFN_GU, 0, 0, D, D, 128, 22, 1, G, bx};
                  EpiSwiglu E{HBUF, DFF};
                  pg8::gemm_phase(lds, D, D, D / 64, S, E); }
                } else { if (l + 1 < DEPTH) CONVERT_MIXER(l + 1); } SUBSYNC(); }
            PH_END
            PH_BEGIN
                { SchedBatched S{(const char*)HBUF, (const char*)FFN_D_DENSE, 0, 0, DFF, DFF, 128, 4, 1, G, bx};
                  EpiResT<false> E{ZHP, nullptr, STATS, ln_x_g + l * D, ln_x_b + l * D};
                  pg8::gemm_phase(lds, DFF, DFF, DFF / 64, S, E); }
            PH_END
            PH_BEGIN
                if (l + 1 < DEPTH) ln_pass<0, false, true, false>(gw, NGW, lane, ZHP, OUTF, nullptr, XB, STATS, ln_ffn_g + l * D, ln_ffn_b + l * D, nullptr, nullptr, nullptr, nullptr, nullptr, w_in + (size_t)(l + 1) * D * NIN + 3584, NIN, nullptr, nullptr, nullptr, hist, FLOG);
                else ln_pass<0, false, false, true>(gw, NGW, lane, ZHP, OUTF, nullptr, XB, STATS, ln_ffn_g + l * D, ln_ffn_b + l * D, nullptr, nullptr, nullptr, nullptr, nullptr, nullptr, 0, nullptr, nullptr, nullptr, hist, nullptr);
                if (l + 1 < DEPTH) { SUBSYNC(); { int tq_ = threadIdx.x; asm volatile("" : "+v"(tq_)); const int lane = tq_ & 63; CONVERT_FFN(l + 1); } }
            PH_END
        } else {
            PH_BEGIN
                LOAD_TOFF();
                for (int t0 = gw * 64; t0 < T; t0 += NGW * 64) { const int t = t0 + lane; const int e0 = TOKE[2 * t], e1 = TOKE[2 * t + 1];
                    int r0 = 0, r1 = 0, tb0 = 0, tb1 = 0; unsigned cme = 0u; const unsigned long long lt = (1ull << lane) - 1ull;
#pragma unroll
                    for (int e = 0; e < 8; ++e) { const unsigned long long m0 = __ballot(e0 == e), m1 = __ballot(e1 == e); const int n0 = __popcll(m0), n1 = __popcll(m1);
                        if (lane == e) cme = (unsigned)(n0 + n1);
                        if (e0 == e) { r0 = __popcll(m0 & lt); tb0 = toff[e] * 256; }
                        if (e1 == e) { r1 = n0 + __popcll(m1 & lt); tb1 = toff[e] * 256; } }
                    unsigned base = 0u; if (lane < 8 && cme) base = __hip_atomic_fetch_add(ctl + CW_FILL + (li2 * 8 + lane) * 64, cme, RLX_AGENT);
                    const int pos0 = tb0 + (int)__shfl(base, e0) + r0, pos1 = tb1 + (int)__shfl(base, e1) + r1;
                    TOKP[2 * t] = pos0; TOKP[2 * t + 1] = pos1; INV16[pos0] = (unsigned short)t; INV16[pos1] = (unsigned short)t; }
            PH_END
            PH_BEGIN
                for (int step = 0; step < 2; ++step) { if ((step == 0) != ((vcu & 1) != 0)) {
                LOAD_TOFF();
                { LAS unsigned short* linv = (LAS unsigned short*)(lds + 135168);
                  { int tq = tid; asm volatile("" : "+v"(tq));
#pragma unroll 1
                    for (int q = tq; q < 12 * 256; q += NWAVES * 64) { const int i = q >> 8; const int L = i * G + bx; if (L < toff[8] * 11) linv[q] = INV16[(L / 11) * 256 + (q & 255)]; } }
                  SUBSYNC(); }
                { SchedMoeG S; S.Abase = (const char*)XB; S.linv = (const LAS unsigned short*)(lds + 135168); S.Bbase = (const char*)FFN_GU; S.strideB = (size_t)2 * DFFE * D * 2; S.lda = D; S.ldb = D; S.G = G; S.c = bx;
#pragma unroll
                  for (int e = 0; e < 9; ++e) S.toff[e] = toff[e];
                  EpiSwiglu E{HBUF, DFFE};
                  pg8::gemm_phase(lds, D, D, D / 64, S, E); }
                } else { if (l + 1 < DEPTH) CONVERT_MIXER(l + 1); } SUBSYNC(); }
            PH_END
            PH_BEGIN
                LOAD_TOFF();
                { SchedMoe S; S.Abase = (const char*)HBUF; S.Bbase = (const char*)FFN_D_MOE; S.strideB = (size_t)D * DFFE * 2; S.lda = DFFE; S.ldb = DFFE; S.nN = 4; S.G = G; S.c = bx;
#pragma unroll
                  for (int e = 0; e < 9; ++e) S.toff[e] = toff[e];
                  EpiScale E{Y2, D, 1.0f, 0};
                  pg8::gemm_phase(lds, DFFE, DFFE, DFFE / 64, S, E); }
            PH_END
            PH_BEGIN
                if (l + 1 < DEPTH) ln_pass<1, false, true, false>(gw, NGW, lane, ZHP, OUTF, nullptr, XB, STATS, ln_ffn_g + l * D, ln_ffn_b + l * D, ln_x_g + l * D, ln_x_b + l * D, Y2, TOKP, TOKW, w_in + (size_t)(l + 1) * D * NIN + 3584, NIN, nullptr, nullptr, nullptr, hist, FLOG);
                else ln_pass<1, false, false, true>(gw, NGW, lane, ZHP, OUTF, nullptr, XB, STATS, ln_ffn_g + l * D, ln_ffn_b + l * D, ln_x_g + l * D, ln_x_b + l * D, Y2, TOKP, TOKW, nullptr, 0, nullptr, nullptr, nullptr, hist, nullptr);
                if (l + 1 < DEPTH) { SUBSYNC(); { int tq_ = threadIdx.x; asm volatile("" : "+v"(tq_)); const int lane = tq_ & 63; CONVERT_FFN(l + 1); } }
            PH_END
        }
    }
}

#ifndef SPLIT_LAUNCH
#define SPLIT_LAUNCH 0
#endif
extern "C" void kernel_launch(void* const* d_in, const int* in_sizes, int n_in, void* d_out, int out_size, void* d_ws, size_t ws_size, hipStream_t stream) {
    static int grid = 0;
    if (grid == 0) {
        if (n_in != 34 || out_size != T * D || ws_size < WS_END) { fprintf(stderr, "kernel_launch: unexpected shapes (n_in %d out %d ws %zu)\n", n_in, out_size, ws_size); grid = -1; return; }
        int dev = 0, cus = 0;
        if (hipGetDevice(&dev) != hipSuccess || hipDeviceGetAttribute(&cus, hipDeviceAttributeMultiprocessorCount, dev) != hipSuccess) { grid = -1; return; }
        if (hipFuncSetAttribute((const void*)hybrid_fwd, hipFuncAttributeMaxDynamicSharedMemorySize, LDS_BYTES) != hipSuccess) { grid = -1; return; }
        int per_cu = 0;
        if (hipOccupancyMaxActiveBlocksPerMultiprocessor(&per_cu, (const void*)hybrid_fwd, NWAVES * 64, LDS_BYTES) != hipSuccess || per_cu < 1) { fprintf(stderr, "kernel_launch: occupancy query says %d\n", per_cu); }
        (void)hipGetLastError();
        grid = cus;
    }
    if (grid < 0) return;
    if (hipMemsetAsync((char*)d_ws + WS_CTL, 0, CTL_ZERO_BYTES, stream) != hipSuccess) return;
    Args a{};
    for (int i = 0; i < 34; ++i) a.in[i] = d_in[i];
    a.out = (float*)d_out; a.ws = (unsigned char*)d_ws;
#if SPLIT_LAUNCH
    for (int ph = 0; ph < NPH_TOTAL; ++ph) { a.ph_lo = ph; a.ph_hi = ph + 1; hipLaunchKernelGGL(hybrid_fwd, dim3(grid), dim3(NWAVES * 64), LDS_BYTES, stream, a); }
#else
    a.ph_lo = 0; a.ph_hi = NPH_TOTAL;
    hipLaunchKernelGGL(hybrid_fwd, dim3(grid), dim3(NWAVES * 64), LDS_BYTES, stream, a);
#endif
}
```

```cpp
#include <hip/hip_runtime.h>
#include <cstdio>
#include <cstdint>

#define GAS __attribute__((address_space(1)))
#define LAS __attribute__((address_space(3)))
typedef unsigned short bf16_t;
typedef short bf16x8 __attribute__((ext_vector_type(8)));
typedef short s16x4 __attribute__((ext_vector_type(4)));
typedef float f32x2 __attribute__((ext_vector_type(2)));
typedef float f32x4 __attribute__((ext_vector_type(4)));
typedef float f32x16 __attribute__((ext_vector_type(16)));
typedef unsigned u32x2 __attribute__((ext_vector_type(2)));
typedef unsigned u32x4 __attribute__((ext_vector_type(4)));

constexpr int NB = 8, SEQ = 4096, T = NB * SEQ, D = 1024;
constexpr int DEPTH = 4, NIN = 6664, NQKV = 3072, NGATE = 3072;
constexpr int DFF = 2816, DFFE = 1408, NEXP = 8, NMEM = 256;
constexpr int XG_ROWS = 2 * T + 8 * 256;
constexpr float LOG2E = 1.4426950408889634f;
constexpr float C2_64 = 0.125f * LOG2E;
constexpr float C2_256 = 0.0625f * LOG2E;
constexpr float ALPHA = 1.681792830507429f;
constexpr float LN_EPS = 1e-5f;

typedef __bf16 bf16x2_t __attribute__((ext_vector_type(2)));
__device__ __forceinline__ unsigned cvt_pk_bf16(float lo, float hi) { const f32x2 v = {lo, hi}; const bf16x2_t b = __builtin_convertvector(v, bf16x2_t); return __builtin_bit_cast(unsigned, b); }
typedef _Float16 h16x2_t __attribute__((ext_vector_type(2)));
__device__ __forceinline__ unsigned cvt_pk_f16(float lo, float hi) { const f32x2 v = {lo, hi}; const h16x2_t h = __builtin_convertvector(v, h16x2_t); return __builtin_bit_cast(unsigned, h); }
__device__ __forceinline__ f32x2 unpk_f16(unsigned u) { return __builtin_convertvector(__builtin_bit_cast(h16x2_t, u), f32x2); }
__device__ __forceinline__ u32x4 pack8h(const f32x4 a, const f32x4 b) { u32x4 w; w.x = cvt_pk_f16(a[0], a[1]); w.y = cvt_pk_f16(a[2], a[3]); w.z = cvt_pk_f16(b[0], b[1]); w.w = cvt_pk_f16(b[2], b[3]); return w; }
__device__ __forceinline__ void unpack8h(const u32x4 w, f32x4& a, f32x4& b) { const f32x2 p0 = unpk_f16(w.x), p1 = unpk_f16(w.y), p2 = unpk_f16(w.z), p3 = unpk_f16(w.w); a = (f32x4){p0.x, p0.y, p1.x, p1.y}; b = (f32x4){p2.x, p2.y, p3.x, p3.y}; }
__device__ __forceinline__ float bf_lo(unsigned u) { return __uint_as_float(u << 16); }
__device__ __forceinline__ float bf_hi(unsigned u) { return __uint_as_float(u & 0xffff0000u); }
__device__ __forceinline__ float fexp2(float x) { return __builtin_amdgcn_exp2f(x); }
__device__ __forceinline__ float frcp(float x) { return __builtin_amdgcn_rcpf(x); }
__device__ __forceinline__ float sigmoidf_(float x) { return frcp(1.0f + fexp2(-x * LOG2E)); }
__device__ __forceinline__ float siluf_(float x) { return x * sigmoidf_(x); }
__device__ __forceinline__ float gelu_tanh_(float x) { const float u = 0.7978845608028654f * (x + 0.044715f * x * x * x); return x * sigmoidf_(2.0f * u); }
__device__ __forceinline__ float wave_sum(float v) {
#pragma unroll
    for (int o = 1; o < 64; o <<= 1) v += __shfl_xor(v, o);
    return v;
}
__device__ __forceinline__ u32x4 pack8(const f32x4 a, const f32x4 b) { u32x4 w; w.x = cvt_pk_bf16(a[0], a[1]); w.y = cvt_pk_bf16(a[2], a[3]); w.z = cvt_pk_bf16(b[0], b[1]); w.w = cvt_pk_bf16(b[2], b[3]); return w; }
__device__ __forceinline__ void unpack8(const u32x4 w, f32x4& a, f32x4& b) { a = (f32x4){bf_lo(w.x), bf_hi(w.x), bf_lo(w.y), bf_hi(w.y)}; b = (f32x4){bf_lo(w.z), bf_hi(w.z), bf_lo(w.w), bf_hi(w.w)}; }

namespace pg8 {
constexpr int BM = 256, BK = 64, HALF = 128, HTB = HALF * BK * 2, STAGE_BYTES = 8 * HTB, NXCD = 8, WGM = 8;
__host__ __device__ __forceinline__ int lds_byte(int r, int c) { const int st = (r >> 4) * 2 + (c >> 5), rr = r & 15, cc = c & 31, ob = rr * 64 + cc * 2; return st * 1024 + (ob ^ (((ob >> 9) & 1) << 5)); }
__host__ __device__ __forceinline__ void stage_rc(int b, int& R, int& C) { const int st = b / 1024, sb = b % 1024, swz = sb ^ (((sb >> 9) & 1) << 5); R = (st >> 1) * 16 + swz / 64; C = (st & 1) * 32 + (swz % 64) / 2; }
__host__ __device__ __forceinline__ int perm32(int rho) { const int n = rho >> 4, i = rho & 15; return 8 * (i >> 2) + 4 * n + (i & 3); }

struct Unit { const char* A; const char* B; int pm, pn, aux; };

__device__ __forceinline__ bool static_order(int nM, int nN, int G, int c, int i, int& pm, int& pn) {
    const int nwg = nM * nN; const long L = (long)i * G + c; if (L >= nwg) return false;
    int wgid = (int)L; { const int q = nwg / NXCD, r = nwg % NXCD, xcd = wgid % NXCD, off = wgid / NXCD; wgid = (xcd < r ? xcd * (q + 1) : r * (q + 1) + (xcd - r) * q) + off; }
    const int nig = WGM * nN, gid = wgid / nig, fm = gid * WGM, gsz = (nM - fm) < WGM ? (nM - fm) : WGM;
    pm = fm + ((wgid % nig) % gsz); pn = (wgid % nig) / gsz; return true;
}

template <class Epi, class Sched, bool ALIGN_EPI = true, bool SP2 = true>
__device__ __forceinline__ void gemm_phase(LAS unsigned char* lds, const int lda, const int ldb, const int nt, const Sched& S, const Epi& E) {
    int tid = threadIdx.x; asm volatile("" : "+v"(tid));
    const int wid = __builtin_amdgcn_readfirstlane(tid >> 6), lane = tid & 63, wr = wid >> 2, wc = wid & 3, fr = lane & 15, fq = lane >> 4;
    constexpr bool GA = Sched::GATHER; static_assert(!GA || SP2, "gathered A: SP2 stream only");
    unsigned voffA[2], voffB[2]; int RA[2], CA[2];
#pragma unroll
    for (int i = 0; i < 2; ++i) { int R, C; stage_rc(tid * 16 + i * 8192, R, C); const int Rb = Epi::PERM ? ((R & ~31) + perm32(R & 31)) : R; RA[i] = R; CA[i] = C;
        voffA[i] = (unsigned)(R * lda + C) * 2u; voffB[i] = (unsigned)(Rb * ldb + C) * 2u; }
    unsigned vC0[2] = {0u, 0u}, vC1[2] = {0u, 0u}, vN0[2] = {0u, 0u}, vN1[2] = {0u, 0u};
    const size_t kstep = (size_t)(BK * 2);
    const size_t hstepA = (size_t)HALF * lda * 2, hstepB = (size_t)HALF * ldb * 2;
    const unsigned ldsw = (unsigned)wid * 1024u;
    const int aoff = lds_byte(wr * 64 + fr, fq * 8), boff = lds_byte(wc * 32 + fr, fq * 8);
#define PG8_SA(b, h) (((b) * 2 + (h)) * HTB)
#define PG8_SB(b, h) ((4 + (b) * 2 + (h)) * HTB)
#define PG8_STAGE(bufoff, gbase, voff) do { _Pragma("unroll") for (int _i = 0; _i < 2; ++_i) \
        __builtin_amdgcn_global_load_lds((const unsigned*)((const char*)(gbase) + (voff)[_i]), (LAS unsigned*)(lds + (bufoff) + ldsw + _i * 8192), 16, 0, 0); } while (0)
#define PG8_STAGE_A(b, h, ptr, nx) do { if constexpr (GA) { const unsigned o0_ = (nx) ? ((h) ? vN1[0] : vN0[0]) : ((h) ? vC1[0] : vC0[0]), o1_ = (nx) ? ((h) ? vN1[1] : vN0[1]) : ((h) ? vC1[1] : vC0[1]); \
        __builtin_amdgcn_global_load_lds((const unsigned*)((const char*)(ptr) + o0_), (LAS unsigned*)(lds + PG8_SA(b, h) + ldsw), 16, 0, 0); \
        __builtin_amdgcn_global_load_lds((const unsigned*)((const char*)(ptr) + o1_), (LAS unsigned*)(lds + PG8_SA(b, h) + ldsw + 8192), 16, 0, 0); } \
        else PG8_STAGE(PG8_SA(b, h), (ptr) + ((h) ? hstepA : (size_t)0), voffA); } while (0)
#define PG8_LDA(dst, b, h) do { _Pragma("unroll") for (int m = 0; m < 4; ++m) _Pragma("unroll") for (int k = 0; k < 2; ++k) dst[m][k] = *(const LAS bf16x8*)(lds + PG8_SA(b, h) + aoff + m * 2048 + k * 1024); } while (0)
#define PG8_LDB(dst, b, h) do { _Pragma("unroll") for (int n = 0; n < 2; ++n) _Pragma("unroll") for (int k = 0; k < 2; ++k) dst[n][k] = *(const LAS bf16x8*)(lds + PG8_SB(b, h) + boff + n * 2048 + k * 1024); } while (0)
#define PG8_MMA(ai, bj, At, Bt) do { __builtin_amdgcn_s_setprio(1); _Pragma("unroll") for (int m = 0; m < 4; ++m) _Pragma("unroll") for (int n = 0; n < 2; ++n) _Pragma("unroll") for (int k = 0; k < 2; ++k) \
        acc[ai][bj][m][n] = __builtin_amdgcn_mfma_f32_16x16x32_bf16(Bt[n][k], At[m][k], acc[ai][bj][m][n], 0, 0, 0); __builtin_amdgcn_s_setprio(0); } while (0)
#define PG8_WAIT_V(n) asm volatile("s_waitcnt vmcnt(" #n ")" ::: "memory")
#define PG8_WAIT_L(n) asm volatile("s_waitcnt lgkmcnt(" #n ")" ::: "memory")
#define PG8_BAR __builtin_amdgcn_s_barrier()
#define PG8_SCHED __builtin_amdgcn_sched_barrier(0)
    Unit cur, nxt; int ui = 0;
    if (!S.next(0, cur)) return;
    f32x4 acc[2][2][4][2];
#pragma unroll
    for (int a = 0; a < 2; ++a)
#pragma unroll
        for (int b = 0; b < 2; ++b)
#pragma unroll
            for (int m = 0; m < 4; ++m)
#pragma unroll
                for (int n = 0; n < 2; ++n) acc[a][b][m][n] = (f32x4){0.f, 0.f, 0.f, 0.f};
    bf16x8 At[4][2], B0[2][2], B1[2][2];
    const char* cA = cur.A; const char* cB = cur.B;
    if constexpr (GA) S.gather(0, RA, CA, vC0, vC1);
    if constexpr (SP2) {
        PG8_STAGE(PG8_SB(0, 0), cB, voffB); PG8_STAGE(PG8_SB(0, 1), cB + hstepB, voffB); PG8_STAGE_A(0, 0, cA, false); PG8_STAGE_A(0, 1, cA, false);
        if (wr == 1) PG8_BAR;
        PG8_WAIT_V(2); PG8_BAR;
        PG8_STAGE(PG8_SB(1, 0), cB + kstep, voffB); PG8_STAGE_A(1, 0, cA + kstep, false); PG8_STAGE(PG8_SB(1, 1), cB + hstepB + kstep, voffB);
        PG8_WAIT_V(6); PG8_BAR;
    } else {
        PG8_STAGE(PG8_SB(0, 0), cB, voffB); PG8_STAGE(PG8_SA(0, 0), cA, voffA); PG8_STAGE(PG8_SB(0, 1), cB + hstepB, voffB); PG8_STAGE(PG8_SA(0, 1), cA + hstepA, voffA);
        if (wr == 1) PG8_BAR;
        PG8_WAIT_V(4); PG8_BAR;
        PG8_STAGE(PG8_SB(1, 0), cB + kstep, voffB); PG8_STAGE(PG8_SA(1, 0), cA + kstep, voffA); PG8_STAGE(PG8_SB(1, 1), cB + hstepB + kstep, voffB);
        PG8_WAIT_V(6); PG8_BAR;
    }
    for (;;) {
        const bool has_next = S.next(ui + 1, nxt);
        const char* nA = has_next ? nxt.A : cA; const char* nB = has_next ? nxt.B : cB;
        if constexpr (GA) { if (has_next) S.gather(ui + 1, RA, CA, vN0, vN1); else { vN0[0] = vC0[0]; vN0[1] = vC0[1]; vN1[0] = vC1[0]; vN1[1] = vC1[1]; } }
        for (int t = 0; t < nt; t += 2) {
            const bool last = (t == nt - 2);
            const char* a1 = cA + (size_t)(t + 1) * kstep;
            const char* a2 = last ? nA : cA + (size_t)(t + 2) * kstep; const char* b2 = last ? nB : cB + (size_t)(t + 2) * kstep;
            const char* a3 = a2 + kstep; const char* b3 = b2 + kstep;
            if constexpr (SP2) {
            PG8_LDB(B0, 0, 0); PG8_LDB(B1, 0, 1); PG8_SCHED; PG8_LDA(At, 0, 0); PG8_STAGE_A(1, 1, a1, false);
            PG8_WAIT_V(8); PG8_WAIT_L(0); PG8_BAR; PG8_MMA(0, 0, At, B0); PG8_MMA(0, 1, At, B1); PG8_BAR; PG8_SCHED;
            PG8_LDA(At, 0, 1); PG8_STAGE(PG8_SB(0, 0), b2, voffB); PG8_STAGE(PG8_SB(0, 1), b2 + hstepB, voffB); PG8_STAGE_A(0, 0, a2, last);
            PG8_WAIT_V(8); PG8_WAIT_L(0); PG8_BAR; PG8_MMA(1, 0, At, B0); PG8_MMA(1, 1, At, B1); PG8_BAR; PG8_SCHED;
            PG8_LDB(B0, 1, 0); PG8_LDB(B1, 1, 1); PG8_SCHED; PG8_LDA(At, 1, 0); PG8_STAGE_A(0, 1, a2, last);
            PG8_WAIT_V(8); PG8_WAIT_L(0); PG8_BAR; PG8_MMA(0, 0, At, B0); PG8_MMA(0, 1, At, B1); PG8_BAR; PG8_SCHED;
            PG8_LDA(At, 1, 1); PG8_STAGE(PG8_SB(1, 0), b3, voffB); PG8_STAGE(PG8_SB(1, 1), b3 + hstepB, voffB); PG8_STAGE_A(1, 0, a3, last);
            PG8_WAIT_V(8); PG8_WAIT_L(0); PG8_BAR; PG8_MMA(1, 0, At, B0); PG8_MMA(1, 1, At, B1); PG8_BAR; PG8_SCHED;
            } else {
            PG8_LDB(B0, 0, 0); PG8_SCHED; PG8_LDA(At, 0, 0); PG8_STAGE(PG8_SA(1, 1), a1 + hstepA, voffA);
            PG8_WAIT_L(8); PG8_BAR; PG8_WAIT_L(0); PG8_MMA(0, 0, At, B0); PG8_BAR; PG8_SCHED;
            PG8_LDB(B1, 0, 1); PG8_STAGE(PG8_SB(0, 0), b2, voffB);
            PG8_BAR; PG8_WAIT_L(0); PG8_MMA(0, 1, At, B1); PG8_BAR;
            PG8_LDA(At, 0, 1); PG8_STAGE(PG8_SA(0, 0), a2, voffA);
            PG8_BAR; PG8_WAIT_L(0); PG8_MMA(1, 0, At, B0); PG8_BAR; PG8_SCHED;
            PG8_STAGE(PG8_SB(0, 1), b2 + hstepB, voffB);
            PG8_WAIT_V(6); PG8_BAR; PG8_MMA(1, 1, At, B1); PG8_BAR;
            PG8_LDB(B0, 1, 0); PG8_SCHED; PG8_LDA(At, 1, 0); PG8_STAGE(PG8_SA(0, 1), a2 + hstepA, voffA);
            PG8_WAIT_L(8); PG8_BAR; PG8_WAIT_L(0); PG8_MMA(0, 0, At, B0); PG8_BAR; PG8_SCHED;
            PG8_LDB(B1, 1, 1); PG8_STAGE(PG8_SB(1, 0), b3, voffB);
            PG8_BAR; PG8_WAIT_L(0); PG8_MMA(0, 1, At, B1); PG8_BAR;
            PG8_LDA(At, 1, 1); PG8_STAGE(PG8_SA(1, 0), a3, voffA);
            PG8_BAR; PG8_WAIT_L(0); PG8_MMA(1, 0, At, B0); PG8_BAR; PG8_SCHED;
            PG8_STAGE(PG8_SB(1, 1), b3 + hstepB, voffB);
            PG8_WAIT_V(6); PG8_BAR; PG8_MMA(1, 1, At, B1); PG8_BAR;
            }
        }
        if constexpr (ALIGN_EPI) { if (wr == 0) PG8_BAR; }
        { int fr2 = fr, fq2 = fq; asm volatile("" : "+v"(fr2), "+v"(fq2)); E(acc, cur, wr, wc, fr2, fq2); }
        if (!has_next) break;
        if (!Epi::keep_acc(cur)) {
#pragma unroll
        for (int a = 0; a < 2; ++a)
#pragma unroll
            for (int b = 0; b < 2; ++b)
#pragma unroll
                for (int m = 0; m < 4; ++m)
#pragma unroll
                    for (int n = 0; n < 2; ++n) acc[a][b][m][n] = (f32x4){0.f, 0.f, 0.f, 0.f};
        }
        cur = nxt; cA = nA; cB = nB; ++ui;
        if constexpr (GA) { vC0[0] = vN0[0]; vC0[1] = vN0[1]; vC1[0] = vN1[0]; vC1[1] = vN1[1]; }
        if constexpr (ALIGN_EPI) { if (wr == 1) PG8_BAR; }
    }
    PG8_WAIT_V(0);
    if constexpr (!ALIGN_EPI) { if (wr == 0) PG8_BAR; }
    PG8_BAR;
#undef PG8_SA
#undef PG8_SB
#undef PG8_STAGE
#undef PG8_STAGE_A
#undef PG8_LDA
#undef PG8_LDB
#undef PG8_MMA
#undef PG8_WAIT_V
#undef PG8_WAIT_L
#undef PG8_BAR
#undef PG8_SCHED
}
}
using pg8::Unit;
typedef f32x4 Acc[2][2][4][2];

struct SchedBatched { static constexpr bool GATHER = false;
    const char* Abase; const char* Bbase; size_t strideA, strideB; int lda, ldb, nM, nN, nbatch, G, c;
    __device__ __forceinline__ bool next(int i, Unit& u) const {
        if (nbatch == 1) { int pm, pn; if (!pg8::static_order(nM, nN, G, c, i, pm, pn)) return false;
            u.pm = pm; u.pn = pn; u.aux = 0; u.A = Abase + (size_t)pm * 256 * lda * 2; u.B = Bbase + (size_t)pn * 256 * ldb * 2; return true; }
        const long L = (long)i * G + c; const int per = nM * nN; if (L >= (long)per * nbatch) return false;
        const int g = (int)(L / per), r = (int)(L % per); u.pm = r / nN; u.pn = r % nN; u.aux = g;
        u.A = Abase + (size_t)g * strideA + (size_t)u.pm * 256 * lda * 2; u.B = Bbase + (size_t)g * strideB + (size_t)u.pn * 256 * ldb * 2; return true;
    }
};
struct SchedOne { static constexpr bool GATHER = false; Unit u; __device__ __forceinline__ bool next(int i, Unit& o) const { if (i != 0) return false; o = u; return true; } };
struct SchedMerge { static constexpr bool GATHER = false;
    const char* A0; const char* A1; const char* A2; const char* Bbase; int G, c;
    __device__ __forceinline__ bool next(int i, Unit& u) const {
        const int n = i % 3; int pm, pn; if (!pg8::static_order(128, 4, G, c, i / 3, pm, pn)) return false;
        u.pm = pm; u.pn = pn; u.aux = n;
        const char* a = n == 0 ? A0 : (n == 1 ? A1 : A2);
        u.A = a + (size_t)pm * 256 * 512 * 2; u.B = Bbase + (size_t)n * (1024 * 512 * 2) + (size_t)pn * 256 * 512 * 2; return true;
    }
};
struct SchedMoe { static constexpr bool GATHER = false;
    const char* Abase; const char* Bbase; size_t strideB; int lda, ldb, nN, G, c; int toff[9];
    __device__ __forceinline__ bool next(int i, Unit& u) const {
        const long L = (long)i * G + c; if (L >= (long)toff[8] * nN) return false;
        const int pm = (int)(L / nN), pn = (int)(L % nN); int e = 0;
#pragma unroll
        for (int k = 1; k < 8; ++k) e += (pm >= toff[k]) ? 1 : 0;
        u.pm = pm; u.pn = pn; u.aux = e; u.A = Abase + (size_t)pm * 256 * lda * 2; u.B = Bbase + (size_t)e * strideB + (size_t)pn * 256 * ldb * 2; return true;
    }
};

struct SchedMoeG { static constexpr bool GATHER = true;
    static constexpr int nN = 11; const char* Abase; const char* Bbase; size_t strideB; int lda, ldb, G, c; int toff[9]; const LAS unsigned short* linv;
    __device__ __forceinline__ bool next(int i, Unit& u) const {
        const long L = (long)i * G + c; if (L >= (long)toff[8] * nN) return false;
        const int pm = (int)(L / nN), pn = (int)(L % nN); int e = 0;
#pragma unroll
        for (int k = 1; k < 8; ++k) e += (pm >= toff[k]) ? 1 : 0;
        u.pm = pm; u.pn = pn; u.aux = e; u.A = Abase; u.B = Bbase + (size_t)e * strideB + (size_t)pn * 256 * ldb * 2; return true;
    }
    __device__ __forceinline__ void gather(int ord, const int* R, const int* C, unsigned* v0, unsigned* v1) const {
#pragma unroll
        for (int i = 0; i < 2; ++i) { const unsigned t0 = linv[ord * 256 + R[i]], t1 = linv[ord * 256 + 128 + R[i]];
            v0[i] = (t0 * (unsigned)lda + (unsigned)C[i]) * 2u; v1[i] = (t1 * (unsigned)lda + (unsigned)C[i]) * 2u; }
    }
};

#define FOR_ROWS _Pragma("unroll") for (int ai = 0; ai < 2; ++ai) _Pragma("unroll") for (int m = 0; m < 4; ++m)
#define ROW_T (ai * 128 + wr * 64 + m * 16 + fr)

struct EpiScale {
    static __device__ __forceinline__ bool keep_acc(const Unit&) { return false; } static constexpr bool PERM = true;
    bf16_t* O; int ldc; float scale; size_t auxstride;
    __device__ __forceinline__ void operator()(const Acc& acc, const Unit& u, int wr, int wc, int fr, int fq) const {
        bf16_t* base = O + (size_t)u.aux * auxstride + (size_t)u.pm * 256 * ldc + u.pn * 256 + wc * 32 + 8 * fq;
        FOR_ROWS { const int rt = ROW_T;
#pragma unroll
            for (int bj = 0; bj < 2; ++bj) { __builtin_nontemporal_store(pack8(acc[ai][bj][m][0] * scale, acc[ai][bj][m][1] * scale), (u32x4*)(base + (size_t)rt * ldc + bj * 128)); } }
    }
};
struct EpiInProj {
    static __device__ __forceinline__ bool keep_acc(const Unit&) { return false; } static constexpr bool PERM = true;
    bf16_t* UG; bf16_t* QKV; const float* ROPE; unsigned* NORM;
    __device__ __forceinline__ void operator()(const Acc& acc, const Unit& u, int wr, int wc, int fr, int fq) const {
        if (u.pn < 2) {
            FOR_ROWS { const int rt = ROW_T; const int row = u.pm * 256 + rt, b = row >> 12, t = row & 4095, j = t >> 5, ti = t & 31;
#pragma unroll
                for (int bj = 0; bj < 2; ++bj) { const int c0 = u.pn * 256 + bj * 128 + wc * 32 + 8 * fq, g = c0 >> 4, ci = c0 & 15;
                    __builtin_nontemporal_store(pack8(acc[ai][bj][m][0], acc[ai][bj][m][1]), (u32x4*)(UG + ((size_t)(g * 1024 + b * 128 + j) * 640 + ti * 16 + ci))); } }
        } else {
            const int seg = (u.pn - 2) >> 1; const float sc = (seg == 0 || seg == 3) ? C2_64 : 1.0f; const bool rope = (seg < 2) && ((wc & 1) == 0);
            const int colbase = (u.pn - 2) * 256 + wc * 32 + 8 * fq;
            const bool nrm = (seg == 3 || seg == 4); float hm0 = 0.f, hm1 = 0.f;
            FOR_ROWS { const int rt = ROW_T; const int row = u.pm * 256 + rt;
#pragma unroll
                for (int bj = 0; bj < 2; ++bj) { f32x4 v0 = acc[ai][bj][m][0], v1 = acc[ai][bj][m][1];
                    if (nrm) { const f32x4 w0 = v0 * sc, w1 = v1 * sc; const f32x4 q2 = w0 * w0 + w1 * w1; float ss = (q2[0] + q2[1]) + (q2[2] + q2[3]);
                        ss += __shfl_xor(ss, 16); ss += __shfl_xor(ss, 32);
                        if (bj == 0) hm0 = fmaxf(hm0, ss); else hm1 = fmaxf(hm1, ss); }
                    if (rope) {
                        f32x4 p0, p1;
#pragma unroll
                        for (int k = 0; k < 4; ++k) { p0[k] = __shfl_xor(v0[k], 16); p1[k] = __shfl_xor(v1[k], 16); }
                        if (fq < 2) { const f32x4 c0 = *(const f32x4*)(ROPE + (size_t)row * 16), c1 = *(const f32x4*)(ROPE + (size_t)row * 16 + 4), s0 = *(const f32x4*)(ROPE + (size_t)row * 16 + 8), s1 = *(const f32x4*)(ROPE + (size_t)row * 16 + 12);
                            const float sg = fq == 0 ? -1.0f : 1.0f;
                            v0 = v0 * c0 + (p0 * s0) * sg; v1 = v1 * c1 + (p1 * s1) * sg; }
                    }
                    __builtin_nontemporal_store(pack8(v0 * sc, v1 * sc), (u32x4*)(QKV + (size_t)row * NQKV + colbase + bj * 128)); } }
            if (nrm) {
#pragma unroll
                for (int o = 1; o < 16; o <<= 1) { hm0 = fmaxf(hm0, __shfl_xor(hm0, o)); hm1 = fmaxf(hm1, __shfl_xor(hm1, o)); }
                if ((threadIdx.x & 63) == 0) { const int b = (u.pm * 256) >> 12, c0 = (u.pn - 2) * 256 + wc * 32;
                    __hip_atomic_fetch_max(NORM + ((b * 8 + ((c0 >> 6) & 7)) * 4 + (seg == 4 ? 2 : 0) + (wc & 1)), __float_as_uint(hm0 * 1.01f), __ATOMIC_RELAXED, __HIP_MEMORY_SCOPE_AGENT);
                    __hip_atomic_fetch_max(NORM + ((b * 8 + (((c0 + 128) >> 6) & 7)) * 4 + (seg == 4 ? 2 : 0) + (wc & 1)), __float_as_uint(hm1 * 1.01f), __ATOMIC_RELAXED, __HIP_MEMORY_SCOPE_AGENT); } }
        }
    }
};
struct EpiGates {
    static __device__ __forceinline__ bool keep_acc(const Unit&) { return false; } static constexpr bool PERM = true;
    bf16_t* G;
    __device__ __forceinline__ void operator()(const Acc& acc, const Unit& u, int wr, int wc, int fr, int fq) const {
        bf16_t* base = G + (size_t)u.pm * 256 * NGATE + u.pn * 256 + wc * 32 + 8 * fq;
        FOR_ROWS { const int rt = ROW_T;
#pragma unroll
            for (int bj = 0; bj < 2; ++bj) { f32x4 a = acc[ai][bj][m][0], b = acc[ai][bj][m][1];
#pragma unroll
                for (int k = 0; k < 4; ++k) { a[k] = sigmoidf_(a[k]); b[k] = sigmoidf_(b[k]); }
                __builtin_nontemporal_store(pack8(a, b), (u32x4*)(base + (size_t)rt * NGATE + bj * 128)); } }
    }
};
struct EpiGlu {
    static constexpr bool F16 = false; static __device__ __forceinline__ bool keep_acc(const Unit&) { return false; } static constexpr bool PERM = true; static constexpr int NVMEM = 0;
    const bf16_t* Y; bf16_t* O;
    __device__ __forceinline__ void operator()(const Acc& acc, const Unit& u, int wr, int wc, int fr, int fq) const {
        const size_t off0 = (size_t)u.pm * 256 * 512 + u.pn * 256 + wc * 32 + 8 * fq;
#pragma unroll
        for (int ai = 0; ai < 2; ++ai) {
            u32x4 yz[4][2];
#pragma unroll
            for (int m = 0; m < 4; ++m)
#pragma unroll
                for (int bj = 0; bj < 2; ++bj) yz[m][bj] = *(const u32x4*)(Y + off0 + (size_t)ROW_T * 512 + bj * 128);
#pragma unroll
            for (int m = 0; m < 4; ++m)
#pragma unroll
                for (int bj = 0; bj < 2; ++bj) { f32x4 ya, yb; unpack8(yz[m][bj], ya, yb); f32x4 a = acc[ai][bj][m][0], b = acc[ai][bj][m][1];
#pragma unroll
                    for (int k = 0; k < 4; ++k) { a[k] = ya[k] * sigmoidf_(a[k]); b[k] = yb[k] * sigmoidf_(b[k]); }
                    *(u32x4*)(O + off0 + (size_t)ROW_T * 512 + bj * 128) = pack8(a, b); }
            asm volatile("" ::: "memory");
        }
    }

};
struct EpiMerge {
    static constexpr bool F16 = false; static __device__ __forceinline__ bool keep_acc(const Unit& u) { return u.aux < 2; } static constexpr bool PERM = true; static constexpr int NVMEM = 0;
    const bf16_t* G; bf16_t* M;
    __device__ __forceinline__ void operator()(Acc& acc, const Unit& u, int wr, int wc, int fr, int fq) const {
        const int col0 = u.pn * 256 + wc * 32 + 8 * fq; const int n = u.aux;
#pragma unroll
        for (int ai = 0; ai < 2; ++ai)
#pragma unroll
            for (int mp = 0; mp < 2; ++mp) {
                u32x4 gz[2][2], hz[2][2];
#pragma unroll
                for (int mm = 0; mm < 2; ++mm) { const int m = 2 * mp + mm; const size_t row = (size_t)u.pm * 256 + ROW_T;
#pragma unroll
                    for (int bj = 0; bj < 2; ++bj) { gz[mm][bj] = *(const u32x4*)(G + row * NGATE + n * 1024 + col0 + bj * 128); if (n < 2) hz[mm][bj] = *(const u32x4*)(G + row * NGATE + (n + 1) * 1024 + col0 + bj * 128); } }
#pragma unroll
                for (int mm = 0; mm < 2; ++mm) { const int m = 2 * mp + mm; const size_t row = (size_t)u.pm * 256 + ROW_T;
#pragma unroll
                    for (int bj = 0; bj < 2; ++bj) { f32x4 ga, gb; unpack8(gz[mm][bj], ga, gb);
#pragma unroll
                        for (int k = 0; k < 4; ++k) { ga[k] = fmaxf(ga[k], 1.0e-30f); gb[k] = fmaxf(gb[k], 1.0e-30f); }
                        if (n < 2) { f32x4 ha, hb; unpack8(hz[mm][bj], ha, hb);
#pragma unroll
                            for (int k = 0; k < 4; ++k) { ga[k] *= frcp(fmaxf(ha[k], 1.0e-30f)); gb[k] *= frcp(fmaxf(hb[k], 1.0e-30f)); }
                            acc[ai][bj][m][0] *= ga; acc[ai][bj][m][1] *= gb; }
                        else *(u32x4*)(M + row * 1024 + col0 + bj * 128) = pack8(acc[ai][bj][m][0] * ga, acc[ai][bj][m][1] * gb); } }
                asm volatile("" ::: "memory");
            }
    }

};
template <bool INF32> struct EpiResT {
    static __device__ __forceinline__ bool keep_acc(const Unit&) { return false; } static constexpr bool PERM = true; static constexpr int NVMEM = 0;
    unsigned short* ZH; const float* X32; const float* ST; const float* g; const float* b;
    __device__ __forceinline__ void operator()(const Acc& acc, const Unit& u, int wr, int wc, int fr, int fq) const {
        const int col0 = u.pn * 256 + wc * 32 + 8 * fq;
        f32x4 g4[2][2], b4[2][2];
#pragma unroll
        for (int bj = 0; bj < 2; ++bj)
#pragma unroll
            for (int n = 0; n < 2; ++n) { g4[bj][n] = *(const f32x4*)(g + col0 + bj * 128 + n * 4); b4[bj][n] = *(const f32x4*)(b + col0 + bj * 128 + n * 4) * ALPHA; }
#pragma unroll
        for (int ai = 0; ai < 2; ++ai) {
            u32x4 zr[4][2]; f32x2 stv[4];
#pragma unroll
            for (int m = 0; m < 4; ++m) { const size_t row = (size_t)u.pm * 256 + ROW_T; stv[m] = *(const f32x2*)(ST + row * 2);
                if (!INF32) {
#pragma unroll
                    for (int bj = 0; bj < 2; ++bj) zr[m][bj] = *(const u32x4*)(ZH + row * D + col0 + bj * 128); } }
#pragma unroll
            for (int m = 0; m < 4; ++m) { const size_t row = (size_t)u.pm * 256 + ROW_T; const f32x2 st = stv[m]; const float sc = st.y * ALPHA;
#pragma unroll
                for (int bj = 0; bj < 2; ++bj) { const size_t off = row * D + col0 + bj * 128; f32x4 x0, x1;
                    if (INF32) { x0 = *(const f32x4*)(X32 + off); x1 = *(const f32x4*)(X32 + off + 4); } else unpack8h(zr[m][bj], x0, x1);
                    x0 = ((x0 - st.x) * sc) * g4[bj][0] + b4[bj][0] + acc[ai][bj][m][0]; x1 = ((x1 - st.x) * sc) * g4[bj][1] + b4[bj][1] + acc[ai][bj][m][1];
                    *(u32x4*)(ZH + off) = pack8h(x0, x1); } }
            asm volatile("" ::: "memory");
        }
    }
};
struct EpiSwiglu {
    static __device__ __forceinline__ bool keep_acc(const Unit&) { return false; } static constexpr bool PERM = true;
    bf16_t* H; int ldh;
    __device__ __forceinline__ void operator()(const Acc& acc, const Unit& u, int wr, int wc, int fr, int fq) const {
        bf16_t* base = H + (size_t)u.pm * 256 * ldh + u.pn * 128 + wc * 32 + 8 * fq;
        FOR_ROWS { const int rt = ROW_T; f32x4 a = acc[ai][0][m][0], b = acc[ai][0][m][1]; const f32x4 ua = acc[ai][1][m][0], ub = acc[ai][1][m][1];
#pragma unroll
            for (int k = 0; k < 4; ++k) { a[k] = siluf_(a[k]) * ua[k]; b[k] = siluf_(b[k]) * ub[k]; }
            __builtin_nontemporal_store(pack8(a, b), (u32x4*)(base + (size_t)rt * ldh)); }
    }
};
struct EpiS1 {
    static __device__ __forceinline__ bool keep_acc(const Unit&) { return false; } static constexpr bool PERM = false;
    float* SLOC;
    __device__ __forceinline__ void operator()(const Acc& acc, const Unit& u, int wr, int wc, int fr, int fq) const {
        float* base = SLOC + ((size_t)u.aux * 1024 + u.pm * 256) * 128 + wc * 32 + 4 * fq;
        FOR_ROWS { const int rt = ROW_T;
#pragma unroll
            for (int n = 0; n < 2; ++n) *(f32x4*)(base + (size_t)rt * 128 + n * 16) = acc[ai][0][m][n]; }
    }
};
struct EpiS3 {
    static constexpr bool F16 = false; static __device__ __forceinline__ bool keep_acc(const Unit&) { return false; } static constexpr bool PERM = true; static constexpr int NVMEM = 0;
    const bf16_t* UG; const float* dskip; bf16_t* Y;
    __device__ __forceinline__ void operator()(const Acc& acc, const Unit& u, int wr, int wc, int fr, int fq) const {
        const int g = u.aux;
        f32x4 da[2], db[2]; int to[2], co[2];
#pragma unroll
        for (int bj = 0; bj < 2; ++bj) { const int n0 = u.pn * 256 + bj * 128 + wc * 32 + 8 * fq; to[bj] = n0 >> 4; co[bj] = n0 & 15; da[bj] = *(const f32x4*)(dskip + g * 16 + co[bj]); db[bj] = *(const f32x4*)(dskip + g * 16 + co[bj] + 4); }
#pragma unroll
        for (int ai = 0; ai < 2; ++ai) {
            u32x4 uz[4][2];
#pragma unroll
            for (int m = 0; m < 4; ++m)
#pragma unroll
                for (int bj = 0; bj < 2; ++bj) uz[m][bj] = *(const u32x4*)(UG + ((size_t)(g * 1024 + u.pm * 256 + ROW_T) * 640 + to[bj] * 16 + co[bj]));
#pragma unroll
            for (int m = 0; m < 4; ++m) { const int R = u.pm * 256 + ROW_T, b = R >> 7, j = R & 127;
#pragma unroll
                for (int bj = 0; bj < 2; ++bj) { f32x4 ua, ub; unpack8(uz[m][bj], ua, ub);
                    f32x4 a = acc[ai][bj][m][0] + da[bj] * ua, bb = acc[ai][bj][m][1] + db[bj] * ub;
#pragma unroll
                    for (int k = 0; k < 4; ++k) { a[k] = gelu_tanh_(a[k]); bb[k] = gelu_tanh_(bb[k]); }
                    *(u32x4*)(Y + ((size_t)(b * 4096 + j * 32 + to[bj]) * 512 + g * 16 + co[bj])) = pack8(a, bb); } }
            asm volatile("" ::: "memory");
        }
    }

};

namespace att {
__device__ __forceinline__ int crow(int r, int hi) { return (r & 3) + 8 * (r >> 2) + 4 * hi; }
__device__ __forceinline__ float swap_max(float m) { auto rr = __builtin_amdgcn_permlane32_swap(__float_as_uint(m), __float_as_uint(m), false, false); return fmaxf(__uint_as_float(rr[0]), __uint_as_float(rr[1])); }
__device__ __forceinline__ float swap_add(float m) { auto rr = __builtin_amdgcn_permlane32_swap(__float_as_uint(m), __float_as_uint(m), false, false); return __uint_as_float(rr[0]) + __uint_as_float(rr[1]); }
__device__ __forceinline__ float rowmax(const f32x16& p0, const f32x16& p1) {
    float a = fmaxf(p0[0], p1[0]);
#pragma unroll
    for (int r = 1; r < 16; ++r) a = fmaxf(a, fmaxf(p0[r], p1[r]));
    return swap_max(a);
}
__device__ __forceinline__ float max3f(float a, float b, float c) { float r; asm("v_max3_f32 %0, %1, %2, %3" : "=v"(r) : "v"(a), "v"(b), "v"(c)); return r; }
__device__ __forceinline__ float rowmax_fast(const f32x16& p0, const f32x16& p1) {
    float a = max3f(p0[0], p0[1], p1[0]), b = max3f(p0[2], p0[3], p1[1]); a = max3f(a, p1[2], p1[3]);
#pragma unroll
    for (int r = 4; r < 16; r += 4) { a = max3f(a, p0[r], p0[r + 1]); b = max3f(b, p0[r + 2], p0[r + 3]); a = max3f(a, p1[r], p1[r + 1]); b = max3f(b, p1[r + 2], p1[r + 3]); }
    float m; asm("v_max_f32_e32 %0, %1, %2" : "=v"(m) : "v"(a), "v"(b));
    auto rr = __builtin_amdgcn_permlane32_swap(__float_as_uint(m), __float_as_uint(m), false, false);
    float o; asm("v_max_f32_e32 %0, %1, %2" : "=v"(o) : "v"(__uint_as_float(rr[0])), "v"(__uint_as_float(rr[1]))); return o;
}
template <int NK> __device__ __forceinline__ void qkt(f32x16& p0, f32x16& p1, const LAS unsigned char* Kslot, const bf16x8* qr, int r32, int hi) {
    const LAS unsigned char* kb = Kslot + hi * 1024 + r32 * 16;
#pragma unroll
    for (int d0 = 0; d0 < NK; ++d0) {
        const bf16x8 b0 = *(const LAS bf16x8*)(kb + d0 * 2048);
        const bf16x8 b1 = *(const LAS bf16x8*)(kb + d0 * 2048 + 512);
        p0 = __builtin_amdgcn_mfma_f32_32x32x16_bf16(b0, qr[d0], p0, 0, 0, 0);
        p1 = __builtin_amdgcn_mfma_f32_32x32x16_bf16(b1, qr[d0], p1, 0, 0, 0);
    }
}
template <int ND> __device__ __forceinline__ void pv(f32x16* o, unsigned vb, bf16x8 pa0, bf16x8 pa1, bf16x8 pa2, bf16x8 pa3) {
#pragma unroll
    for (int d0 = 0; d0 < ND; ++d0) { s16x4 lo[4], hi[4];
#pragma unroll
        for (int ks = 0; ks < 4; ++ks) {
            asm volatile("ds_read_b64_tr_b16 %0, %1 offset:%c2" : "=&v"(lo[ks]) : "v"(vb), "i"(d0 * 4096 + ks * 1024) : "memory");
            asm volatile("ds_read_b64_tr_b16 %0, %1 offset:%c2" : "=&v"(hi[ks]) : "v"(vb), "i"(d0 * 4096 + ks * 1024 + 512) : "memory"); }
        asm volatile("s_waitcnt lgkmcnt(0)" ::: "memory"); __builtin_amdgcn_sched_barrier(0);
#define ATT_PK(k) (bf16x8){lo[k][0], lo[k][1], lo[k][2], lo[k][3], hi[k][0], hi[k][1], hi[k][2], hi[k][3]}
        o[d0] = __builtin_amdgcn_mfma_f32_32x32x16_bf16(pa0, ATT_PK(0), o[d0], 0, 0, 0);
        o[d0] = __builtin_amdgcn_mfma_f32_32x32x16_bf16(pa1, ATT_PK(1), o[d0], 0, 0, 0);
        o[d0] = __builtin_amdgcn_mfma_f32_32x32x16_bf16(pa2, ATT_PK(2), o[d0], 0, 0, 0);
        o[d0] = __builtin_amdgcn_mfma_f32_32x32x16_bf16(pa3, ATT_PK(3), o[d0], 0, 0, 0);
#undef ATT_PK
    }
}
__device__ __forceinline__ void glds16(const void* gsrc, unsigned lds_dst) { unsigned keep;
    asm volatile("s_mov_b32 %0, m0\n\ts_mov_b32 m0, %2\n\ts_nop 0\n\tglobal_load_lds_dwordx4 %1, off\n\ts_mov_b32 m0, %0" : "=&s"(keep) : "v"(gsrc), "s"(lds_dst) : "memory"); }
#define ATT_WAITBAR() do { asm volatile("s_waitcnt vmcnt(0) lgkmcnt(0)" ::: "memory"); __builtin_amdgcn_s_barrier(); asm volatile("" ::: "memory"); } while (0)
constexpr float NEG = -1.0e30f;

constexpr int ATT_NS = 4, ATT_KSLOT = 10240, ATT_VOFF = ATT_NS * ATT_KSLOT, ATT_OST = ATT_VOFF + ATT_NS * 8192;
template <int MODE>
__device__ __forceinline__ void attn64_unit(LAS unsigned char* lds, LAS float* wsf_all, const bf16_t* Qp, const bf16_t* Kp, const bf16_t* Vp, const long rs,
                                            const int i0, const int t_lo, const int t_hi, const bf16_t* kbias, bf16_t* Op, const long os, float* lsep, const long ls) {
    int tid = threadIdx.x; asm volatile("" : "+v"(tid));
    const int lane = tid & 63, r32 = lane & 31, hi = lane >> 5, wid = __builtin_amdgcn_readfirstlane(tid >> 6);
    LAS float* wsf = wsf_all + wid * 64;
    const int qw0 = i0 + wid * 32, qi = qw0 + r32;
    constexpr float THR = 30.0f;
    int w_lo = t_lo; const int w_hi = ((qw0 + 31) >> 6) + 1;
    if (MODE == 1) { const int lo = (qw0 - 128) >> 6; w_lo = lo > t_lo ? lo : t_lo; }
    float mhat = 0.f, lrun = 0.f; bool started = false; f32x16 o[2]; o[0] = f32x16{}; o[1] = f32x16{};
    f32x16 negm = f32x16{};
    const bf16_t* ksrc = Kp + (long)lane * rs + wid * 8;
    const bf16_t* vsrc = Vp + (long)(16 * (wid & 3) + (lane >> 2)) * rs + (wid >> 2) * 32 + (lane & 3) * 8;
    const unsigned vb0 = (unsigned)(uintptr_t)(lds + ATT_VOFF) + ((lane >> 4) & 1) * 32 + (lane & 3) * 8 + (4 * hi + ((lane & 15) >> 2)) * 64;
#define ATT_ISSUE(tt) do { const int t_ = (tt) < t_hi ? (tt) : t_hi - 1; const int s_ = (tt) & (ATT_NS - 1); const unsigned l0_ = (unsigned)(uintptr_t)lds; \
        glds16(ksrc + (long)t_ * 64 * rs, (unsigned)__builtin_amdgcn_readfirstlane((int)(l0_ + s_ * ATT_KSLOT + wid * 1024))); \
        glds16(vsrc + (long)t_ * 64 * rs, (unsigned)__builtin_amdgcn_readfirstlane((int)(l0_ + ATT_VOFF + s_ * 8192 + wid * 1024))); \
        if (MODE == 0 && wid == 0) glds16(kbias + (long)(t_ * 64 + lane) * 64, (unsigned)__builtin_amdgcn_readfirstlane((int)(l0_ + s_ * ATT_KSLOT + 8192))); } while (0)
#define ATT_QK(tt) do { const LAS unsigned char* Ks_ = lds + ((tt) & (ATT_NS - 1)) * ATT_KSLOT; const LAS unsigned char* kb_ = Ks_ + hi * 1024 + r32 * 16; bf16x8 kf[10]; \
        _Pragma("unroll") for (int d0_ = 0; d0_ < 4; ++d0_) { kf[2 * d0_] = *(const LAS bf16x8*)(kb_ + d0_ * 2048); kf[2 * d0_ + 1] = *(const LAS bf16x8*)(kb_ + d0_ * 2048 + 512); } \
        if (MODE == 0) { const LAS unsigned char* kx_ = Ks_ + 8192 + r32 * 16; kf[8] = *(const LAS bf16x8*)(kx_); kf[9] = *(const LAS bf16x8*)(kx_ + 512); \
            asm volatile("s_waitcnt lgkmcnt(0)" : "+v"(kf[0]), "+v"(kf[1]), "+v"(kf[2]), "+v"(kf[3]), "+v"(kf[4]), "+v"(kf[5]), "+v"(kf[6]), "+v"(kf[7]), "+v"(kf[8]), "+v"(kf[9]) :: "memory"); } \
        else asm volatile("s_waitcnt lgkmcnt(0)" : "+v"(kf[0]), "+v"(kf[1]), "+v"(kf[2]), "+v"(kf[3]), "+v"(kf[4]), "+v"(kf[5]), "+v"(kf[6]), "+v"(kf[7]) :: "memory"); \
        p0 = __builtin_amdgcn_mfma_f32_32x32x16_bf16(kf[0], qr[0], negm, 0, 0, 0); \
        p1 = __builtin_amdgcn_mfma_f32_32x32x16_bf16(kf[1], qr[0], negm, 0, 0, 0); \
        _Pragma("unroll") for (int d0_ = 1; d0_ < 4; ++d0_) { \
            p0 = __builtin_amdgcn_mfma_f32_32x32x16_bf16(kf[2 * d0_], qr[d0_], p0, 0, 0, 0); \
            p1 = __builtin_amdgcn_mfma_f32_32x32x16_bf16(kf[2 * d0_ + 1], qr[d0_], p1, 0, 0, 0); } \
        if (MODE == 0) { p0 = __builtin_amdgcn_mfma_f32_32x32x16_bf16(kf[8], qr[4], p0, 0, 0, 0); p1 = __builtin_amdgcn_mfma_f32_32x32x16_bf16(kf[9], qr[4], p1, 0, 0, 0); } \
        asm volatile("s_nop 15\n\ts_nop 7" : "+v"(p0), "+v"(p1)); } while (0)
#define ATT_WAIT_TILES(n2, n3) do { if (MODE == 0 && wid == 0) asm volatile("s_waitcnt vmcnt(" #n3 ") lgkmcnt(0)" ::: "memory"); else asm volatile("s_waitcnt vmcnt(" #n2 ") lgkmcnt(0)" ::: "memory"); \
        __builtin_amdgcn_s_barrier(); asm volatile("" ::: "memory"); } while (0)
    ATT_ISSUE(t_lo); ATT_ISSUE(t_lo + 1); ATT_ISSUE(t_lo + 2);
    bf16x8 qr[5];
#pragma unroll
    for (int d0 = 0; d0 < 4; ++d0) qr[d0] = *(const bf16x8*)(Qp + (long)qi * rs + d0 * 16 + hi * 8);
    { const short one = hi == 0 ? (short)0x3F80 : (short)0; qr[4] = (bf16x8){one, one, one, 0, 0, 0, 0, 0}; }
    asm volatile("s_waitcnt vmcnt(0)" : "+v"(qr[0]), "+v"(qr[1]), "+v"(qr[2]), "+v"(qr[3]) :: "memory");
    const bool stag = wid >= 4;
    f32x16 p0 = f32x16{}, p1 = f32x16{};
    ATT_WAIT_TILES(4, 6);
    if (stag && t_lo >= w_lo && t_lo < w_hi) ATT_QK(t_lo);
    for (int t = t_lo; t < t_hi; ++t) {
        ATT_WAIT_TILES(2, 3);
        ATT_ISSUE(t + 3);
        const bool a0 = (t >= w_lo && t < w_hi), a1 = (t + 1 >= w_lo && t + 1 < w_hi);
        if (!stag && a0) ATT_QK(t);
        if (a0) {
            const int kvb = 64 * t + 4 * hi;
            if (MODE == 0) {
                if (64 * t + 63 > qw0) {
#pragma unroll
                    for (int r = 0; r < 16; ++r) { const int kv = kvb + (r & 3) + 8 * (r >> 2); if (kv > qi) p0[r] = -INFINITY; if (kv + 32 > qi) p1[r] = -INFINITY; }
                }
            } else {
                if (64 * t + 63 > qw0 || 64 * t < qw0 + 31 - 128) {
#pragma unroll
                    for (int r = 0; r < 16; ++r) { const int dd = qi - (kvb + (r & 3) + 8 * (r >> 2)); if (dd < 0 || dd > 128) p0[r] = -INFINITY; if (dd - 32 < 0 || dd - 32 > 128) p1[r] = -INFINITY; }
                }
            }
            const float rm = rowmax_fast(p0, p1);
            const bool need = started ? (rm > THR) : (rm > -1.0e30f);
            bool resc = false;
            if (__any(need)) {
                const float dl = need ? rm : 0.f; mhat += dl;
#pragma unroll
                for (int r = 0; r < 16; ++r) { p0[r] -= dl; p1[r] -= dl; }
#pragma unroll
                for (int r = 0; r < 16; ++r) negm[r] = -mhat;
                const float f = (need && started) ? fexp2(-dl) : 1.0f; lrun *= f; started = started || need;
                if (hi == 0) wsf[r32] = f; resc = true;
            }
            float ps = 0.f;
#pragma unroll
            for (int r = 0; r < 16; ++r) { p0[r] = fexp2(p0[r]); p1[r] = fexp2(p1[r]); ps += p0[r] + p1[r]; }
            lrun += ps;
            if (resc) {
                asm volatile("s_waitcnt lgkmcnt(0)" ::: "memory");
#pragma unroll
                for (int g = 0; g < 4; ++g) { const f32x4 fv = *(const LAS f32x4*)(wsf + 8 * g + 4 * hi);
#pragma unroll
                    for (int k = 0; k < 4; ++k) { o[0][4 * g + k] *= fv[k]; o[1][4 * g + k] *= fv[k]; } }
            }
            u32x4 pw0, pw1, pw2, pw3;
            pw0 = (u32x4){cvt_pk_bf16(p0[0], p0[1]), cvt_pk_bf16(p0[2], p0[3]), cvt_pk_bf16(p0[4], p0[5]), cvt_pk_bf16(p0[6], p0[7])};
            pw1 = (u32x4){cvt_pk_bf16(p0[8], p0[9]), cvt_pk_bf16(p0[10], p0[11]), cvt_pk_bf16(p0[12], p0[13]), cvt_pk_bf16(p0[14], p0[15])};
            pw2 = (u32x4){cvt_pk_bf16(p1[0], p1[1]), cvt_pk_bf16(p1[2], p1[3]), cvt_pk_bf16(p1[4], p1[5]), cvt_pk_bf16(p1[6], p1[7])};
            pw3 = (u32x4){cvt_pk_bf16(p1[8], p1[9]), cvt_pk_bf16(p1[10], p1[11]), cvt_pk_bf16(p1[12], p1[13]), cvt_pk_bf16(p1[14], p1[15])};
            pv<2>(o, vb0 + (t & (ATT_NS - 1)) * 8192, __builtin_bit_cast(bf16x8, pw0), __builtin_bit_cast(bf16x8, pw1), __builtin_bit_cast(bf16x8, pw2), __builtin_bit_cast(bf16x8, pw3));
        }
        if (stag && a1) ATT_QK(t + 1);
    }
#undef ATT_ISSUE
#undef ATT_QK
#undef ATT_WAIT_TILES
    const float ltot = swap_add(lrun);
    if (hi == 0) { wsf[32 + r32] = ltot; if (MODE == 1) lsep[(long)qi * ls] = mhat + __builtin_amdgcn_logf(ltot); }
    asm volatile("s_waitcnt lgkmcnt(0)" ::: "memory");
    LAS bf16_t* stg = (LAS bf16_t*)(lds + ATT_OST) + wid * 2048;
#pragma unroll
    for (int g = 0; g < 4; ++g) { const f32x4 lv = *(const LAS f32x4*)(wsf + 32 + 8 * g + 4 * hi);
#pragma unroll
        for (int k = 0; k < 4; ++k) { const int r = 4 * g + k; const float rl = frcp(lv[k]); LAS bf16_t* srow = stg + crow(r, hi) * 64 + r32;
            srow[0] = (bf16_t)(cvt_pk_bf16(o[0][r] * rl, 0.f) & 0xffffu); srow[32] = (bf16_t)(cvt_pk_bf16(o[1][r] * rl, 0.f) & 0xffffu); } }
    asm volatile("s_waitcnt lgkmcnt(0)" ::: "memory");
#pragma unroll
    for (int i = 0; i < 4; ++i) { const int row = i * 8 + (lane >> 3), ch = lane & 7; const u32x4 v = *(const LAS u32x4*)(stg + row * 64 + ch * 8); *(u32x4*)(Op + (long)(qw0 + row) * os + ch * 8) = v; }
    ATT_WAITBAR();
}

__device__ __forceinline__ s16x4 vtr(const LAS unsigned char* p) { return __builtin_amdgcn_ds_read_tr16_b64_v4i16((LAS s16x4*)p); }
#define FX_MX3(a, b, c) __builtin_fmaxf(__builtin_fmaxf((a), (b)), (c))
__device__ __forceinline__ float rowmax_b(const f32x16& p0, const f32x16& p1) {
    float a = FX_MX3(p0[0], p0[1], p1[0]), b = FX_MX3(p0[2], p0[3], p1[1]); a = FX_MX3(a, p1[2], p1[3]);
#pragma unroll
    for (int r = 4; r < 16; r += 4) { a = FX_MX3(a, p0[r], p0[r + 1]); b = FX_MX3(b, p0[r + 2], p0[r + 3]); a = FX_MX3(a, p1[r], p1[r + 1]); b = FX_MX3(b, p1[r + 2], p1[r + 3]); }
    const float m = __builtin_fmaxf(a, b); auto rr = __builtin_amdgcn_permlane32_swap(__float_as_uint(m), __float_as_uint(m), false, false);
    return __builtin_fmaxf(__uint_as_float(rr[0]), __uint_as_float(rr[1])); }
__device__ __forceinline__ void fox_unit(LAS unsigned char* lds, LAS float* wsf_all, const bf16_t* Qp, const bf16_t* Kp, const bf16_t* Vp, const long rs,
                                         const int i0, const int t_lo, const int t_hi, const bf16_t* kbias, bf16_t* Op, const long os) {
    int tid = threadIdx.x; asm volatile("" : "+v"(tid));
    const int lane = tid & 63, r32 = lane & 31, hi = lane >> 5, wid = __builtin_amdgcn_readfirstlane(tid >> 6);
    LAS float* wsf = wsf_all + wid * 64;
    const int qw0 = i0 + wid * 32, qi = qw0 + r32;
    constexpr float THR = 30.0f;
#define FX_SBAR() __builtin_amdgcn_sched_barrier(0)
#define FX_PIN(x) asm volatile("" : "+v"(x))
#define FX_MF(a, b, c) __builtin_amdgcn_mfma_f32_32x32x16_bf16(a, b, c, 0, 0, 0)
    float mhat = 0.f, lrun = 0.f; f32x16 o[2]; o[0] = f32x16{}; o[1] = f32x16{};
    const bf16_t* ksrc = Kp + (long)lane * rs + wid * 8;
    const bf16_t* vsrc = Vp + (long)(16 * (wid & 3) + (lane >> 2)) * rs + (wid >> 2) * 32 + (lane & 3) * 8;
    const LAS unsigned char* vp0 = lds + ATT_VOFF + ((lane >> 4) & 1) * 32 + (lane & 3) * 8 + (4 * hi + ((lane & 15) >> 2)) * 64;
    const LAS unsigned char* kp0 = lds + hi * 1024 + r32 * 16;
    const LAS unsigned char* kx0 = lds + 8192 + r32 * 16;
#define FX_DMA_K(tt) do { const int t_ = (tt) < t_hi ? (tt) : t_hi - 1; const int s_ = (tt) & (ATT_NS - 1); const unsigned l0_ = (unsigned)(uintptr_t)lds; \
        glds16(ksrc + (long)t_ * 64 * rs, (unsigned)__builtin_amdgcn_readfirstlane((int)(l0_ + s_ * ATT_KSLOT + wid * 1024))); \
        if (wid == 0) glds16(kbias + (long)(t_ * 64 + lane) * 64, (unsigned)__builtin_amdgcn_readfirstlane((int)(l0_ + s_ * ATT_KSLOT + 8192))); } while (0)
#define FX_DMA_V(tt) do { const int t_ = (tt) < t_hi ? (tt) : t_hi - 1; const int s_ = (tt) & (ATT_NS - 1); const unsigned l0_ = (unsigned)(uintptr_t)lds; \
        glds16(vsrc + (long)t_ * 64 * rs, (unsigned)__builtin_amdgcn_readfirstlane((int)(l0_ + ATT_VOFF + s_ * 8192 + wid * 1024))); } while (0)
#define FX_WAIT_BAR() do { if (wid == 0) asm volatile("s_waitcnt vmcnt(4) lgkmcnt(0)\n\ts_barrier" ::: "memory"); else asm volatile("s_waitcnt vmcnt(3) lgkmcnt(0)\n\ts_barrier" ::: "memory"); } while (0)
#define FX_KLOAD2(kp_, d0) do { kf[2 * (d0)] = *(const LAS bf16x8*)((kp_) + (d0) * 2048); kf[2 * (d0) + 1] = *(const LAS bf16x8*)((kp_) + (d0) * 2048 + 512); } while (0)
#define FX_KLOADX(kx_) do { kf[8] = *(const LAS bf16x8*)(kx_); kf[9] = *(const LAS bf16x8*)((kx_) + 512); } while (0)
#define FX_MASK(C0, C1, tt) do { if (64 * (tt) + 63 > qw0) { const int kvb_ = 64 * (tt) + 4 * hi; \
        _Pragma("unroll") for (int r = 0; r < 16; ++r) { const int kv = kvb_ + (r & 3) + 8 * (r >> 2); if (kv > qi) C0[r] = -INFINITY; if (kv + 32 > qi) C1[r] = -INFINITY; } } } while (0)
#define FX_SETREF() do { const float nm_ = -mhat; const unsigned h1_ = cvt_pk_bf16(nm_, 0.f) & 0xffffu; const float r1_ = nm_ - bf_lo(h1_); const unsigned h2_ = cvt_pk_bf16(r1_, 0.f) & 0xffffu; \
        const float r2_ = r1_ - bf_lo(h2_); const unsigned h3_ = cvt_pk_bf16(r2_, 0.f) & 0xffffu; \
        u32x4 q4_; q4_.x = q4d0; q4_.y = hi == 0 ? (0x3F80u | (h1_ << 16)) : 0u; q4_.z = hi == 0 ? (h2_ | (h3_ << 16)) : 0u; q4_.w = 0u; qr[4] = __builtin_bit_cast(bf16x8, q4_); } while (0)
    FX_DMA_K(t_lo); FX_DMA_K(t_lo + 1); FX_DMA_V(t_lo); FX_DMA_K(t_lo + 2); FX_DMA_V(t_lo + 1); FX_DMA_K(t_lo + 3); FX_DMA_V(t_lo + 2);
    bf16x8 qr[5];
#pragma unroll
    for (int d0 = 0; d0 < 4; ++d0) qr[d0] = *(const bf16x8*)(Qp + (long)qi * rs + d0 * 16 + hi * 8);
    unsigned q4d0 = hi == 0 ? 0x3F803F80u : 0u; asm volatile("" : "+v"(q4d0));
    { u32x4 q4_; q4_.x = q4d0; q4_.y = hi == 0 ? 0x3F80u : 0u; q4_.z = 0u; q4_.w = 0u; qr[4] = __builtin_bit_cast(bf16x8, q4_); }
    asm volatile("s_waitcnt vmcnt(0)" : "+v"(qr[0]), "+v"(qr[1]), "+v"(qr[2]), "+v"(qr[3]) :: "memory");
    asm volatile("s_barrier" ::: "memory");
    f32x16 pA0, pA1, pB0, pB1; bf16x8 kf[10]; s16x4 vlo[8], vhi[8]; u32x4 pw0, pw1, pw2, pw3; bool resc = false;
    { const LAS unsigned char* kp_ = kp0 + (t_lo & (ATT_NS - 1)) * ATT_KSLOT;
      FX_KLOAD2(kp_, 0); FX_KLOAD2(kp_, 1); FX_KLOAD2(kp_, 2); FX_KLOAD2(kp_, 3); FX_KLOADX(kx0 + (t_lo & (ATT_NS - 1)) * ATT_KSLOT); }
    pA0 = FX_MF(kf[8], qr[4], (f32x16){}); pA1 = FX_MF(kf[9], qr[4], (f32x16){});
#pragma unroll
    for (int d0 = 0; d0 < 4; ++d0) { pA0 = FX_MF(kf[2 * d0], qr[d0], pA0); pA1 = FX_MF(kf[2 * d0 + 1], qr[d0], pA1); }
    FX_MASK(pA0, pA1, t_lo);
    { const float rm = rowmax_b(pA0, pA1); mhat = rm;
#pragma unroll
      for (int r = 0; r < 16; ++r) { pA0[r] = fexp2(pA0[r] - rm); pA1[r] = fexp2(pA1[r] - rm); }
      FX_SETREF(); }
    { const LAS unsigned char* kp_ = kp0 + ((t_lo + 1) & (ATT_NS - 1)) * ATT_KSLOT;
      FX_KLOAD2(kp_, 0); FX_KLOAD2(kp_, 1); FX_KLOAD2(kp_, 2); FX_KLOAD2(kp_, 3); FX_KLOADX(kx0 + ((t_lo + 1) & (ATT_NS - 1)) * ATT_KSLOT); }
    asm volatile("s_waitcnt lgkmcnt(0)\n\ts_barrier" ::: "memory");
#define FX_PKW(P, i) cvt_pk_bf16(P[i], P[(i) + 1])
#define FX_PAF(k) __builtin_bit_cast(bf16x8, pw##k)
#define FX_VFR(i) (bf16x8){vlo[i][0], vlo[i][1], vlo[i][2], vlo[i][3], vhi[i][0], vhi[i][1], vhi[i][2], vhi[i][3]}
#define FX_VRD(i) do { vlo[i] = vtr(vp_ + (((i) >> 2) * 4096 + ((i) & 3) * 1024)); vhi[i] = vtr(vp_ + (((i) >> 2) * 4096 + ((i) & 3) * 1024 + 512)); } while (0)
#define FX_GAPA(MF, a0, a1, a2, W0, W1, PW) do { MF; sacc += a0; sacc += a1; sacc += a2; W0; W1; FX_PIN(PW); FX_PIN(sacc); FX_SBAR(); } while (0)
#define FX_GAPA3(MF, a0, a1, a2) do { MF; sacc += a0; sacc += a1; sacc += a2; FX_PIN(sacc); FX_SBAR(); } while (0)
#define FX_GAPB(MF, X, i) do { MF; X[i] = fexp2(X[i]); X[(i) + 1] = fexp2(X[(i) + 1]); X[(i) + 2] = fexp2(X[(i) + 2]); X[(i) + 3] = fexp2(X[(i) + 3]); FX_PIN(X); FX_SBAR(); } while (0)
#define FX_STEP(C0, C1, P0, P1, t, MASK) do { FX_SBAR(); \
    const LAS unsigned char* vp_ = vp0 + (((t) - 1) & (ATT_NS - 1)) * 8192; \
    FX_VRD(0); FX_SBAR(); float sacc = P0[0] + P0[1]; \
                       FX_GAPA(C0 = FX_MF(kf[8], qr[4], (f32x16){}), P0[2], P0[3], P0[4],    pw0[0] = FX_PKW(P0, 0),  pw0[1] = FX_PKW(P0, 2),  pw0); \
    FX_VRD(4); FX_SBAR(); FX_GAPA(C1 = FX_MF(kf[9], qr[4], (f32x16){}), P0[5], P0[6], P0[7],    pw0[2] = FX_PKW(P0, 4),  pw0[3] = FX_PKW(P0, 6),  pw0); \
    FX_VRD(1); FX_SBAR(); FX_GAPA(C0 = FX_MF(kf[0], qr[0], C0),   P0[8], P0[9], P0[10],   pw1[0] = FX_PKW(P0, 8),  pw1[1] = FX_PKW(P0, 10), pw1); \
    FX_VRD(5); FX_SBAR(); FX_GAPA(C1 = FX_MF(kf[1], qr[0], C1),   P0[11], P0[12], P0[13], pw1[2] = FX_PKW(P0, 12), pw1[3] = FX_PKW(P0, 14), pw1); \
    FX_VRD(2); FX_SBAR(); FX_GAPA(C0 = FX_MF(kf[2], qr[1], C0),   P0[14], P0[15], P1[0],  pw2[0] = FX_PKW(P1, 0),  pw2[1] = FX_PKW(P1, 2),  pw2); \
    FX_VRD(6); FX_SBAR(); FX_GAPA(C1 = FX_MF(kf[3], qr[1], C1),   P1[1], P1[2], P1[3],    pw2[2] = FX_PKW(P1, 4),  pw2[3] = FX_PKW(P1, 6),  pw2); \
    FX_VRD(3); FX_SBAR(); FX_GAPA(C0 = FX_MF(kf[4], qr[2], C0),   P1[4], P1[5], P1[6],    pw3[0] = FX_PKW(P1, 8),  pw3[1] = FX_PKW(P1, 10), pw3); \
    FX_VRD(7); FX_SBAR(); FX_GAPA(C1 = FX_MF(kf[5], qr[2], C1),   P1[7], P1[8], P1[9],    pw3[2] = FX_PKW(P1, 12), pw3[3] = FX_PKW(P1, 14), pw3); \
    FX_GAPA3(C0 = FX_MF(kf[6], qr[3], C0), P1[10], P1[11], P1[12]); \
    FX_GAPA3(C1 = FX_MF(kf[7], qr[3], C1), P1[13], P1[14], P1[15]); \
    lrun += sacc; \
    FX_DMA_K((t) + 3); FX_DMA_V((t) + 2);                                  \
    if (MASK) FX_MASK(C0, C1, t); \
    { const float rm = rowmax_b(C0, C1); resc = false;                     \
      if (__builtin_expect(__any(rm > THR), 0)) { const float dl = __builtin_fmaxf(rm, 0.f); mhat += dl;        \
          _Pragma("unroll") for (int r = 0; r < 16; ++r) { C0[r] -= dl; C1[r] -= dl; } \
          FX_SETREF(); \
          const float f = fexp2(-dl); lrun *= f; if (hi == 0) wsf[r32] = f; resc = true; } } \
    FX_SBAR(); \
    const LAS unsigned char* kp_ = kp0 + (((t) + 1) & (ATT_NS - 1)) * ATT_KSLOT; \
    FX_GAPB(o[0] = FX_MF(FX_PAF(0), FX_VFR(0), o[0]), C0, 0);                              FX_GAPB(o[1] = FX_MF(FX_PAF(0), FX_VFR(4), o[1]), C0, 4); \
    FX_KLOAD2(kp_, 0); FX_SBAR(); FX_GAPB(o[0] = FX_MF(FX_PAF(1), FX_VFR(1), o[0]), C0, 8);   FX_KLOAD2(kp_, 1); FX_SBAR(); FX_GAPB(o[1] = FX_MF(FX_PAF(1), FX_VFR(5), o[1]), C0, 12); \
    FX_KLOAD2(kp_, 2); FX_SBAR(); FX_GAPB(o[0] = FX_MF(FX_PAF(2), FX_VFR(2), o[0]), C1, 0);   FX_KLOAD2(kp_, 3); FX_SBAR(); FX_GAPB(o[1] = FX_MF(FX_PAF(2), FX_VFR(6), o[1]), C1, 4); \
    FX_KLOADX(kx0 + (((t) + 1) & (ATT_NS - 1)) * ATT_KSLOT); FX_SBAR(); FX_GAPB(o[0] = FX_MF(FX_PAF(3), FX_VFR(3), o[0]), C1, 8);   FX_GAPB(o[1] = FX_MF(FX_PAF(3), FX_VFR(7), o[1]), C1, 12); \
    FX_WAIT_BAR(); \
    if (resc) { _Pragma("unroll") for (int g = 0; g < 4; ++g) { const f32x4 fv = *(const LAS f32x4*)(wsf + 8 * g + 4 * hi); \
        _Pragma("unroll") for (int k = 0; k < 4; ++k) { o[0][4 * g + k] *= fv[k]; o[1][4 * g + k] *= fv[k]; } } } \
    } while (0)
#define FX_DRAIN(P0, P1) do { float sacc = P0[0] + P0[1]; \
      _Pragma("unroll") for (int r = 2; r < 16; ++r) sacc += P0[r]; \
      _Pragma("unroll") for (int r = 0; r < 16; ++r) sacc += P1[r]; \
      lrun += sacc; \
      pw0 = (u32x4){FX_PKW(P0, 0), FX_PKW(P0, 2), FX_PKW(P0, 4), FX_PKW(P0, 6)}; pw1 = (u32x4){FX_PKW(P0, 8), FX_PKW(P0, 10), FX_PKW(P0, 12), FX_PKW(P0, 14)}; \
      pw2 = (u32x4){FX_PKW(P1, 0), FX_PKW(P1, 2), FX_PKW(P1, 4), FX_PKW(P1, 6)}; pw3 = (u32x4){FX_PKW(P1, 8), FX_PKW(P1, 10), FX_PKW(P1, 12), FX_PKW(P1, 14)}; \
      const LAS unsigned char* vp_ = vp0 + ((t_hi - 1) & (ATT_NS - 1)) * 8192; _Pragma("unroll") for (int i = 0; i < 8; ++i) FX_VRD(i); \
      o[0] = FX_MF(FX_PAF(0), FX_VFR(0), o[0]); o[1] = FX_MF(FX_PAF(0), FX_VFR(4), o[1]); o[0] = FX_MF(FX_PAF(1), FX_VFR(1), o[0]); o[1] = FX_MF(FX_PAF(1), FX_VFR(5), o[1]); \
      o[0] = FX_MF(FX_PAF(2), FX_VFR(2), o[0]); o[1] = FX_MF(FX_PAF(2), FX_VFR(6), o[1]); o[0] = FX_MF(FX_PAF(3), FX_VFR(3), o[0]); o[1] = FX_MF(FX_PAF(3), FX_VFR(7), o[1]); } while (0)
    int t = t_lo + 1; const int t_band = t_hi - 4;
    for (; t + 1 < t_band; t += 2) {
        FX_STEP(pB0, pB1, pA0, pA1, t, false);
        FX_STEP(pA0, pA1, pB0, pB1, t + 1, false);
    }
    for (; t + 1 < t_hi; t += 2) {
        FX_STEP(pB0, pB1, pA0, pA1, t, true);
        FX_STEP(pA0, pA1, pB0, pB1, t + 1, true);
    }
    if (t < t_hi) { FX_STEP(pB0, pB1, pA0, pA1, t, true); FX_DRAIN(pB0, pB1); } else FX_DRAIN(pA0, pA1);
    const float ltot = swap_add(lrun);
    if (hi == 0) wsf[32 + r32] = ltot;
    asm volatile("s_waitcnt lgkmcnt(0)" ::: "memory");
    LAS bf16_t* stg = (LAS bf16_t*)(lds + ATT_OST) + wid * 2048;
#pragma unroll
    for (int g = 0; g < 4; ++g) { const f32x4 lv = *(const LAS f32x4*)(wsf + 32 + 8 * g + 4 * hi);
#pragma unroll
        for (int k = 0; k < 4; ++k) { const int r = 4 * g + k; const float rl = frcp(lv[k]); LAS bf16_t* srow = stg + crow(r, hi) * 64 + r32;
            srow[0] = (bf16_t)(cvt_pk_bf16(o[0][r] * rl, 0.f) & 0xffffu); srow[32] = (bf16_t)(cvt_pk_bf16(o[1][r] * rl, 0.f) & 0xffffu); } }
    asm volatile("s_waitcnt lgkmcnt(0)" ::: "memory");
#pragma unroll
    for (int i = 0; i < 4; ++i) { const int row = i * 8 + (lane >> 3), ch = lane & 7; const u32x4 v = *(const LAS u32x4*)(stg + row * 64 + ch * 8); *(u32x4*)(Op + (long)(qw0 + row) * os + ch * 8) = v; }
    ATT_WAITBAR();
#undef FX_SBAR
#undef FX_SETREF
#undef FX_PIN
#undef FX_MF
#undef FX_DMA_K
#undef FX_DMA_V
#undef FX_WAIT_BAR
#undef FX_KLOAD2
#undef FX_KLOADX
#undef FX_MASK
#undef FX_PKW
#undef FX_PAF
#undef FX_VFR
#undef FX_VRD
#undef FX_GAPA
#undef FX_GAPA3
#undef FX_GAPB
#undef FX_STEP
#undef FX_DRAIN
}

template <bool ISO>
__device__ __forceinline__ void dil_sweep(LAS unsigned char* lds, LAS float* wsf_all, const bf16_t* Qp, const bf16_t* Kp, const bf16_t* Vp, const long rs, const int B0, const int NB,
                                          bf16_t* Op, const long os, float* lsep, const long ls, const long bst, const long obst, const long lbst) {
    int tid = threadIdx.x; asm volatile("" : "+v"(tid));
    const int lane = tid & 63, r32 = lane & 31, hi = lane >> 5, wid = __builtin_amdgcn_readfirstlane(tid >> 6);
    LAS float* wsf = wsf_all + wid * 64;
    const int NT = 4 * (B0 + NB), T0 = ISO ? 4 * B0 : (B0 > 0 ? 4 * B0 - 2 : 0), wh = wid >> 1;
    constexpr float THR = 30.0f;
    float mhat = 0.f, lrun = 0.f; bool started = false; f32x16 o[2]; o[0] = f32x16{}; o[1] = f32x16{};
    f32x16 negm = f32x16{};
    const bf16_t* ksrc = Kp + (long)lane * rs + wid * 8;
    const bf16_t* vsrc = Vp + (long)(16 * (wid & 3) + (lane >> 2)) * rs + (wid >> 2) * 32 + (lane & 3) * 8;
    const LAS unsigned char* vp0 = lds + ATT_VOFF + ((lane >> 4) & 1) * 32 + (lane & 3) * 8 + (4 * hi + ((lane & 15) >> 2)) * 64;
    LAS bf16_t* stg = (LAS bf16_t*)(lds + ATT_OST) + wid * 2048;
#define DS_ISSUE(tt) do { const int t_ = (tt) < NT ? (tt) : NT - 1; const int s_ = (tt) & (ATT_NS - 1); const unsigned l0_ = (unsigned)(uintptr_t)lds; \
        const long to_ = ISO ? (long)(t_ >> 2) * bst + (long)(t_ & 3) * 64 * rs : (long)t_ * 64 * rs; \
        glds16(ksrc + to_, (unsigned)__builtin_amdgcn_readfirstlane((int)(l0_ + s_ * ATT_KSLOT + wid * 1024))); \
        glds16(vsrc + to_, (unsigned)__builtin_amdgcn_readfirstlane((int)(l0_ + ATT_VOFF + s_ * 8192 + wid * 1024))); } while (0)
#define DS_QDMA(bq) do { const unsigned sb_ = (unsigned)(uintptr_t)stg; \
        _Pragma("unroll") for (int i_ = 0; i_ < 4; ++i_) glds16(Qp + (ISO ? (long)(bq) * bst : (long)256 * (bq) * rs) + (long)(32 * wid + 8 * i_ + (lane >> 3)) * rs + (lane & 7) * 8, (unsigned)__builtin_amdgcn_readfirstlane((int)(sb_ + i_ * 1024))); } while (0)
#define DS_WAITBAR(n) do { asm volatile("s_waitcnt vmcnt(" #n ") lgkmcnt(0)" ::: "memory"); __builtin_amdgcn_s_barrier(); asm volatile("" ::: "memory"); } while (0)
    DS_ISSUE(T0); DS_ISSUE(T0 + 1); DS_ISSUE(T0 + 2); DS_QDMA(B0);
    DS_WAITBAR(0);
    bf16x8 qr[4]; f32x16 p0 = f32x16{}, p1 = f32x16{};
#pragma unroll
    for (int d0 = 0; d0 < 4; ++d0) qr[d0] = bf16x8{};
    for (int t = T0; t <= NT; ++t) {
        const int u = t - 4 * B0 - wh + 2, rel = u & 3, blk = B0 + (u >> 2);
        const bool act = (u >= 0) && (rel != 3) && (blk < B0 + NB) && (!ISO || t >= 4 * blk);
        if (rel == 0) DS_WAITBAR(2); else DS_WAITBAR(4);
        if (rel == 3 && u > 0 && blk < B0 + NB) {
            const int qw0 = (ISO ? 0 : 256 * blk) + 32 * wid, qi = qw0 + r32;
            bf16_t* Ob_ = Op + (ISO ? (long)blk * obst : 0L); float* lb_ = lsep + (ISO ? (long)blk * lbst : 0L);
            const float ltot = swap_add(lrun);
            if (hi == 0) { wsf[32 + r32] = ltot; lb_[(long)qi * ls] = mhat + __builtin_amdgcn_logf(ltot); }
            asm volatile("s_waitcnt lgkmcnt(0)" ::: "memory");
#pragma unroll
            for (int g = 0; g < 4; ++g) { const f32x4 lv = *(const LAS f32x4*)(wsf + 32 + 8 * g + 4 * hi);
#pragma unroll
                for (int k = 0; k < 4; ++k) { const int r = 4 * g + k; const float rl = frcp(lv[k]); LAS bf16_t* srow = stg + crow(r, hi) * 64 + r32;
                    srow[0] = (bf16_t)(cvt_pk_bf16(o[0][r] * rl, 0.f) & 0xffffu); srow[32] = (bf16_t)(cvt_pk_bf16(o[1][r] * rl, 0.f) & 0xffffu); } }
            asm volatile("s_waitcnt lgkmcnt(0)" ::: "memory");
#pragma unroll
            for (int i = 0; i < 4; ++i) { const int row = i * 8 + (lane >> 3), ch = lane & 7; const u32x4 v = *(const LAS u32x4*)(stg + row * 64 + ch * 8); *(u32x4*)(Ob_ + (long)(qw0 + row) * os + ch * 8) = v; }
            if (blk + 1 < B0 + NB) DS_QDMA(blk + 1);
        }
        DS_ISSUE(t + 3);
        if (act) {
            const int qw0 = (ISO ? 0 : 256 * blk) + 32 * wid, qi = qw0 + r32, tk = ISO ? t - 4 * blk : t;
            if (ISO ? (t == 4 * blk + (wh > 2 ? wh - 2 : 0)) : (rel == 0 || t == 0)) {
#pragma unroll
                for (int d0 = 0; d0 < 4; ++d0) qr[d0] = *(const LAS bf16x8*)((const LAS unsigned char*)stg + r32 * 128 + d0 * 32 + hi * 16);
                asm volatile("s_waitcnt lgkmcnt(0)" : "+v"(qr[0]), "+v"(qr[1]), "+v"(qr[2]), "+v"(qr[3]) :: "memory");
                o[0] = f32x16{}; o[1] = f32x16{}; negm = f32x16{}; mhat = 0.f; lrun = 0.f; started = false;
            }
            { const LAS unsigned char* Ks_ = lds + (t & (ATT_NS - 1)) * ATT_KSLOT; const LAS unsigned char* kb_ = Ks_ + hi * 1024 + r32 * 16; bf16x8 kf[8];
#pragma unroll
              for (int d0_ = 0; d0_ < 4; ++d0_) { kf[2 * d0_] = *(const LAS bf16x8*)(kb_ + d0_ * 2048); kf[2 * d0_ + 1] = *(const LAS bf16x8*)(kb_ + d0_ * 2048 + 512); }
              asm volatile("s_waitcnt lgkmcnt(0)" : "+v"(kf[0]), "+v"(kf[1]), "+v"(kf[2]), "+v"(kf[3]), "+v"(kf[4]), "+v"(kf[5]), "+v"(kf[6]), "+v"(kf[7]) :: "memory");
              p0 = __builtin_amdgcn_mfma_f32_32x32x16_bf16(kf[0], qr[0], negm, 0, 0, 0);
              p1 = __builtin_amdgcn_mfma_f32_32x32x16_bf16(kf[1], qr[0], negm, 0, 0, 0);
#pragma unroll
              for (int d0_ = 1; d0_ < 4; ++d0_) {
                  p0 = __builtin_amdgcn_mfma_f32_32x32x16_bf16(kf[2 * d0_], qr[d0_], p0, 0, 0, 0);
                  p1 = __builtin_amdgcn_mfma_f32_32x32x16_bf16(kf[2 * d0_ + 1], qr[d0_], p1, 0, 0, 0); }
              asm volatile("s_nop 15\n\ts_nop 7" : "+v"(p0), "+v"(p1)); }
            s16x4 vlo[8], vhi[8];
            { const LAS unsigned char* vp_ = vp0 + (t & (ATT_NS - 1)) * 8192;
#pragma unroll
              for (int i = 0; i < 8; ++i) { vlo[i] = vtr(vp_ + ((i >> 2) * 4096 + (i & 3) * 1024)); vhi[i] = vtr(vp_ + ((i >> 2) * 4096 + (i & 3) * 1024 + 512)); } }
            __builtin_amdgcn_sched_barrier(0);
            if (64 * tk + 63 > qw0 || 64 * tk < qw0 + 31 - 128) { const int kvb = 64 * tk + 4 * hi;
#pragma unroll
                for (int r = 0; r < 16; ++r) { const int dd = qi - (kvb + (r & 3) + 8 * (r >> 2)); if (dd < 0 || dd > 128) p0[r] = -INFINITY; if (dd - 32 < 0 || dd - 32 > 128) p1[r] = -INFINITY; }
            }
            const float rm = rowmax_fast(p0, p1);
            const bool need = started ? (rm > THR) : (rm > -1.0e30f);
            bool resc = false;
            if (__any(need)) {
                const float dl = need ? rm : 0.f; mhat += dl;
#pragma unroll
                for (int r = 0; r < 16; ++r) { p0[r] -= dl; p1[r] -= dl; }
#pragma unroll
                for (int r = 0; r < 16; ++r) negm[r] = -mhat;
                const float f = (need && started) ? fexp2(-dl) : 1.0f; lrun *= f; started = started || need;
                if (hi == 0) wsf[r32] = f; resc = true;
            }
#pragma unroll
            for (int r = 0; r < 16; ++r) { p0[r] = fexp2(p0[r]); p1[r] = fexp2(p1[r]); }
            if (resc) {
                asm volatile("s_waitcnt lgkmcnt(0)" ::: "memory");
#pragma unroll
                for (int g = 0; g < 4; ++g) { const f32x4 fv = *(const LAS f32x4*)(wsf + 8 * g + 4 * hi);
#pragma unroll
                    for (int k = 0; k < 4; ++k) { o[0][4 * g + k] *= fv[k]; o[1][4 * g + k] *= fv[k]; } }
            }
            u32x4 pw0, pw1, pw2, pw3;
            pw0 = (u32x4){cvt_pk_bf16(p0[0], p0[1]), cvt_pk_bf16(p0[2], p0[3]), cvt_pk_bf16(p0[4], p0[5]), cvt_pk_bf16(p0[6], p0[7])};
            pw1 = (u32x4){cvt_pk_bf16(p0[8], p0[9]), cvt_pk_bf16(p0[10], p0[11]), cvt_pk_bf16(p0[12], p0[13]), cvt_pk_bf16(p0[14], p0[15])};
            pw2 = (u32x4){cvt_pk_bf16(p1[0], p1[1]), cvt_pk_bf16(p1[2], p1[3]), cvt_pk_bf16(p1[4], p1[5]), cvt_pk_bf16(p1[6], p1[7])};
            pw3 = (u32x4){cvt_pk_bf16(p1[8], p1[9]), cvt_pk_bf16(p1[10], p1[11]), cvt_pk_bf16(p1[12], p1[13]), cvt_pk_bf16(p1[14], p1[15])};
#define DS_VF(i) (bf16x8){vlo[i][0], vlo[i][1], vlo[i][2], vlo[i][3], vhi[i][0], vhi[i][1], vhi[i][2], vhi[i][3]}
#define DS_GP(d, PW, i, P, r0) do { o[d] = __builtin_amdgcn_mfma_f32_32x32x16_bf16(__builtin_bit_cast(bf16x8, PW), DS_VF(i), o[d], 0, 0, 0); \
        ps += P[r0]; ps += P[(r0) + 1]; ps += P[(r0) + 2]; ps += P[(r0) + 3]; asm volatile("" : "+v"(ps)); __builtin_amdgcn_sched_barrier(0); } while (0)
            { float ps = 0.f; __builtin_amdgcn_sched_barrier(0);
              DS_GP(0, pw0, 0, p0, 0); DS_GP(1, pw0, 4, p0, 4); DS_GP(0, pw1, 1, p0, 8); DS_GP(1, pw1, 5, p0, 12);
              DS_GP(0, pw2, 2, p1, 0); DS_GP(1, pw2, 6, p1, 4); DS_GP(0, pw3, 3, p1, 8); DS_GP(1, pw3, 7, p1, 12);
              lrun += ps; }
#undef DS_VF
#undef DS_GP
        }
    }
    ATT_WAITBAR();
#undef DS_ISSUE
#undef DS_QDMA
#undef DS_WAITBAR
}

__device__ __forceinline__ void xattn_unit(LAS unsigned char* lds, LAS float* wsf_all, const bf16_t* Qp, const bf16_t* Kp, const bf16_t* Vp, bf16_t* Op) {
    int tid = threadIdx.x; asm volatile("" : "+v"(tid));
    const int lane = tid & 63, r32 = lane & 31, hi = lane >> 5, wid = __builtin_amdgcn_readfirstlane(tid >> 6);
    LAS float* wsf = wsf_all + wid * 64;
    const int qi = wid * 32 + r32;
#define XA_ISSUE(s_) do { const unsigned sl_ = (unsigned)(uintptr_t)lds + ((s_) & 3) * 32768; \
        if ((s_) < 4) { _Pragma("unroll") for (int i_ = 0; i_ < 4; ++i_) { const int c_ = wid + 8 * i_; \
            glds16(Kp + (long)((s_) * 64 + lane) * D + c_ * 8, (unsigned)__builtin_amdgcn_readfirstlane((int)(sl_ + c_ * 1024))); } } \
        else { _Pragma("unroll") for (int i_ = 0; i_ < 4; ++i_) { const int pi_ = wid + 8 * i_, db_ = pi_ >> 2, kg_ = pi_ & 3; \
            glds16(Vp + (long)(((s_) - 4) * 64 + 16 * kg_ + (lane >> 2)) * D + db_ * 32 + (lane & 3) * 8, (unsigned)__builtin_amdgcn_readfirstlane((int)(sl_ + pi_ * 1024))); } } } while (0)
#define XA_WAITBAR(n) do { asm volatile("s_waitcnt vmcnt(" #n ") lgkmcnt(0)" ::: "memory"); __builtin_amdgcn_s_barrier(); asm volatile("" ::: "memory"); } while (0)
    XA_ISSUE(0);
    bf16x8 qr[16];
#pragma unroll
    for (int d0 = 0; d0 < 16; ++d0) qr[d0] = *(const bf16x8*)(Qp + (long)qi * D + d0 * 16 + hi * 8);
    asm volatile("s_waitcnt vmcnt(0)" : "+v"(qr[0]), "+v"(qr[1]), "+v"(qr[2]), "+v"(qr[3]), "+v"(qr[4]), "+v"(qr[5]), "+v"(qr[6]), "+v"(qr[7]),
                 "+v"(qr[8]), "+v"(qr[9]), "+v"(qr[10]), "+v"(qr[11]), "+v"(qr[12]), "+v"(qr[13]), "+v"(qr[14]), "+v"(qr[15]) :: "memory");
    XA_ISSUE(1); XA_ISSUE(2); XA_ISSUE(3);
    __builtin_amdgcn_s_barrier(); asm volatile("" ::: "memory");
    f32x16 p[4][2];
#pragma unroll
    for (int s = 0; s < 4; ++s) {
        if (s > 0) { XA_WAITBAR(8);
                     XA_ISSUE(s + 3); }
        p[s][0] = f32x16{}; p[s][1] = f32x16{};
        qkt<16>(p[s][0], p[s][1], lds + (s & 3) * 32768, qr, r32, hi);
    }
    float a = NEG;
#pragma unroll
    for (int s = 0; s < 4; ++s)
#pragma unroll
        for (int r = 0; r < 16; ++r) a = fmaxf(a, fmaxf(p[s][0][r], p[s][1][r]));
    const float mx = swap_max(a);
    float ps = 0.f; u32x4 pw[4][4];
#pragma unroll
    for (int s = 0; s < 4; ++s) {
#pragma unroll
        for (int r = 0; r < 16; ++r) { p[s][0][r] = fexp2(p[s][0][r] - mx); p[s][1][r] = fexp2(p[s][1][r] - mx); ps += p[s][0][r] + p[s][1][r]; }
#pragma unroll
        for (int h2 = 0; h2 < 2; ++h2) {
            pw[s][2 * h2] = (u32x4){cvt_pk_bf16(p[s][h2][0], p[s][h2][1]), cvt_pk_bf16(p[s][h2][2], p[s][h2][3]), cvt_pk_bf16(p[s][h2][4], p[s][h2][5]), cvt_pk_bf16(p[s][h2][6], p[s][h2][7])};
            pw[s][2 * h2 + 1] = (u32x4){cvt_pk_bf16(p[s][h2][8], p[s][h2][9]), cvt_pk_bf16(p[s][h2][10], p[s][h2][11]), cvt_pk_bf16(p[s][h2][12], p[s][h2][13]), cvt_pk_bf16(p[s][h2][14], p[s][h2][15])}; }
    }
    const float ltot = swap_add(ps);
    f32x16 o[8];
#pragma unroll
    for (int d0 = 0; d0 < 8; ++d0) o[d0] = f32x16{};
    const unsigned vb0 = (unsigned)(uintptr_t)lds + ((lane >> 4) & 1) * 32 + (lane & 3) * 8 + (4 * hi + ((lane & 15) >> 2)) * 64;
#pragma unroll
    for (int s = 4; s < 8; ++s) {
        if (s < 6) XA_WAITBAR(8); else if (s == 6) XA_WAITBAR(4); else XA_WAITBAR(0);
        if (s == 4) XA_ISSUE(7);
        pv<8>(o, vb0 + (s & 3) * 32768, __builtin_bit_cast(bf16x8, pw[s - 4][0]), __builtin_bit_cast(bf16x8, pw[s - 4][1]), __builtin_bit_cast(bf16x8, pw[s - 4][2]), __builtin_bit_cast(bf16x8, pw[s - 4][3]));
    }
#undef XA_ISSUE
    if (hi == 0) wsf[32 + r32] = ltot;
    XA_WAITBAR(0);
#undef XA_WAITBAR
    LAS bf16_t* stg = (LAS bf16_t*)(lds + wid * 16384);
#pragma unroll
    for (int g = 0; g < 4; ++g) { const f32x4 lv = *(const LAS f32x4*)(wsf + 32 + 8 * g + 4 * hi);
#pragma unroll
        for (int k = 0; k < 4; ++k) { const int r = 4 * g + k; const float rl = frcp(lv[k]); LAS bf16_t* srow = stg + crow(r, hi) * 256 + r32;
#pragma unroll
            for (int d0 = 0; d0 < 8; ++d0) srow[d0 * 32] = (bf16_t)(cvt_pk_bf16(o[d0][r] * rl, 0.f) & 0xffffu); } }
    asm volatile("s_waitcnt lgkmcnt(0)" ::: "memory");
#pragma unroll
    for (int i = 0; i < 16; ++i) { const int row = i * 2 + (lane >> 5), ch = lane & 31; const u32x4 v = *(const LAS u32x4*)(stg + row * 256 + ch * 8); *(u32x4*)(Op + (long)(wid * 32 + row) * D + ch * 8) = v; }
    ATT_WAITBAR();
}
}

constexpr size_t MiB = 1u << 20;
constexpr size_t WS_CTL = 0, CTL_ZERO_BYTES = 1 * MiB;
constexpr size_t WS_ROPE = 1 * MiB;
constexpr size_t WS_FLOG = 3 * MiB;
constexpr size_t WS_CL = 4 * MiB;
constexpr size_t WS_LSE = 5 * MiB;
constexpr size_t WS_TOKE = 8 * MiB;
constexpr size_t WS_TOKW = WS_TOKE + 256 * 1024;
constexpr size_t WS_TOKP = WS_TOKW + 256 * 1024;
constexpr size_t WS_SLOC = 9 * MiB;
constexpr size_t WS_POW = 25 * MiB;
constexpr size_t WS_BBAR = 28 * MiB;
constexpr size_t WS_KMAT = 29 * MiB;
constexpr size_t WS_ONES = 33 * MiB, WS_ZEROS = 33 * MiB + 4096, WS_STATS = 33 * MiB + 65536;
constexpr size_t WS_XB = 34 * MiB;
constexpr size_t WS_WL = 98 * MiB;
constexpr size_t WL_WIN = 0, WL_WGLU = 13 * MiB, WL_WB = WL_WGLU + MiB / 2, WL_WOUT = WL_WB + 3 * MiB, WL_XQ = WL_WOUT + 2 * MiB, WL_XO = WL_XQ + 2 * MiB, WL_TF = WL_XO + 2 * MiB, WL_E = WL_TF + 20 * MiB;
constexpr size_t WS_FFNW = 148 * MiB;
constexpr size_t WS_UG = 214 * MiB;
constexpr size_t WS_QKV = 254 * MiB;
constexpr size_t WS_YS = 446 * MiB;
constexpr size_t WS_KBIAS = 606 * MiB;
constexpr size_t WS_ZH = 610 * MiB;
constexpr size_t WS_END = 674 * MiB;
static_assert(WL_E + 4 * MiB + MiB / 4 <= 50 * MiB, "WL map");
constexpr int CW_TMO = 0, CW_BAR = 4096, CW_CNT = 16384, CW_FILL = 16384 + 2048, CW_QUEUE = 16384 + 4096, CW_NORM = 32768;
constexpr int RING_BYTES = 131072, MISC_OFF = RING_BYTES, WSF_OFF = RING_BYTES + 512, LDS_BYTES = 147456;
constexpr int NWAVES = 8, PTR_OFF = RING_BYTES + 3072;
__device__ __forceinline__ const void* inptr(LAS unsigned char* lds, int k) { const unsigned long long v = ((volatile LAS unsigned long long*)(lds + PTR_OFF))[k];
    const unsigned lo = (unsigned)__builtin_amdgcn_readfirstlane((int)(unsigned)v), hi = (unsigned)__builtin_amdgcn_readfirstlane((int)(unsigned)(v >> 32)); return (const void*)(GAS const void*)(((unsigned long long)hi << 32) | lo); }

typedef GAS unsigned gu32;
#define RLX_AGENT __ATOMIC_RELAXED, __HIP_MEMORY_SCOPE_AGENT

#define XB_TMO      128
#define XB_XCNT(j)  (256  + 64 * (j))
#define XB_XSUB(j)  (1280 + 64 * (j))
#define XB_XGEN(j)  (2304 + 64 * (j))
#define XB_TOP      3328
#define XB_TOPGEN   3392
#define XCD_BAR_WORDS 3456
#define XB_SPIN_CAP (1u << 22)
__device__ __forceinline__ unsigned xb_ld(unsigned* p)              { return __hip_atomic_load(p, __ATOMIC_RELAXED, __HIP_MEMORY_SCOPE_AGENT); }
__device__ __forceinline__ unsigned xb_add(unsigned* p, unsigned v) { return __hip_atomic_fetch_add(p, v, __ATOMIC_RELAXED, __HIP_MEMORY_SCOPE_AGENT); }
__device__ __forceinline__ unsigned xb_xcc_id() { return (unsigned)__builtin_amdgcn_s_getreg((3 << 11) | 20) & 0xFu; }
#define XB_SPIN(cond, bar) do { unsigned _sp = 0; while (cond) { __builtin_amdgcn_s_sleep(1); \
    if ((++_sp & 255u) == 0u) { if (xb_ld(&(bar)[XB_TMO])) break; if (_sp > XB_SPIN_CAP) { atomicAdd(&(bar)[XB_TMO], 1u); break; } } } } while (0)
struct XcdBarrier { unsigned* bar; unsigned x; volatile LAS unsigned* st; };
__device__ __forceinline__ XcdBarrier xcd_barrier_post(unsigned* bar, volatile LAS unsigned* st) {
    XcdBarrier b; b.bar = bar; b.x = xb_xcc_id(); b.st = st;
    if (threadIdx.x == 0) (void)xb_add(&bar[XB_XCNT(b.x)], 1u);
    return b;
}
__device__ __forceinline__ void xcd_barrier_complete(unsigned* bar, unsigned x, unsigned& nloc, unsigned& nx) {
    const unsigned G = gridDim.x * gridDim.y * gridDim.z;
    unsigned sum, cnt, mine, sp = 0u;
    for (;;) {
        sum = 0u; cnt = 0u; mine = 0u;
#pragma unroll
        for (unsigned j = 0; j < 16; ++j) { const unsigned c = xb_ld(&bar[XB_XCNT(j)]); sum += c; cnt += (c > 0u) ? 1u : 0u; mine = (j == x) ? c : mine; }
        if (sum == G) break;
        __builtin_amdgcn_s_sleep(1);
        if ((++sp & 255u) == 0u) { if (xb_ld(&bar[XB_TMO])) break; if (sp > XB_SPIN_CAP) { atomicAdd(&bar[XB_TMO], 1u); break; } }
    }
    nloc = mine > 0u ? mine : 1u; nx = cnt > 0u ? cnt : 1u;
}
__device__ __forceinline__ void xcd_barrier(const XcdBarrier& b) {
    asm volatile("s_waitcnt vmcnt(0)" ::: "memory");
    __syncthreads();
    if (threadIdx.x == 0) {
        unsigned* bar = b.bar;
        __builtin_amdgcn_s_waitcnt(0);
        unsigned nloc = b.st[0], nx = b.st[1];
        if (nloc == 0u) { xcd_barrier_complete(bar, b.x, nloc, nx); b.st[0] = nloc; b.st[1] = nx; }
        const unsigned old = xb_add(&bar[XB_XSUB(b.x)], 1u);
        const unsigned gen = old / nloc;
        if (old + 1u == (gen + 1u) * nloc) {
            __builtin_amdgcn_fence(__ATOMIC_RELEASE, "agent");
            asm volatile("s_waitcnt vmcnt(0)" ::: "memory");
            const unsigned og = xb_add(&bar[XB_TOP], 1u);
            const unsigned tg = og / nx;
            if (og + 1u == (tg + 1u) * nx) xb_add(&bar[XB_TOPGEN], 1u);
            else XB_SPIN(xb_ld(&bar[XB_TOPGEN]) == tg, bar);
            __builtin_amdgcn_fence(__ATOMIC_ACQUIRE, "agent");
            xb_add(&bar[XB_XGEN(b.x)], 1u);
            asm volatile("s_waitcnt vmcnt(0)" ::: "memory");
        } else {
            XB_SPIN(xb_ld(&bar[XB_XGEN(b.x)]) == gen, bar);
            __builtin_amdgcn_fence(__ATOMIC_ACQUIRE, "agent");
            asm volatile("s_waitcnt vmcnt(0)" ::: "memory");
        }
    }
    __syncthreads();
}

__device__ __forceinline__ void conv_mat(int& rot, int gw, int NGW, LAS float* scr, int lane, const float* W, int K, int ldn, int nblk, int mode, bf16_t* WT, int dstrow0) {
    asm volatile("" : "+v"(lane));
    const int nitems = (K / 64) * nblk;
    int it = gw - rot; if (it < 0) it += NGW;
    rot += nitems % NGW; if (rot >= NGW) rot -= NGW;
    const int kr = lane >> 3, n4 = (lane & 7) * 4;
    f32x4 v[8];
#define CM_COL(it_) ((mode == 1 && 32 * ((it_) % nblk) >= 3584) ? 32 * ((it_) % nblk) + 8 : 32 * ((it_) % nblk))
    if (it < nitems) { const float* sp = W + (size_t)(64 * (it / nblk) + kr) * ldn + CM_COL(it) + n4;
#pragma unroll
        for (int i = 0; i < 8; ++i) v[i] = *(const f32x4*)(sp + (size_t)(8 * i) * ldn); }
    while (it < nitems) {
        const int kb = it / nblk, n0 = 32 * (it % nblk), k0 = 64 * kb;
        const int drow = (mode == 2) ? dstrow0 + 256 * (n0 >> 7) + (n0 & 127) : dstrow0 + n0;
#pragma unroll
        for (int i = 0; i < 8; ++i)
#pragma unroll
            for (int q = 0; q < 4; ++q) scr[(8 * i + kr) * 33 + n4 + q] = v[i][q];
        const int nx = it + NGW;
        if (nx < nitems) { const float* sp = W + (size_t)(64 * (nx / nblk) + kr) * ldn + CM_COL(nx) + n4;
#pragma unroll
            for (int i = 0; i < 8; ++i) v[i] = *(const f32x4*)(sp + (size_t)(8 * i) * ldn); }
        asm volatile("" ::: "memory");
        const int c = lane & 7;
#pragma unroll
        for (int j = 0; j < 4; ++j) { const int n = (lane >> 3) + 8 * j; const LAS float* sl = scr + (8 * c) * 33 + n;
            u32x4 o; o.x = cvt_pk_bf16(sl[0 * 33], sl[1 * 33]); o.y = cvt_pk_bf16(sl[2 * 33], sl[3 * 33]); o.z = cvt_pk_bf16(sl[4 * 33], sl[5 * 33]); o.w = cvt_pk_bf16(sl[6 * 33], sl[7 * 33]);
            *(u32x4*)(WT + (size_t)(drow + n) * K + k0 + 8 * c) = o; }
        asm volatile("s_waitcnt lgkmcnt(0)" ::: "memory");
        it = nx;
    }
#undef CM_COL
}
__device__ __forceinline__ void dsincos(double x, double& s, double& c) {
    const double q = __builtin_rint(x * 0.63661977236758134308);
    const double r = (x - q * 1.57079632679489655800) - q * 6.12323399573676603587e-17;
    const double r2 = r * r;
    double sp = 1.0 / 6227020800.0; sp = sp * r2 - 1.0 / 39916800.0; sp = sp * r2 + 1.0 / 362880.0; sp = sp * r2 - 1.0 / 5040.0; sp = sp * r2 + 1.0 / 120.0; sp = sp * r2 - 1.0 / 6.0; sp = sp * r2 + 1.0; sp = sp * r;
    double cp = -1.0 / 87178291200.0; cp = cp * r2 + 1.0 / 479001600.0; cp = cp * r2 - 1.0 / 3628800.0; cp = cp * r2 + 1.0 / 40320.0; cp = cp * r2 - 1.0 / 720.0; cp = cp * r2 + 1.0 / 24.0; cp = cp * r2 - 0.5; cp = cp * r2 + 1.0;
    const int qi = (int)((long long)q & 3);
    s = (qi == 0) ? sp : (qi == 1) ? cp : (qi == 2) ? -sp : -cp;
    c = (qi == 0) ? cp : (qi == 1) ? -sp : (qi == 2) ? -cp : sp;
}

template <int SRC, bool ROUTER, bool FLOG, bool WF32>
__device__ __forceinline__ void ln_pass(int gw, int NGW, int lane, unsigned short* ZH, float* OUT32, const float* xin, bf16_t* XB, float* ST, const float* gam, const float* bet, const float* gp, const float* bp,
                                        const bf16_t* Y2, const int* TOKP, const float* TOKW_in,
                                        const float* wrt, int wrt_ld, const float* brt, int* TOKE, float* TOKW, LAS unsigned* hist, float* FLOGo) {
    f32x4 g4[4], b4[4];
    if (SRC != 2) {
#pragma unroll
        for (int j = 0; j < 4; ++j) { g4[j] = *(const f32x4*)(gam + 4 * lane + 256 * j); b4[j] = *(const f32x4*)(bet + 4 * lane + 256 * j); }
    }
    f32x4 wq[16][2];
    if (ROUTER || FLOG) {
#pragma unroll
        for (int j = 0; j < 4; ++j)
#pragma unroll
            for (int k = 0; k < 4; ++k) { const float* wp = wrt + (size_t)(4 * lane + 256 * j + k) * wrt_ld; wq[4 * j + k][0] = *(const f32x4*)wp; wq[4 * j + k][1] = *(const f32x4*)(wp + 4); }
    }
    f32x4 xN[4]; u32x2 hN[4]; f32x2 stN; int p0N, p1N; float w0N, w1N; u32x2 yaC[4], ybC[4];
#define LN_LOAD1(r_) do { if (SRC == 2) { _Pragma("unroll") for (int j = 0; j < 4; ++j) xN[j] = *(const f32x4*)(xin + (size_t)(r_) * D + 4 * lane + 256 * j); } \
        else { _Pragma("unroll") for (int j = 0; j < 4; ++j) hN[j] = *(const u32x2*)(ZH + (size_t)(r_) * D + 4 * lane + 256 * j); \
            if (SRC == 1) { stN = *(const f32x2*)(ST + (size_t)(r_) * 2); p0N = TOKP[2 * (r_)]; p1N = TOKP[2 * (r_) + 1]; w0N = TOKW_in[2 * (r_)]; w1N = TOKW_in[2 * (r_) + 1]; } } } while (0)
#define LN_LOAD2() do { if (SRC == 1) { _Pragma("unroll") for (int j = 0; j < 4; ++j) { yaC[j] = *(const u32x2*)(Y2 + (size_t)p0N * D + 4 * lane + 256 * j); ybC[j] = *(const u32x2*)(Y2 + (size_t)p1N * D + 4 * lane + 256 * j); } } } while (0)
    LN_LOAD1(gw); LN_LOAD2();
    for (int row = gw; row < T; row += NGW) {
        f32x4 v[4]; u32x2 hC[4]; f32x2 stp; float w0, w1; u32x2 ya[4], yb[4];
        if (SRC == 1) { stp = stN; w0 = w0N; w1 = w1N; }
#pragma unroll
        for (int j = 0; j < 4; ++j) { if (SRC == 2) v[j] = xN[j]; else hC[j] = hN[j]; if (SRC == 1) { ya[j] = yaC[j]; yb[j] = ybC[j]; } }
        const int nrow = row + NGW < T ? row + NGW : row;
        LN_LOAD1(nrow);
        if (SRC == 2) {
            if (lane == 0) *(f32x2*)(ST + (size_t)row * 2) = (f32x2){0.f, 1.f};
        } else {
#pragma unroll
            for (int j = 0; j < 4; ++j) { const u32x2 hz = hC[j]; const f32x2 h0 = unpk_f16(hz.x), h1 = unpk_f16(hz.y); v[j] = (f32x4){h0.x, h0.y, h1.x, h1.y}; }
            if (SRC == 1) {
#pragma unroll
                for (int j = 0; j < 4; ++j) { const u32x2 a = ya[j], b = yb[j];
                    const f32x4 gq = *(const f32x4*)(gp + 4 * lane + 256 * j), bq = *(const f32x4*)(bp + 4 * lane + 256 * j);
                    const f32x4 xp = ((v[j] - stp.x) * stp.y) * gq + bq;
                    v[j] = xp * ALPHA + (f32x4){bf_lo(a.x), bf_hi(a.x), bf_lo(a.y), bf_hi(a.y)} * w0 + (f32x4){bf_lo(b.x), bf_hi(b.x), bf_lo(b.y), bf_hi(b.y)} * w1;
                    if (!WF32) { u32x2 hz; hz.x = cvt_pk_f16(v[j][0], v[j][1]); hz.y = cvt_pk_f16(v[j][2], v[j][3]); *(u32x2*)(ZH + (size_t)row * D + 4 * lane + 256 * j) = hz;
                        const f32x2 h0 = unpk_f16(hz.x), h1 = unpk_f16(hz.y); v[j] = (f32x4){h0.x, h0.y, h1.x, h1.y}; } }
            }
            float s = 0.f;
#pragma unroll
            for (int j = 0; j < 4; ++j) s += (v[j][0] + v[j][1]) + (v[j][2] + v[j][3]);
            const float mean = wave_sum(s) * (1.f / D); float s2 = 0.f;
#pragma unroll
            for (int j = 0; j < 4; ++j) { v[j] = v[j] - mean; s2 += (v[j][0] * v[j][0] + v[j][1] * v[j][1]) + (v[j][2] * v[j][2] + v[j][3] * v[j][3]); }
            const float rstd = 1.f / sqrtf(wave_sum(s2) * (1.f / D) + LN_EPS);
            if (!WF32 && lane == 0) *(f32x2*)(ST + (size_t)row * 2) = (f32x2){mean, rstd};
#pragma unroll
            for (int j = 0; j < 4; ++j) v[j] = v[j] * rstd * g4[j] + b4[j];
        }
        LN_LOAD2();
#pragma unroll
        for (int j = 0; j < 4; ++j) { if (WF32) *(f32x4*)(OUT32 + (size_t)row * D + 4 * lane + 256 * j) = v[j];
            u32x2 o; o.x = cvt_pk_bf16(v[j][0], v[j][1]); o.y = cvt_pk_bf16(v[j][2], v[j][3]); *(u32x2*)(XB + (size_t)row * D + 4 * lane + 256 * j) = o; }
        if (ROUTER || FLOG) {
            f32x4 a0 = (f32x4){0.f, 0.f, 0.f, 0.f}, a1 = a0;
#pragma unroll
            for (int j = 0; j < 4; ++j)
#pragma unroll
                for (int k = 0; k < 4; ++k) { a0 += wq[4 * j + k][0] * v[j][k]; a1 += wq[4 * j + k][1] * v[j][k]; }
            float lg[8];
#pragma unroll
            for (int k = 0; k < 4; ++k) { lg[k] = wave_sum(a0[k]); lg[4 + k] = wave_sum(a1[k]); }
            if (FLOG) { if (lane == 0) { *(f32x4*)(FLOGo + (size_t)row * 8) = (f32x4){lg[0], lg[1], lg[2], lg[3]}; *(f32x4*)(FLOGo + (size_t)row * 8 + 4) = (f32x4){lg[4], lg[5], lg[6], lg[7]}; } }
            if (ROUTER) {
#pragma unroll
                for (int k = 0; k < 8; ++k) lg[k] += brt[k];
                int i1 = 0; float v1 = lg[0];
#pragma unroll
                for (int k = 1; k < 8; ++k) if (lg[k] > v1) { v1 = lg[k]; i1 = k; }
                int i2 = -1; float v2 = -3.0e38f;
#pragma unroll
                for (int k = 0; k < 8; ++k) if (k != i1 && lg[k] > v2) { v2 = lg[k]; i2 = k; }
                const float w2 = 1.0f / (1.0f + expf(v1 - v2)), w1 = 1.0f - w2;
                if (lane == 0) { TOKE[2 * row] = i1; TOKE[2 * row + 1] = i2; TOKW[2 * row] = w1; TOKW[2 * row + 1] = w2;
                    __hip_atomic_fetch_add(hist + i1, 1u, __ATOMIC_RELAXED, __HIP_MEMORY_SCOPE_WORKGROUP); __hip_atomic_fetch_add(hist + i2, 1u, __ATOMIC_RELAXED, __HIP_MEMORY_SCOPE_WORKGROUP); }
            }
        }
    }
#undef LN_LOAD1
#undef LN_LOAD2
}

struct Args { const void* in[34]; float* out; unsigned char* ws; int ph_lo, ph_hi; };
constexpr int NPH_TOTAL = 2 + 2 * 13 + 2 * 14;

__global__ void __launch_bounds__(NWAVES * 64, 2) hybrid_fwd(Args args) {
    extern __shared__ __attribute__((aligned(16))) unsigned char lds_raw[];
    LAS unsigned char* lds = (LAS unsigned char*)lds_raw;
    volatile LAS unsigned* MISC = (volatile LAS unsigned*)(lds + MISC_OFF);
    LAS unsigned* hist = (LAS unsigned*)(lds + MISC_OFF + 64);
    LAS float* wsf_all = (LAS float*)(lds + WSF_OFF);
    const int G = gridDim.x; const int bx = blockIdx.x; const int vcu = (G % 8 == 0) ? (bx % 8) * (G / 8) + bx / 8 : bx;
    const int NGW = G * NWAVES, NGT = G * NWAVES * 64;
    unsigned char* ws = args.ws;
    unsigned* ctl = (unsigned*)(ws + WS_CTL);
    for (int u = threadIdx.x; u < (LDS_BYTES - MISC_OFF) / 4; u += NWAVES * 64) ((LAS unsigned*)(lds + MISC_OFF))[u] = 0u;
    __syncthreads();
    const int lo = args.ph_lo, hi = args.ph_hi;
    XcdBarrier bar; bar.bar = ctl + CW_BAR; bar.x = 0; bar.st = nullptr;
    if (hi - lo > 1) bar = xcd_barrier_post(ctl + CW_BAR, MISC + 8);
    int pid = 0;
#define PH_BEGIN if (pid >= lo && pid < hi) { int tid = threadIdx.x; asm volatile("" : "+v"(tid)); const int lane = tid & 63, wave = __builtin_amdgcn_readfirstlane(tid >> 6); \
        const int gw = vcu * NWAVES + wave, gt = vcu * (NWAVES * 64) + tid; LAS float* scr = (LAS float*)(lds + wave * 16384); int rot = 0; (void)rot; unsigned long long wsl_ = (unsigned long long)(uintptr_t)ws; asm volatile("" : "+s"(wsl_)); unsigned char* wsl = (unsigned char*)(GAS unsigned char*)wsl_; (void)lane; (void)gw; (void)gt; (void)scr;
#define PH_END } if (pid >= lo && pid + 1 < hi) xcd_barrier(bar); ++pid;
#define LOAD_TOFF() int toff[9]; { int acc_t = 0; _Pragma("unroll") for (int e = 0; e < 8; ++e) { toff[e] = acc_t; \
        const unsigned c = (unsigned)__builtin_amdgcn_readfirstlane((int)__hip_atomic_load(ctl + CW_CNT + (li2 * 8 + e) * 64, RLX_AGENT)); acc_t += (int)((c + 255u) >> 8); } toff[8] = acc_t; }
#define CONVERT_MIXER(LL) do { const int LL_ = (LL); \
            conv_mat(rot, gw, NGW, scr, lane, w_in + (size_t)LL_ * D * NIN, D, NIN, 208, 1, WIN_T, 0); \
            conv_mat(rot, gw, NGW, scr, lane, w_glu + (size_t)LL_ * 512 * 512, 512, 512, 16, 0, WGLU_T, 0); \
            for (int n = 0; n < 3; ++n) conv_mat(rot, gw, NGW, scr, lane, w_branch + ((size_t)LL_ * 3 + n) * 512 * D, 512, D, 32, 0, WB_T + (size_t)n * D * 512, 0); \
            conv_mat(rot, gw, NGW, scr, lane, w_mix_out + (size_t)LL_ * D * D, D, D, 32, 0, WOUT_T, 0); \
            conv_mat(rot, gw, NGW, scr, lane, w_xq + (size_t)LL_ * D * D, D, D, 32, 0, XQ_T, 0); \
            conv_mat(rot, gw, NGW, scr, lane, w_xo + (size_t)LL_ * D * D, D, D, 32, 0, XO_T, 0); \
    } while (0)
#define CONVERT_FFN(LL) do { const int LL_ = (LL); \
            if (!(LL_ & 1)) { \
                conv_mat(rot, gw, NGW, scr, lane, ffn_wg + (size_t)(LL_ >> 1) * D * DFF, D, DFF, 88, 2, FFN_GU, 0); \
                conv_mat(rot, gw, NGW, scr, lane, ffn_wu + (size_t)(LL_ >> 1) * D * DFF, D, DFF, 88, 2, FFN_GU, 128); \
                conv_mat(rot, gw, NGW, scr, lane, ffn_wd + (size_t)(LL_ >> 1) * DFF * D, DFF, D, 32, 0, FFN_D_DENSE, 0); \
            } else { \
                for (int e = 0; e < NEXP; ++e) { \
                    conv_mat(rot, gw, NGW, scr, lane, moe_wg + ((size_t)(LL_ >> 1) * NEXP + e) * D * DFFE, D, DFFE, 44, 2, FFN_GU + (size_t)e * 2 * DFFE * D, 0); \
                    conv_mat(rot, gw, NGW, scr, lane, moe_wu + ((size_t)(LL_ >> 1) * NEXP + e) * D * DFFE, D, DFFE, 44, 2, FFN_GU + (size_t)e * 2 * DFFE * D, 128); \
                    conv_mat(rot, gw, NGW, scr, lane, moe_wd + ((size_t)(LL_ >> 1) * NEXP + e) * DFFE * D, DFFE, D, 32, 0, FFN_D_MOE + (size_t)e * D * DFFE, 0); \
                } \
            } \
    } while (0)
#define SUBSYNC() do { asm volatile("s_waitcnt vmcnt(0) lgkmcnt(0)" ::: "memory"); __syncthreads(); } while (0)

    if (threadIdx.x < 34) ((LAS unsigned long long*)(lds + PTR_OFF))[threadIdx.x] = (unsigned long long)(uintptr_t)args.in[threadIdx.x];
    __syncthreads();
#define INP(k) ((const float*)inptr(lds, (k)))
#define x_in INP(0)
#define mem_in INP(1)
#define pos_in ((const int*)inptr(lds, 2))
#define w_in INP(3)
#define b_forget INP(4)
#define lam_re INP(5)
#define lam_im INP(6)
#define log_dt INP(7)
#define ssm_bre INP(8)
#define ssm_bim INP(9)
#define ssm_cre INP(10)
#define ssm_cim INP(11)
#define ssm_d INP(12)
#define w_glu INP(13)
#define w_branch INP(14)
#define w_mix_out INP(15)
#define ln_mix_g INP(16)
#define ln_mix_b INP(17)
#define w_xq INP(18)
#define w_xk INP(19)
#define w_xv INP(20)
#define w_xo INP(21)
#define ln_x_g INP(22)
#define ln_x_b INP(23)
#define ffn_wg INP(24)
#define ffn_wu INP(25)
#define ffn_wd INP(26)
#define moe_wr INP(27)
#define moe_br INP(28)
#define moe_wg INP(29)
#define moe_wu INP(30)
#define moe_wd INP(31)
#define ln_ffn_g INP(32)
#define ln_ffn_b INP(33)
    float* OUTF = args.out;
#define ZHP ((unsigned short*)(wsl + WS_ZH))
#define ROPE ((float*)(wsl + WS_ROPE))
#define FLOG ((float*)(wsl + WS_FLOG))
#define KBIAS ((bf16_t*)(wsl + WS_KBIAS))
#define LSE ((float*)(wsl + WS_LSE))
#define TOKE ((int*)(wsl + WS_TOKE))
#define TOKW ((float*)(wsl + WS_TOKW))
#define TOKP ((int*)(wsl + WS_TOKP))
#define INV16 ((unsigned short*)(wsl + WS_TOKP + 256 * 1024))
#define SLOC ((float*)(wsl + WS_SLOC))
#define POW ((f32x2*)(wsl + WS_POW))
#define BBAR ((f32x2*)(wsl + WS_BBAR))
#define KMAT ((float*)(wsl + WS_KMAT))
#define XB ((bf16_t*)(wsl + WS_XB))
#define STATS ((float*)(wsl + WS_STATS))
#define ONESV ((const float*)(wsl + WS_ONES))
#define ZEROSV ((const float*)(wsl + WS_ZEROS))
#define XKV ((bf16_t*)OUTF)
#define WIN_T ((bf16_t*)(wsl + WS_WL + WL_WIN))
#define WGLU_T ((bf16_t*)(wsl + WS_WL + WL_WGLU))
#define WB_T ((bf16_t*)(wsl + WS_WL + WL_WB))
#define WOUT_T ((bf16_t*)(wsl + WS_WL + WL_WOUT))
#define XQ_T ((bf16_t*)(wsl + WS_WL + WL_XQ))
#define XO_T ((bf16_t*)(wsl + WS_WL + WL_XO))
#define TF ((bf16_t*)(wsl + WS_WL + WL_TF))
#define ETAB ((bf16_t*)(wsl + WS_WL + WL_E))
#define FFN_GU ((bf16_t*)(wsl + WS_FFNW))
#define FFN_D_DENSE ((bf16_t*)(wsl + WS_FFNW + 11 * MiB))
#define FFN_D_MOE ((bf16_t*)(wsl + WS_FFNW + 44 * MiB))
#define UG ((bf16_t*)(wsl + WS_UG))
#define YSSM2 ((bf16_t*)(wsl + WS_UG))
#define QKV ((bf16_t*)(wsl + WS_QKV))
#define GATES ((bf16_t*)(wsl + WS_QKV))
#define XQ ((bf16_t*)(wsl + WS_QKV))
#define HBUF ((bf16_t*)(wsl + WS_QKV))
#define WKV_T ((bf16_t*)(wsl + WS_QKV))
#define MEMB ((bf16_t*)(wsl + WS_QKV + 16 * MiB))
#define YSSM ((bf16_t*)(wsl + WS_YS))
#define O1 ((bf16_t*)(wsl + WS_YS + 32 * MiB))
#define O2 ((bf16_t*)(wsl + WS_YS + 64 * MiB))
#define O3 ((bf16_t*)(wsl + WS_YS + 96 * MiB))
#define YFOX ((bf16_t*)(wsl + WS_YS + 128 * MiB))
#define MERGED O2
#define XG ((bf16_t*)(wsl + WS_YS))
#define Y2 ((bf16_t*)(wsl + WS_YS))

    PH_BEGIN
        ln_pass<2, false, true, false>(gw, NGW, lane, ZHP, OUTF, x_in, XB, STATS, nullptr, nullptr, nullptr, nullptr, nullptr, nullptr, nullptr, w_in + 3584, NIN, nullptr, nullptr, nullptr, hist, FLOG);
        for (int it = gt; it < 1024; it += NGT) { ((float*)(wsl + WS_ONES))[it] = 1.0f; ((float*)(wsl + WS_ZEROS))[it] = 0.0f; }
        for (int it = gt; it < T * 8; it += NGT) { const int row = it >> 3, j = it & 7;
            const float inv = (float)exp(-(double)j * 0.125 * 13.122363377404328);
            const float ang = (float)pos_in[row] * inv; double s, c; dsincos((double)ang, s, c);
            ROPE[(size_t)row * 16 + j] = (float)c; ROPE[(size_t)row * 16 + 8 + j] = (float)s; }
        for (int i2 = gt; i2 < DEPTH * 32 * 64 * 33; i2 += NGT) { const int it = i2 / 33, k = i2 - it * 33, g = (it >> 6) & 31, l = it >> 11;
            const double lr = lam_re[it], li = lam_im[it], dt = exp((double)log_dt[l * 32 + g]);
            const double mg = exp(k * dt * lr); double s, c; dsincos(k * dt * li, s, c); POW[(size_t)it * 33 + k] = (f32x2){(float)(mg * c), (float)(mg * s)}; }
        for (int i2 = gt; i2 < DEPTH * 32 * 64 * 16; i2 += NGT) { const int it = i2 >> 4, cc = i2 & 15, g = (it >> 6) & 31, l = it >> 11;
            const double lr = lam_re[it], li = lam_im[it], dt = exp((double)log_dt[l * 32 + g]);
            const double mg = exp(dt * lr); double s, c; dsincos(dt * li, s, c);
            const double nr = mg * c - 1.0, ni = mg * s, den = lr * lr + li * li, qr = (nr * lr + ni * li) / den, qi = (ni * lr - nr * li) / den;
            const double br = ssm_bre[(size_t)it * 16 + cc], bi = ssm_bim[(size_t)it * 16 + cc];
            BBAR[(size_t)it * 16 + cc] = (f32x2){(float)(qr * br - qi * bi), (float)(qr * bi + qi * br)}; }
        for (int it = gt; it < NB * NMEM * D / 4; it += NGT) { const f32x4 v = *(const f32x4*)(mem_in + (size_t)it * 4); u32x2 o; o.x = cvt_pk_bf16(v[0], v[1]); o.y = cvt_pk_bf16(v[2], v[3]); *(u32x2*)(MEMB + (size_t)it * 4) = o; }
        for (int l = 0; l < DEPTH; ++l) { conv_mat(rot, gw, NGW, scr, lane, w_xk + (size_t)l * D * D, D, D, 32, 0, WKV_T + (size_t)(2 * l) * D * D, 0);
                                          conv_mat(rot, gw, NGW, scr, lane, w_xv + (size_t)l * D * D, D, D, 32, 0, WKV_T + (size_t)(2 * l + 1) * D * D, 0); }
        CONVERT_MIXER(0); CONVERT_FFN(0);
    PH_END
    PH_BEGIN
        { SchedBatched S{(const char*)MEMB, (const char*)WKV_T, 0, (size_t)D * D * 2, D, D, 8, 4, 8, G, bx};
          EpiScale E{XKV, D, 1.0f, (size_t)NB * NMEM * D};
          pg8::gemm_phase(lds, D, D, D / 64, S, E); }
        for (int i2 = gt; i2 < DEPTH * 32 * 32 * 16 * 2; i2 += NGT) { const int it = i2 >> 1, hf = i2 & 1, co = it & 15, lag = (it >> 4) & 31, lg = it >> 9;
            float acc[16];
#pragma unroll
            for (int c = 0; c < 16; ++c) acc[c] = 0.f;
            for (int p = 32 * hf; p < 32 * hf + 32; ++p) { const f32x2 pw = POW[((size_t)lg * 64 + p) * 33 + lag]; const float cr = ssm_cre[((size_t)lg * 16 + co) * 64 + p], ci = ssm_cim[((size_t)lg * 16 + co) * 64 + p];
                const float zr = cr * pw.x - ci * pw.y, zi = cr * pw.y + ci * pw.x; const f32x2* bb = BBAR + ((size_t)lg * 64 + p) * 16;
#pragma unroll
                for (int c = 0; c < 16; ++c) acc[c] += zr * bb[c].x - zi * bb[c].y; }
#pragma unroll
            for (int c = 0; c < 16; ++c) acc[c] += __shfl_xor(acc[c], 1);
            if (hf == 0) {
#pragma unroll
                for (int c = 0; c < 16; ++c) KMAT[(((size_t)lg * 32 + lag) * 16 + co) * 16 + c] = acc[c]; } }
    PH_END

    for (int l = 0; l < DEPTH; ++l) {
        const bool moe = (l & 1) != 0; const int li2 = l >> 1;
        PH_BEGIN
            for (int step = 0; step < 2; ++step) { if ((step == 0) != ((vcu & 1) != 0)) {
            { SchedBatched S{(const char*)XB, (const char*)WIN_T, 0, 0, D, D, 128, 14, 1, G, bx};
              EpiInProj E{UG, QKV, ROPE, ctl + CW_NORM + l * 256};
              pg8::gemm_phase(lds, D, D, D / 64, S, E); }
            } else {
            for (int it = gt; it < 32 * 512 * 80; it += NGT) { const int k8 = it % 80, n = (it / 80) & 511, g = it / (80 * 512); const int k0 = 8 * k8, to = n >> 4, co = n & 15; const int lg = l * 32 + g;
                f32x4 a = (f32x4){0.f, 0.f, 0.f, 0.f}, b = a;
                if (k0 < 512) { const int ti = k0 >> 4, ci0 = k0 & 15, lag = to - ti;
                    if (lag >= 0) { const float* kp = KMAT + (((size_t)lg * 32 + lag) * 16 + co) * 16 + ci0; a = *(const f32x4*)kp; b = *(const f32x4*)(kp + 4); } }
                else { const int j0 = k0 - 512, part = j0 >> 6, p0 = j0 & 63; float v[8];
#pragma unroll
                    for (int q = 0; q < 8; ++q) { const int p = p0 + q; const f32x2 pw = POW[((size_t)lg * 64 + p) * 33 + to + 1]; const float cr = ssm_cre[((size_t)lg * 16 + co) * 64 + p], ci = ssm_cim[((size_t)lg * 16 + co) * 64 + p];
                        v[q] = part == 0 ? (cr * pw.x - ci * pw.y) : -(cr * pw.y + ci * pw.x); }
                    a = (f32x4){v[0], v[1], v[2], v[3]}; b = (f32x4){v[4], v[5], v[6], v[7]}; }
                *(u32x4*)(TF + ((size_t)g * 512 + n) * 640 + k0) = pack8(a, b); }
            for (int it = gt; it < 32 * 128 * 64; it += NGT) { const int k8 = it & 63, rowi = (it >> 6) & 127, g = it >> 13; const int k0 = 8 * k8, ti = k0 >> 4, ci0 = k0 & 15, part = rowi >> 6, p = rowi & 63; const int lg = l * 32 + g;
                const f32x2 pw = POW[((size_t)lg * 64 + p) * 33 + 31 - ti]; const f32x2* bb = BBAR + ((size_t)lg * 64 + p) * 16 + ci0; float v[8];
#pragma unroll
                for (int q = 0; q < 8; ++q) v[q] = part == 0 ? (pw.x * bb[q].x - pw.y * bb[q].y) : (pw.x * bb[q].y + pw.y * bb[q].x);
                *(u32x4*)(ETAB + ((size_t)g * 128 + rowi) * 512 + k0) = pack8((f32x4){v[0], v[1], v[2], v[3]}, (f32x4){v[4], v[5], v[6], v[7]}); }
            } SUBSYNC(); }
        PH_END
        PH_BEGIN
            auto fox_pro = [&](const int b, const int h) {
                    const float bf = b_forget[l * 8 + h]; const int p0 = wave * 512 + lane * 8; float ls8[8]; float run = 0.f;
#pragma unroll
                    for (int q = 0; q < 8; ++q) { const float z = FLOG[((size_t)b * SEQ + p0 + q) * 8 + h] + bf; run += fminf(z, 0.f) - 0.6931471805599453f * __builtin_amdgcn_logf(1.0f + fexp2(-fabsf(z) * LOG2E)); ls8[q] = run; }
                    float incl = run;
#pragma unroll
                    for (int o = 1; o < 64; o <<= 1) { const float t = __shfl_up(incl, o); if (lane >= o) incl += t; }
                    LAS float* wtot = (LAS float*)(lds + 65536); LAS float* betaL = (LAS float*)lds;
                    if (lane == 63) wtot[wave] = incl;
                    const unsigned* nr_ = ctl + CW_NORM + l * 256 + (b * 8 + h) * 4;
                    float qm = __uint_as_float(__hip_atomic_load(nr_, RLX_AGENT)) + __uint_as_float(__hip_atomic_load(nr_ + 1, RLX_AGENT));
                    float km = __uint_as_float(__hip_atomic_load(nr_ + 2, RLX_AGENT)) + __uint_as_float(__hip_atomic_load(nr_ + 3, RLX_AGENT));
                    SUBSYNC();
                    float base = incl - run;
                    for (int w = 0; w < wave; ++w) base += wtot[w];
#pragma unroll
                    for (int q = 0; q < 8; ++q) { const float beta = -(base + ls8[q]) * LOG2E;
                        const unsigned b1 = cvt_pk_bf16(beta, 0.f) & 0xffffu; const float r1 = beta - bf_lo(b1); const unsigned b2 = cvt_pk_bf16(r1, 0.f) & 0xffffu; const float r2 = r1 - bf_lo(b2); const unsigned b3 = cvt_pk_bf16(r2, 0.f) & 0xffffu;
                        *(u32x4*)(KBIAS + (((size_t)b * SEQ + p0 + q) * 8 + h) * 8) = (u32x4){b1 | (b2 << 16), b3 | 0x3F800000u, 0x3F803F80u, 0u}; betaL[p0 + q] = beta; }
                    SUBSYNC();
                    { const float need_d = 2.0f * sqrtf(qm * km) + 36.0f;
#pragma unroll
                      for (int jj = 0; jj < 2; ++jj) { const int j = 2 * wave + jj; const bool cnd = (lane < 4 * j) && (betaL[256 * j] - betaL[64 * lane + 63] >= need_d);
                          const unsigned long long mk = __ballot(cnd); if (lane == 0) MISC[32 + j] = (unsigned)__popcll(mk); } }
                    SUBSYNC();
            };
            int prev_bh = -1;
            if (vcu < 1024) { const int bh0 = (vcu & 255) >> 2; fox_pro(bh0 >> 3, bh0 & 7); prev_bh = bh0; }
            for (int c0 = vcu; c0 < 256; c0 += G) { const int pq = c0 >> 1, g = pq >> 2, pm = pq & 3, pn = c0 & 1; const int lg = l * 32 + g;
                const char* Ag = (const char*)(UG + ((size_t)g * 1024 + pm * 256) * 640);
                { SchedOne S; S.u.A = Ag; S.u.B = (const char*)(ETAB + (size_t)g * 128 * 512); S.u.pm = pm; S.u.pn = 0; S.u.aux = g;
                  EpiS1 E{SLOC};
                  pg8::gemm_phase(lds, 640, 512, 512 / 64, S, E); }
                SUBSYNC();
                if (wave < 2) { const int b = 2 * pm + wave;
                    const f32x2 a = POW[((size_t)lg * 64 + lane) * 33 + 32]; float sr = 0.f, si = 0.f;
                    float lr[16], lim[16];
#pragma unroll
                    for (int q = 0; q < 16; ++q) { const float* sp = SLOC + ((size_t)g * 1024 + b * 128 + q) * 128; lr[q] = sp[lane]; lim[q] = sp[64 + lane]; }
                    for (int j0 = 0; j0 < 128; j0 += 16) { float nlr[16], nlim[16]; const int jn = j0 + 16 < 128 ? j0 + 16 : j0;
#pragma unroll
                        for (int q = 0; q < 16; ++q) { const float* sp = SLOC + ((size_t)g * 1024 + b * 128 + jn + q) * 128; nlr[q] = sp[lane]; nlim[q] = sp[64 + lane]; }
#pragma unroll
                        for (int q = 0; q < 16; ++q) { bf16_t* up = UG + ((size_t)g * 1024 + b * 128 + j0 + q) * 640 + 512;
                            up[lane] = (bf16_t)(cvt_pk_bf16(sr, 0.f) & 0xffffu); up[64 + lane] = (bf16_t)(cvt_pk_bf16(si, 0.f) & 0xffffu);
                            const float nr = a.x * sr - a.y * si + lr[q], ni = a.x * si + a.y * sr + lim[q]; sr = nr; si = ni; }
#pragma unroll
                        for (int q = 0; q < 16; ++q) { lr[q] = nlr[q]; lim[q] = nlim[q]; } } }
                SUBSYNC();
                { SchedOne S; S.u.A = Ag; S.u.B = (const char*)(TF + ((size_t)g * 512 + pn * 256) * 640); S.u.pm = pm; S.u.pn = pn; S.u.aux = g;
                  EpiS3 E{UG, ssm_d + l * 512, YSSM};
                  pg8::gemm_phase(lds, 640, 640, 640 / 64, S, E); }
            }
            {
              for (int k = vcu; k < 1024; k += G) { const int v8 = k & 255, i = k >> 8, bh = v8 >> 2, s = v8 & 3, b = bh >> 3, h = bh & 7; const int qb = (i == 0) ? s : (i == 1) ? 7 - s : (i == 2) ? 8 + s : 15 - s;
                if (bh != prev_bh) { prev_bh = bh; fox_pro(b, h); }
                const int tlo_u = (int)MISC[32 + qb];
                const size_t row0 = (size_t)b * SEQ;
                att::fox_unit(lds, wsf_all, QKV + row0 * NQKV + 1536 + h * 64, QKV + row0 * NQKV + 2048 + h * 64, QKV + row0 * NQKV + 2560 + h * 64, (long)NQKV, qb * 256, tlo_u, (qb * 256 + 256) >> 6,
                                    KBIAS + ((size_t)b * SEQ * 8 + h) * 8, YFOX + row0 * 512 + h * 64, 512); } }
            { unsigned* qctr = ctl + CW_QUEUE + l * 64; unsigned kn = 0u;
              if (tid == 0) MISC[48] = __hip_atomic_fetch_add(qctr, 1u, RLX_AGENT);
              SUBSYNC();
              int k = (int)MISC[48];
              while (k < 960) {
                if (tid == 0) kn = __hip_atomic_fetch_add(qctr, 1u, RLX_AGENT);
                {
                  if (k < 256) { const int bh = k >> 2, j = k & 3, b = bh >> 3, h = bh & 7; const size_t row0 = (size_t)b * SEQ;
                      att::dil_sweep<false>(lds, wsf_all, QKV + row0 * NQKV + h * 64, QKV + row0 * NQKV + 512 + h * 64, QKV + row0 * NQKV + 1024 + h * 64, (long)NQKV, 4 * j, 4,
                                            O1 + row0 * 512 + h * 64, 512L, LSE + row0 * 8 + h, 8L, 0L, 0L, 0L); }
                  else if (k < 512) { const int bh = (k - 256) >> 2, j = k & 3, b = bh >> 3, h = bh & 7; const size_t row0 = (size_t)b * SEQ + j;
                      att::dil_sweep<false>(lds, wsf_all, QKV + row0 * NQKV + h * 64, QKV + row0 * NQKV + 512 + h * 64, QKV + row0 * NQKV + 1024 + h * 64, 4L * NQKV, 0, 4,
                                            O2 + row0 * 512 + h * 64, 4L * 512, LSE + (size_t)T * 8 + row0 * 8 + h, 4L * 8, 0L, 0L, 0L); }
                  else { int bh, b0, nb; if (k < 704) { bh = (k - 512) / 3; b0 = 4 * ((k - 512) % 3); nb = 4; } else { bh = (k - 704) >> 2; b0 = 12 + ((k - 704) & 3); nb = 1; }
                      const int b = bh >> 3, h = bh & 7; const size_t row0 = (size_t)b * SEQ;
                      att::dil_sweep<true>(lds, wsf_all, QKV + row0 * NQKV + h * 64, QKV + row0 * NQKV + 512 + h * 64, QKV + row0 * NQKV + 1024 + h * 64, 16L * NQKV, b0, nb,
                                           O3 + row0 * 512 + h * 64, 16L * 512, LSE + (size_t)2 * T * 8 + row0 * 8 + h, 16L * 8, (long)NQKV, 512L, 8L); } }
                if (tid == 0) MISC[48] = kn;
                SUBSYNC();
                k = (int)MISC[48];
              } }
        PH_END
        PH_BEGIN
            for (int step = 0; step < 2; ++step) { if ((step == 0) != ((vcu & 1) != 0)) {
            { SchedBatched S{(const char*)XB, (const char*)(WIN_T + (size_t)3584 * D), 0, 0, D, D, 128, 12, 1, G, bx};
              EpiGates E{GATES};
              pg8::gemm_phase(lds, D, D, D / 64, S, E); }
            } else {
            { SchedBatched S{(const char*)YSSM, (const char*)WGLU_T, 0, 0, 512, 512, 128, 2, 1, G, bx};
              EpiGlu E{YSSM, YSSM2};
              pg8::gemm_phase(lds, 512, 512, 512 / 64, S, E); }
            { const int h = lane >> 3; float l0n, l1n, l2n; u32x4 q1n, q2n, q3n;
#define MIX_LOAD(r_) do { const size_t off_ = (size_t)(r_) * 512 + lane * 8; l0n = LSE[(size_t)(r_) * 8 + h]; l1n = LSE[(size_t)T * 8 + (size_t)(r_) * 8 + h]; l2n = LSE[(size_t)2 * T * 8 + (size_t)(r_) * 8 + h]; \
        q1n = *(const u32x4*)(O1 + off_); q2n = *(const u32x4*)(O2 + off_); q3n = *(const u32x4*)(O3 + off_); } while (0)
              MIX_LOAD(gw);
              for (int row = gw; row < T; row += NGW) { const size_t off = (size_t)row * 512 + lane * 8;
                const float l0 = l0n, l1 = l1n, l2 = l2n; const u32x4 q1 = q1n, q2 = q2n, q3 = q3n;
                const int nrow = row + NGW < T ? row + NGW : row; MIX_LOAD(nrow);
                const float mx = fmaxf(l0, fmaxf(l1, l2)); float e0 = fexp2(l0 - mx), e1 = fexp2(l1 - mx), e2 = fexp2(l2 - mx); const float rs = frcp(e0 + e1 + e2); e0 *= rs; e1 *= rs; e2 *= rs;
                f32x4 a0, b0, a1, b1, a2, b2; unpack8(q1, a0, b0); unpack8(q2, a1, b1); unpack8(q3, a2, b2);
                *(u32x4*)(O1 + off) = pack8(a0 * e0 + a1 * e1 + a2 * e2, b0 * e0 + b1 * e1 + b2 * e2); }
#undef MIX_LOAD
            }
            } SUBSYNC(); }
        PH_END
        PH_BEGIN
            { SchedMerge S{(const char*)YSSM2, (const char*)O1, (const char*)YFOX, (const char*)WB_T, G, bx};
              EpiMerge E{GATES, MERGED};
              pg8::gemm_phase(lds, 512, 512, 512 / 64, S, E); }
        PH_END
        PH_BEGIN
            { SchedBatched S{(const char*)MERGED, (const char*)WOUT_T, 0, 0, D, D, 128, 4, 1, G, bx};
              if (l == 0) { EpiResT<true> E{ZHP, x_in, STATS, ONESV, ZEROSV}; pg8::gemm_phase(lds, D, D, D / 64, S, E); }
              else { EpiResT<false> E{ZHP, nullptr, STATS, ln_ffn_g + (l - 1) * D, ln_ffn_b + (l - 1) * D}; pg8::gemm_phase(lds, D, D, D / 64, S, E); } }
        PH_END
        PH_BEGIN
            ln_pass<0, false, false, false>(gw, NGW, lane, ZHP, OUTF, nullptr, XB, STATS, ln_mix_g + l * D, ln_mix_b + l * D, nullptr, nullptr, nullptr, nullptr, nullptr, nullptr, 0, nullptr, nullptr, nullptr, hist, nullptr);
        PH_END
        PH_BEGIN
            { SchedBatched S{(const char*)XB, (const char*)XQ_T, 0, 0, D, D, 128, 4, 1, G, bx};
              EpiScale E{XQ, D, C2_256, 0};
              pg8::gemm_phase(lds, D, D, D / 64, S, E); }
        PH_END
        PH_BEGIN
            for (int k = vcu; k < 512; k += G) { const int b = k >> 6, h = (k >> 4) & 3, qb = k & 15; const size_t qrow = (size_t)b * SEQ + qb * 256;
                const bf16_t* Kx = XKV + (size_t)(2 * l) * NB * NMEM * D + (size_t)b * NMEM * D + h * 256; const bf16_t* Vx = Kx + (size_t)NB * NMEM * D;
                att::xattn_unit(lds, wsf_all, XQ + qrow * D + h * 256, Kx, Vx, XQ + qrow * D + h * 256); }
        PH_END
        PH_BEGIN
            { SchedBatched S{(const char*)XQ, (const char*)XO_T, 0, 0, D, D, 128, 4, 1, G, bx};
              EpiResT<false> E{ZHP, nullptr, STATS, ln_mix_g + l * D, ln_mix_b + l * D};
              pg8::gemm_phase(lds, D, D, D / 64, S, E); }
        PH_END
        PH_BEGIN
            if (!moe) ln_pass<0, false, false, false>(gw, NGW, lane, ZHP, OUTF, nullptr, XB, STATS, ln_x_g + l * D, ln_x_b + l * D, nullptr, nullptr, nullptr, nullptr, nullptr, nullptr, 0, nullptr, nullptr, nullptr, hist, nullptr);
            else {
                ln_pass<0, true, false, false>(gw, NGW, lane, ZHP, OUTF, nullptr, XB, STATS, ln_x_g + l * D, ln_x_b + l * D, nullptr, nullptr, nullptr, nullptr, nullptr, moe_wr + (size_t)li2 * D * NEXP, NEXP, moe_br + li2 * NEXP, TOKE, TOKW, hist, nullptr);
                SUBSYNC();
                if (tid < NEXP) { const unsigned c = hist[tid]; if (c) __hip_atomic_fetch_add(ctl + CW_CNT + (li2 * 8 + tid) * 64, c, RLX_AGENT); hist[tid] = 0u; }
                { int stp_ = NGT; asm volatile("" : "+s"(stp_));
                  unsigned z_ = 0u; asm volatile("" : "+v"(z_));
                  for (int it = gt; it < 264 * 256 / 2; it += stp_) ((unsigned*)INV16)[it] = z_; }
            }
        PH_END
        if (!moe) {
            PH_BEGIN
                for (int step = 0; step < 2; ++step) { if ((step == 0) != ((vcu & 1) != 0)) {
                { SchedBatched S{(const char*)XB, (const char*)FFN_GU, 0, 0, D, D, 128, 22, 1, G, bx};
                  EpiSwiglu E{HBUF, DFF};
                  pg8::gemm_phase(lds, D, D, D / 64, S, E); }
                } else { if (l + 1 < DEPTH) CONVERT_MIXER(l + 1); } SUBSYNC(); }
            PH_END
            PH_BEGIN
                { SchedBatched S{(const char*)HBUF, (const char*)FFN_D_DENSE, 0, 0, DFF, DFF, 128, 4, 1, G, bx};
                  EpiResT<false> E{ZHP, nullptr, STATS, ln_x_g + l * D, ln_x_b + l * D};
                  pg8::gemm_phase(lds, DFF, DFF, DFF / 64, S, E); }
            PH_END
            PH_BEGIN
                if (l + 1 < DEPTH) ln_pass<0, false, true, false>(gw, NGW, lane, ZHP, OUTF, nullptr, XB, STATS, ln_ffn_g + l * D, ln_ffn_b + l * D, nullptr, nullptr, nullptr, nullptr, nullptr, w_in + (size_t)(l + 1) * D * NIN + 3584, NIN, nullptr, nullptr, nullptr, hist, FLOG);
                else ln_pass<0, false, false, true>(gw, NGW, lane, ZHP, OUTF, nullptr, XB, STATS, ln_ffn_g + l * D, ln_ffn_b + l * D, nullptr, nullptr, nullptr, nullptr, nullptr, nullptr, 0, nullptr, nullptr, nullptr, hist, nullptr);
                if (l + 1 < DEPTH) { SUBSYNC(); { int tq_ = threadIdx.x; asm volatile("" : "+v"(tq_)); const int lane = tq_ & 63; CONVERT_FFN(l + 1); } }
            PH_END
        } else {
            PH_BEGIN
                LOAD_TOFF();
                for (int t0 = gw * 64; t0 < T; t0 += NGW * 64) { const int t = t0 + lane; const int e0 = TOKE[2 * t], e1 = TOKE[2 * t + 1];
                    int r0 = 0, r1 = 0, tb0 = 0, tb1 = 0; unsigned cme = 0u; const unsigned long long lt = (1ull << lane) - 1ull;
#pragma unroll
                    for (int e = 0; e < 8; ++e) { const unsigned long long m0 = __ballot(e0 == e), m1 = __ballot(e1 == e); const int n0 = __popcll(m0), n1 = __popcll(m1);
                        if (lane == e) cme = (unsigned)(n0 + n1);
                        if (e0 == e) { r0 = __popcll(m0 & lt); tb0 = toff[e] * 256; }
                        if (e1 == e) { r1 = n0 + __popcll(m1 & lt); tb1 = toff[e] * 256; } }
                    unsigned base = 0u; if (lane < 8 && cme) base = __hip_atomic_fetch_add(ctl + CW_FILL + (li2 * 8 + lane) * 64, cme, RLX_AGENT);
                    const int pos0 = tb0 + (int)__shfl(base, e0) + r0, pos1 = tb1 + (int)__shfl(base, e1) + r1;
                    TOKP[2 * t] = pos0; TOKP[2 * t + 1] = pos1; INV16[pos0] = (unsigned short)t; INV16[pos1] = (unsigned short)t; }
            PH_END
            PH_BEGIN
                for (int step = 0; step < 2; ++step) { if ((step == 0) != ((vcu & 1) != 0)) {
                LOAD_TOFF();
                { LAS unsigned short* linv = (LAS unsigned short*)(lds + 135168);
                  { int tq = tid; asm volatile("" : "+v"(tq));
#pragma unroll 1
                    for (int q = tq; q < 12 * 256; q += NWAVES * 64) { const int i = q >> 8; const int L = i * G + bx; if (L < toff[8] * 11) linv[q] = INV16[(L / 11) * 256 + (q & 255)]; } }
                  SUBSYNC(); }
                { SchedMoeG S; S.Abase = (const char*)XB; S.linv = (const LAS unsigned short*)(lds + 135168); S.Bbase = (const char*)FFN_GU; S.strideB = (size_t)2 * DFFE * D * 2; S.lda = D; S.ldb = D; S.G = G; S.c = bx;
#pragma unroll
                  for (int e = 0; e < 9; ++e) S.toff[e] = toff[e];
                  EpiSwiglu E{HBUF, DFFE};
                  pg8::gemm_phase(lds, D, D, D / 64, S, E); }
                } else { if (l + 1 < DEPTH) CONVERT_MIXER(l + 1); } SUBSYNC(); }
            PH_END
            PH_BEGIN
                LOAD_TOFF();
                { SchedMoe S; S.Abase = (const char*)HBUF; S.Bbase = (const char*)FFN_D_MOE; S.strideB = (size_t)D * DFFE * 2; S.lda = DFFE; S.ldb = DFFE; S.nN = 4; S.G = G; S.c = bx;
#pragma unroll
                  for (int e = 0; e < 9; ++e) S.toff[e] = toff[e];
                  EpiScale E{Y2, D, 1.0f, 0};
                  pg8::gemm_phase(lds, DFFE, DFFE, DFFE / 64, S, E); }
            PH_END
            PH_BEGIN
                if (l + 1 < DEPTH) ln_pass<1, false, true, false>(gw, NGW, lane, ZHP, OUTF, nullptr, XB, STATS, ln_ffn_g + l * D, ln_ffn_b + l * D, ln_x_g + l * D, ln_x_b + l * D, Y2, TOKP, TOKW, w_in + (size_t)(l + 1) * D * NIN + 3584, NIN, nullptr, nullptr, nullptr, hist, FLOG);
                else ln_pass<1, false, false, true>(gw, NGW, lane, ZHP, OUTF, nullptr, XB, STATS, ln_ffn_g + l * D, ln_ffn_b + l * D, ln_x_g + l * D, ln_x_b + l * D, Y2, TOKP, TOKW, nullptr, 0, nullptr, nullptr, nullptr, hist, nullptr);
                if (l + 1 < DEPTH) { SUBSYNC(); { int tq_ = threadIdx.x; asm volatile("" : "+v"(tq_)); const int lane = tq_ & 63; CONVERT_FFN(l + 1); } }
            PH_END
        }
    }
}

#ifndef SPLIT_LAUNCH
#define SPLIT_LAUNCH 0
#endif
extern "C" void kernel_launch(void* const* d_in, const int* in_sizes, int n_in, void* d_out, int out_size, void* d_ws, size_t ws_size, hipStream_t stream) {
    static int grid = 0;
    if (grid == 0) {
        if (n_in != 34 || out_size != T * D || ws_size < WS_END) { fprintf(stderr, "kernel_launch: unexpected shapes (n_in %d out %d ws %zu)\n", n_in, out_size, ws_size); grid = -1; return; }
        int dev = 0, cus = 0;
        if (hipGetDevice(&dev) != hipSuccess || hipDeviceGetAttribute(&cus, hipDeviceAttributeMultiprocessorCount, dev) != hipSuccess) { grid = -1; return; }
        if (hipFuncSetAttribute((const void*)hybrid_fwd, hipFuncAttributeMaxDynamicSharedMemorySize, LDS_BYTES) != hipSuccess) { grid = -1; return; }
        int per_cu = 0;
        if (hipOccupancyMaxActiveBlocksPerMultiprocessor(&per_cu, (const void*)hybrid_fwd, NWAVES * 64, LDS_BYTES) != hipSuccess || per_cu < 1) { fprintf(stderr, "kernel_launch: occupancy query says %d\n", per_cu); }
        (void)hipGetLastError();
        grid = cus;
    }
    if (grid < 0) return;
    if (hipMemsetAsync((char*)d_ws + WS_CTL, 0, CTL_ZERO_BYTES, stream) != hipSuccess) return;
    Args a{};
    for (int i = 0; i < 34; ++i) a.in[i] = d_in[i];
    a.out = (float*)d_out; a.ws = (unsigned char*)d_ws;
#if SPLIT_LAUNCH
    for (int ph = 0; ph < NPH_TOTAL; ++ph) { a.ph_lo = ph; a.ph_hi = ph + 1; hipLaunchKernelGGL(hybrid_fwd, dim3(grid), dim3(NWAVES * 64), LDS_BYTES, stream, a); }
#else
    a.ph_lo = 0; a.ph_hi = NPH_TOTAL;
    hipLaunchKernelGGL(hybrid_fwd, dim3(grid), dim3(NWAVES * 64), LDS_BYTES, stream, a);
#endif
}
```

```cpp
#include <hip/hip_runtime.h>
#include <cstdio>
#include <cstdint>

#define GAS __attribute__((address_space(1)))
#define LAS __attribute__((address_space(3)))
typedef unsigned short bf16_t;
typedef short bf16x8 __attribute__((ext_vector_type(8)));
typedef short s16x4 __attribute__((ext_vector_type(4)));
typedef float f32x2 __attribute__((ext_vector_type(2)));
typedef float f32x4 __attribute__((ext_vector_type(4)));
typedef float f32x16 __attribute__((ext_vector_type(16)));
typedef unsigned u32x2 __attribute__((ext_vector_type(2)));
typedef unsigned u32x4 __attribute__((ext_vector_type(4)));

constexpr int NB = 8, SEQ = 4096, T = NB * SEQ, D = 1024;
constexpr int DEPTH = 4, NIN = 6664, NQKV = 3072, NGATE = 3072;
constexpr int DFF = 2816, DFFE = 1408, NEXP = 8, NMEM = 256;
constexpr int XG_ROWS = 2 * T + 8 * 256;
constexpr float LOG2E = 1.4426950408889634f;
constexpr float C2_64 = 0.125f * LOG2E;
constexpr float C2_256 = 0.0625f * LOG2E;
constexpr float ALPHA = 1.681792830507429f;
constexpr float LN_EPS = 1e-5f;

typedef __bf16 bf16x2_t __attribute__((ext_vector_type(2)));
__device__ __forceinline__ unsigned cvt_pk_bf16(float lo, float hi) { const f32x2 v = {lo, hi}; const bf16x2_t b = __builtin_convertvector(v, bf16x2_t); return __builtin_bit_cast(unsigned, b); }
typedef _Float16 h16x2_t __attribute__((ext_vector_type(2)));
__device__ __forceinline__ unsigned cvt_pk_f16(float lo, float hi) { const f32x2 v = {lo, hi}; const h16x2_t h = __builtin_convertvector(v, h16x2_t); return __builtin_bit_cast(unsigned, h); }
__device__ __forceinline__ f32x2 unpk_f16(unsigned u) { return __builtin_convertvector(__builtin_bit_cast(h16x2_t, u), f32x2); }
__device__ __forceinline__ u32x4 pack8h(const f32x4 a, const f32x4 b) { u32x4 w; w.x = cvt_pk_f16(a[0], a[1]); w.y = cvt_pk_f16(a[2], a[3]); w.z = cvt_pk_f16(b[0], b[1]); w.w = cvt_pk_f16(b[2], b[3]); return w; }
__device__ __forceinline__ void unpack8h(const u32x4 w, f32x4& a, f32x4& b) { const f32x2 p0 = unpk_f16(w.x), p1 = unpk_f16(w.y), p2 = unpk_f16(w.z), p3 = unpk_f16(w.w); a = (f32x4){p0.x, p0.y, p1.x, p1.y}; b = (f32x4){p2.x, p2.y, p3.x, p3.y}; }
__device__ __forceinline__ float bf_lo(unsigned u) { return __uint_as_float(u << 16); }
__device__ __forceinline__ float bf_hi(unsigned u) { return __uint_as_float(u & 0xffff0000u); }
__device__ __forceinline__ float fexp2(float x) { return __builtin_amdgcn_exp2f(x); }
__device__ __forceinline__ float frcp(float x) { return __builtin_amdgcn_rcpf(x); }
__device__ __forceinline__ float sigmoidf_(float x) { return frcp(1.0f + fexp2(-x * LOG2E)); }
__device__ __forceinline__ float siluf_(float x) { return x * sigmoidf_(x); }
__device__ __forceinline__ float gelu_tanh_(float x) { const float u = 0.7978845608028654f * (x + 0.044715f * x * x * x); return x * sigmoidf_(2.0f * u); }
template <int CTRL, int RM> __device__ __forceinline__ float dpp_mov0(float v) { return __builtin_bit_cast(float, __builtin_amdgcn_update_dpp(0, __builtin_bit_cast(int, v), CTRL, RM, 0xf, false)); }
__device__ __forceinline__ float wave_sum(float v) {
    v += dpp_mov0<0xB1, 0xf>(v); v += dpp_mov0<0x4E, 0xf>(v); v += dpp_mov0<0x141, 0xf>(v); v += dpp_mov0<0x140, 0xf>(v);
    v += dpp_mov0<0x142, 0xa>(v); v += dpp_mov0<0x143, 0xc>(v);
    return __builtin_bit_cast(float, __builtin_amdgcn_readlane(__builtin_bit_cast(int, v), 63));
}
__device__ __forceinline__ u32x4 pack8(const f32x4 a, const f32x4 b) { u32x4 w; w.x = cvt_pk_bf16(a[0], a[1]); w.y = cvt_pk_bf16(a[2], a[3]); w.z = cvt_pk_bf16(b[0], b[1]); w.w = cvt_pk_bf16(b[2], b[3]); return w; }
__device__ __forceinline__ void unpack8(const u32x4 w, f32x4& a, f32x4& b) { a = (f32x4){bf_lo(w.x), bf_hi(w.x), bf_lo(w.y), bf_hi(w.y)}; b = (f32x4){bf_lo(w.z), bf_hi(w.z), bf_lo(w.w), bf_hi(w.w)}; }

namespace pg8 {
constexpr int BM = 256, BK = 64, HALF = 128, HTB = HALF * BK * 2, STAGE_BYTES = 8 * HTB, NXCD = 8, WGM = 8;
__host__ __device__ __forceinline__ int lds_byte(int r, int c) { const int st = (r >> 4) * 2 + (c >> 5), rr = r & 15, cc = c & 31, ob = rr * 64 + cc * 2; return st * 1024 + (ob ^ (((ob >> 9) & 1) << 5)); }
__host__ __device__ __forceinline__ void stage_rc(int b, int& R, int& C) { const int st = b / 1024, sb = b % 1024, swz = sb ^ (((sb >> 9) & 1) << 5); R = (st >> 1) * 16 + swz / 64; C = (st & 1) * 32 + (swz % 64) / 2; }
__host__ __device__ __forceinline__ int perm32(int rho) { const int n = rho >> 4, i = rho & 15; return 8 * (i >> 2) + 4 * n + (i & 3); }

struct Unit { const char* A; const char* B; int pm, pn, aux; };

__device__ __forceinline__ bool static_order(int nM, int nN, int G, int c, int i, int& pm, int& pn) {
    const int nwg = nM * nN; const long L = (long)i * G + c; if (L >= nwg) return false;
    int wgid = (int)L; { const int q = nwg / NXCD, r = nwg % NXCD, xcd = wgid % NXCD, off = wgid / NXCD; wgid = (xcd < r ? xcd * (q + 1) : r * (q + 1) + (xcd - r) * q) + off; }
    const int nig = WGM * nN, gid = wgid / nig, fm = gid * WGM, gsz = (nM - fm) < WGM ? (nM - fm) : WGM;
    pm = fm + ((wgid % nig) % gsz); pn = (wgid % nig) / gsz; return true;
}

template <class Epi, class Sched, bool ALIGN_EPI = true, bool SP2 = true>
__device__ __forceinline__ void gemm_phase(LAS unsigned char* lds, const int lda, const int ldb, const int nt, const Sched& S, const Epi& E) {
    int tid = threadIdx.x; asm volatile("" : "+v"(tid));
    const int wid = __builtin_amdgcn_readfirstlane(tid >> 6), lane = tid & 63, wr = wid >> 2, wc = wid & 3, fr = lane & 15, fq = lane >> 4;
    constexpr bool GA = Sched::GATHER; static_assert(!GA || SP2, "gathered A: SP2 stream only");
    unsigned voffA[2], voffB[2]; int RA[2], CA[2];
#pragma unroll
    for (int i = 0; i < 2; ++i) { int R, C; stage_rc(tid * 16 + i * 8192, R, C); const int Rb = Epi::PERM ? ((R & ~31) + perm32(R & 31)) : R; RA[i] = R; CA[i] = C;
        voffA[i] = (unsigned)(R * lda + C) * 2u; voffB[i] = (unsigned)(Rb * ldb + C) * 2u; }
    unsigned vC0[2] = {0u, 0u}, vC1[2] = {0u, 0u}, vN0[2] = {0u, 0u}, vN1[2] = {0u, 0u};
    const size_t kstep = (size_t)(BK * 2);
    const size_t hstepA = (size_t)HALF * lda * 2, hstepB = (size_t)HALF * ldb * 2;
    const unsigned ldsw = (unsigned)wid * 1024u;
    const int aoff = lds_byte(wr * 64 + fr, fq * 8), boff = lds_byte(wc * 32 + fr, fq * 8);
#define PG8_SA(b, h) (((b) * 2 + (h)) * HTB)
#define PG8_SB(b, h) ((4 + (b) * 2 + (h)) * HTB)
#define PG8_STAGE(bufoff, gbase, voff) do { _Pragma("unroll") for (int _i = 0; _i < 2; ++_i) \
        __builtin_amdgcn_global_load_lds((const unsigned*)((const char*)(gbase) + (voff)[_i]), (LAS unsigned*)(lds + (bufoff) + ldsw + _i * 8192), 16, 0, 0); } while (0)
#define PG8_STAGE_A(b, h, ptr, nx) do { if constexpr (GA) { const unsigned o0_ = (nx) ? ((h) ? vN1[0] : vN0[0]) : ((h) ? vC1[0] : vC0[0]), o1_ = (nx) ? ((h) ? vN1[1] : vN0[1]) : ((h) ? vC1[1] : vC0[1]); \
        __builtin_amdgcn_global_load_lds((const unsigned*)((const char*)(ptr) + o0_), (LAS unsigned*)(lds + PG8_SA(b, h) + ldsw), 16, 0, 0); \
        __builtin_amdgcn_global_load_lds((const unsigned*)((const char*)(ptr) + o1_), (LAS unsigned*)(lds + PG8_SA(b, h) + ldsw + 8192), 16, 0, 0); } \
        else PG8_STAGE(PG8_SA(b, h), (ptr) + ((h) ? hstepA : (size_t)0), voffA); } while (0)
#define PG8_LDA(dst, b, h) do { _Pragma("unroll") for (int m = 0; m < 4; ++m) _Pragma("unroll") for (int k = 0; k < 2; ++k) dst[m][k] = *(const LAS bf16x8*)(lds + PG8_SA(b, h) + aoff + m * 2048 + k * 1024); } while (0)
#define PG8_LDB(dst, b, h) do { _Pragma("unroll") for (int n = 0; n < 2; ++n) _Pragma("unroll") for (int k = 0; k < 2; ++k) dst[n][k] = *(const LAS bf16x8*)(lds + PG8_SB(b, h) + boff + n * 2048 + k * 1024); } while (0)
#define PG8_MMA(ai, bj, At, Bt) do { __builtin_amdgcn_s_setprio(1); _Pragma("unroll") for (int m = 0; m < 4; ++m) _Pragma("unroll") for (int n = 0; n < 2; ++n) _Pragma("unroll") for (int k = 0; k < 2; ++k) \
        acc[ai][bj][m][n] = __builtin_amdgcn_mfma_f32_16x16x32_bf16(Bt[n][k], At[m][k], acc[ai][bj][m][n], 0, 0, 0); __builtin_amdgcn_s_setprio(0); } while (0)
#define PG8_WAIT_V(n) asm volatile("s_waitcnt vmcnt(" #n ")" ::: "memory")
#define PG8_WAIT_L(n) asm volatile("s_waitcnt lgkmcnt(" #n ")" ::: "memory")
#define PG8_BAR __builtin_amdgcn_s_barrier()
#define PG8_SCHED __builtin_amdgcn_sched_barrier(0)
    Unit cur, nxt; int ui = 0;
    if (!S.next(0, cur)) return;
    f32x4 acc[2][2][4][2];
#pragma unroll
    for (int a = 0; a < 2; ++a)
#pragma unroll
        for (int b = 0; b < 2; ++b)
#pragma unroll
            for (int m = 0; m < 4; ++m)
#pragma unroll
                for (int n = 0; n < 2; ++n) acc[a][b][m][n] = (f32x4){0.f, 0.f, 0.f, 0.f};
    bf16x8 At[4][2], B0[2][2], B1[2][2];
    const char* cA = cur.A; const char* cB = cur.B;
    if constexpr (GA) S.gather(0, RA, CA, vC0, vC1);
    if constexpr (SP2) {
        PG8_STAGE(PG8_SB(0, 0), cB, voffB); PG8_STAGE(PG8_SB(0, 1), cB + hstepB, voffB); PG8_STAGE_A(0, 0, cA, false); PG8_STAGE_A(0, 1, cA, false);
        if (wr == 1) PG8_BAR;
        PG8_WAIT_V(2); PG8_BAR;
        PG8_STAGE(PG8_SB(1, 0), cB + kstep, voffB); PG8_STAGE_A(1, 0, cA + kstep, false); PG8_STAGE(PG8_SB(1, 1), cB + hstepB + kstep, voffB);
        PG8_WAIT_V(6); PG8_BAR;
    } else {
        PG8_STAGE(PG8_SB(0, 0), cB, voffB); PG8_STAGE(PG8_SA(0, 0), cA, voffA); PG8_STAGE(PG8_SB(0, 1), cB + hstepB, voffB); PG8_STAGE(PG8_SA(0, 1), cA + hstepA, voffA);
        if (wr == 1) PG8_BAR;
        PG8_WAIT_V(4); PG8_BAR;
        PG8_STAGE(PG8_SB(1, 0), cB + kstep, voffB); PG8_STAGE(PG8_SA(1, 0), cA + kstep, voffA); PG8_STAGE(PG8_SB(1, 1), cB + hstepB + kstep, voffB);
        PG8_WAIT_V(6); PG8_BAR;
    }
    for (;;) {
        const bool has_next = S.next(ui + 1, nxt);
        const char* nA = has_next ? nxt.A : cA; const char* nB = has_next ? nxt.B : cB;
        if constexpr (GA) { if (has_next) S.gather(ui + 1, RA, CA, vN0, vN1); else { vN0[0] = vC0[0]; vN0[1] = vC0[1]; vN1[0] = vC1[0]; vN1[1] = vC1[1]; } }
        for (int t = 0; t < nt; t += 2) {
            const bool last = (t == nt - 2);
            const char* a1 = cA + (size_t)(t + 1) * kstep;
            const char* a2 = last ? nA : cA + (size_t)(t + 2) * kstep; const char* b2 = last ? nB : cB + (size_t)(t + 2) * kstep;
            const char* a3 = a2 + kstep; const char* b3 = b2 + kstep;
            if constexpr (SP2) {
            PG8_LDB(B0, 0, 0); PG8_LDB(B1, 0, 1); PG8_SCHED; PG8_LDA(At, 0, 0); PG8_STAGE_A(1, 1, a1, false);
            PG8_WAIT_V(8); PG8_WAIT_L(0); PG8_BAR; PG8_MMA(0, 0, At, B0); PG8_MMA(0, 1, At, B1); PG8_BAR; PG8_SCHED;
            PG8_LDA(At, 0, 1); PG8_STAGE(PG8_SB(0, 0), b2, voffB); PG8_STAGE(PG8_SB(0, 1), b2 + hstepB, voffB); PG8_STAGE_A(0, 0, a2, last);
            PG8_WAIT_V(8); PG8_WAIT_L(0); PG8_BAR; PG8_MMA(1, 0, At, B0); PG8_MMA(1, 1, At, B1); PG8_BAR; PG8_SCHED;
            PG8_LDB(B0, 1, 0); PG8_LDB(B1, 1, 1); PG8_SCHED; PG8_LDA(At, 1, 0); PG8_STAGE_A(0, 1, a2, last);
            PG8_WAIT_V(8); PG8_WAIT_L(0); PG8_BAR; PG8_MMA(0, 0, At, B0); PG8_MMA(0, 1, At, B1); PG8_BAR; PG8_SCHED;
            PG8_LDA(At, 1, 1); PG8_STAGE(PG8_SB(1, 0), b3, voffB); PG8_STAGE(PG8_SB(1, 1), b3 + hstepB, voffB); PG8_STAGE_A(1, 0, a3, last);
            PG8_WAIT_V(8); PG8_WAIT_L(0); PG8_BAR; PG8_MMA(1, 0, At, B0); PG8_MMA(1, 1, At, B1); PG8_BAR; PG8_SCHED;
            } else {
            PG8_LDB(B0, 0, 0); PG8_SCHED; PG8_LDA(At, 0, 0); PG8_STAGE(PG8_SA(1, 1), a1 + hstepA, voffA);
            PG8_WAIT_L(8); PG8_BAR; PG8_WAIT_L(0); PG8_MMA(0, 0, At, B0); PG8_BAR; PG8_SCHED;
            PG8_LDB(B1, 0, 1); PG8_STAGE(PG8_SB(0, 0), b2, voffB);
            PG8_BAR; PG8_WAIT_L(0); PG8_MMA(0, 1, At, B1); PG8_BAR;
            PG8_LDA(At, 0, 1); PG8_STAGE(PG8_SA(0, 0), a2, voffA);
            PG8_BAR; PG8_WAIT_L(0); PG8_MMA(1, 0, At, B0); PG8_BAR; PG8_SCHED;
            PG8_STAGE(PG8_SB(0, 1), b2 + hstepB, voffB);
            PG8_WAIT_V(6); PG8_BAR; PG8_MMA(1, 1, At, B1); PG8_BAR;
            PG8_LDB(B0, 1, 0); PG8_SCHED; PG8_LDA(At, 1, 0); PG8_STAGE(PG8_SA(0, 1), a2 + hstepA, voffA);
            PG8_WAIT_L(8); PG8_BAR; PG8_WAIT_L(0); PG8_MMA(0, 0, At, B0); PG8_BAR; PG8_SCHED;
            PG8_LDB(B1, 1, 1); PG8_STAGE(PG8_SB(1, 0), b3, voffB);
            PG8_BAR; PG8_WAIT_L(0); PG8_MMA(0, 1, At, B1); PG8_BAR;
            PG8_LDA(At, 1, 1); PG8_STAGE(PG8_SA(1, 0), a3, voffA);
            PG8_BAR; PG8_WAIT_L(0); PG8_MMA(1, 0, At, B0); PG8_BAR; PG8_SCHED;
            PG8_STAGE(PG8_SB(1, 1), b3 + hstepB, voffB);
            PG8_WAIT_V(6); PG8_BAR; PG8_MMA(1, 1, At, B1); PG8_BAR;
            }
        }
        if constexpr (ALIGN_EPI) { if (wr == 0) PG8_BAR; }
        { int fr2 = fr, fq2 = fq; asm volatile("" : "+v"(fr2), "+v"(fq2)); E(acc, cur, wr, wc, fr2, fq2); }
        if (!has_next) break;
        if (!Epi::keep_acc(cur)) {
#pragma unroll
        for (int a = 0; a < 2; ++a)
#pragma unroll
            for (int b = 0; b < 2; ++b)
#pragma unroll
                for (int m = 0; m < 4; ++m)
#pragma unroll
                    for (int n = 0; n < 2; ++n) acc[a][b][m][n] = (f32x4){0.f, 0.f, 0.f, 0.f};
        }
        cur = nxt; cA = nA; cB = nB; ++ui;
        if constexpr (GA) { vC0[0] = vN0[0]; vC0[1] = vN0[1]; vC1[0] = vN1[0]; vC1[1] = vN1[1]; }
        if constexpr (ALIGN_EPI) { if (wr == 1) PG8_BAR; }
    }
    PG8_WAIT_V(0);
    if constexpr (!ALIGN_EPI) { if (wr == 0) PG8_BAR; }
    PG8_BAR;
#undef PG8_SA
#undef PG8_SB
#undef PG8_STAGE
#undef PG8_STAGE_A
#undef PG8_LDA
#undef PG8_LDB
#undef PG8_MMA
#undef PG8_WAIT_V
#undef PG8_WAIT_L
#undef PG8_BAR
#undef PG8_SCHED
}
}
using pg8::Unit;
typedef f32x4 Acc[2][2][4][2];

struct SchedBatched { static constexpr bool GATHER = false;
    const char* Abase; const char* Bbase; size_t strideA, strideB; int lda, ldb, nM, nN, nbatch, G, c;
    __device__ __forceinline__ bool next(int i, Unit& u) const {
        if (nbatch == 1) { int pm, pn; if (!pg8::static_order(nM, nN, G, c, i, pm, pn)) return false;
            u.pm = pm; u.pn = pn; u.aux = 0; u.A = Abase + (size_t)pm * 256 * lda * 2; u.B = Bbase + (size_t)pn * 256 * ldb * 2; return true; }
        const long L = (long)i * G + c; const int per = nM * nN; if (L >= (long)per * nbatch) return false;
        const int g = (int)(L / per), r = (int)(L % per); u.pm = r / nN; u.pn = r % nN; u.aux = g;
        u.A = Abase + (size_t)g * strideA + (size_t)u.pm * 256 * lda * 2; u.B = Bbase + (size_t)g * strideB + (size_t)u.pn * 256 * ldb * 2; return true;
    }
};
struct SchedOne { static constexpr bool GATHER = false; Unit u; __device__ __forceinline__ bool next(int i, Unit& o) const { if (i != 0) return false; o = u; return true; } };
struct SchedMerge { static constexpr bool GATHER = false;
    const char* A0; const char* A1; const char* A2; const char* Bbase; int G, c;
    __device__ __forceinline__ bool next(int i, Unit& u) const {
        const int n = i % 3; int pm, pn; if (!pg8::static_order(128, 4, G, c, i / 3, pm, pn)) return false;
        u.pm = pm; u.pn = pn; u.aux = n;
        const char* a = n == 0 ? A0 : (n == 1 ? A1 : A2);
        u.A = a + (size_t)pm * 256 * 512 * 2; u.B = Bbase + (size_t)n * (1024 * 512 * 2) + (size_t)pn * 256 * 512 * 2; return true;
    }
};
struct SchedMoe { static constexpr bool GATHER = false;
    const char* Abase; const char* Bbase; size_t strideB; int lda, ldb, nN, G, c; int toff[9];
    __device__ __forceinline__ bool next(int i, Unit& u) const {
        const long L = (long)i * G + c; if (L >= (long)toff[8] * nN) return false;
        const int pm = (int)(L / nN), pn = (int)(L % nN); int e = 0;
#pragma unroll
        for (int k = 1; k < 8; ++k) e += (pm >= toff[k]) ? 1 : 0;
        u.pm = pm; u.pn = pn; u.aux = e; u.A = Abase + (size_t)pm * 256 * lda * 2; u.B = Bbase + (size_t)e * strideB + (size_t)pn * 256 * ldb * 2; return true;
    }
};

struct SchedMoeG { static constexpr bool GATHER = true;
    static constexpr int nN = 11; const char* Abase; const char* Bbase; size_t strideB; int lda, ldb, G, c; int toff[9]; const LAS unsigned short* linv;
    __device__ __forceinline__ bool next(int i, Unit& u) const {
        const long L = (long)i * G + c; if (L >= (long)toff[8] * nN) return false;
        const int pm = (int)(L / nN), pn = (int)(L % nN); int e = 0;
#pragma unroll
        for (int k = 1; k < 8; ++k) e += (pm >= toff[k]) ? 1 : 0;
        u.pm = pm; u.pn = pn; u.aux = e; u.A = Abase; u.B = Bbase + (size_t)e * strideB + (size_t)pn * 256 * ldb * 2; return true;
    }
    __device__ __forceinline__ void gather(int ord, const int* R, const int* C, unsigned* v0, unsigned* v1) const {
#pragma unroll
        for (int i = 0; i < 2; ++i) { const unsigned t0 = linv[ord * 256 + R[i]], t1 = linv[ord * 256 + 128 + R[i]];
            v0[i] = (t0 * (unsigned)lda + (unsigned)C[i]) * 2u; v1[i] = (t1 * (unsigned)lda + (unsigned)C[i]) * 2u; }
    }
};

#define FOR_ROWS _Pragma("unroll") for (int ai = 0; ai < 2; ++ai) _Pragma("unroll") for (int m = 0; m < 4; ++m)
#define ROW_T (ai * 128 + wr * 64 + m * 16 + fr)

struct EpiScale {
    static __device__ __forceinline__ bool keep_acc(const Unit&) { return false; } static constexpr bool PERM = true;
    bf16_t* O; int ldc; float scale; size_t auxstride;
    __device__ __forceinline__ void operator()(const Acc& acc, const Unit& u, int wr, int wc, int fr, int fq) const {
        bf16_t* base = O + (size_t)u.aux * auxstride + (size_t)u.pm * 256 * ldc + u.pn * 256 + wc * 32 + 8 * fq;
        FOR_ROWS { const int rt = ROW_T;
#pragma unroll
            for (int bj = 0; bj < 2; ++bj) { __builtin_nontemporal_store(pack8(acc[ai][bj][m][0] * scale, acc[ai][bj][m][1] * scale), (u32x4*)(base + (size_t)rt * ldc + bj * 128)); } }
    }
};
struct EpiInProj {
    static __device__ __forceinline__ bool keep_acc(const Unit&) { return false; } static constexpr bool PERM = true;
    bf16_t* UG; bf16_t* QKV; const float* ROPE; unsigned* NORM;
    __device__ __forceinline__ void operator()(const Acc& acc, const Unit& u, int wr, int wc, int fr, int fq) const {
        if (u.pn < 2) {
            FOR_ROWS { const int rt = ROW_T; const int row = u.pm * 256 + rt, b = row >> 12, t = row & 4095, j = t >> 5, ti = t & 31;
#pragma unroll
                for (int bj = 0; bj < 2; ++bj) { const int c0 = u.pn * 256 + bj * 128 + wc * 32 + 8 * fq, g = c0 >> 4, ci = c0 & 15;
                    __builtin_nontemporal_store(pack8(acc[ai][bj][m][0], acc[ai][bj][m][1]), (u32x4*)(UG + ((size_t)(g * 1024 + b * 128 + j) * 640 + ti * 16 + ci))); } }
        } else {
            const int seg = (u.pn - 2) >> 1; const float sc = (seg == 0 || seg == 3) ? C2_64 : 1.0f; const bool rope = (seg < 2) && ((wc & 1) == 0);
            const int colbase = (u.pn - 2) * 256 + wc * 32 + 8 * fq;
            const bool nrm = (seg == 3 || seg == 4); float hm0 = 0.f, hm1 = 0.f;
            FOR_ROWS { const int rt = ROW_T; const int row = u.pm * 256 + rt;
#pragma unroll
                for (int bj = 0; bj < 2; ++bj) { f32x4 v0 = acc[ai][bj][m][0], v1 = acc[ai][bj][m][1];
                    if (nrm) { const f32x4 w0 = v0 * sc, w1 = v1 * sc; const f32x4 q2 = w0 * w0 + w1 * w1; float ss = (q2[0] + q2[1]) + (q2[2] + q2[3]);
                        ss += __shfl_xor(ss, 16); ss += __shfl_xor(ss, 32);
                        if (bj == 0) hm0 = fmaxf(hm0, ss); else hm1 = fmaxf(hm1, ss); }
                    if (rope) {
                        f32x4 p0, p1;
#pragma unroll
                        for (int k = 0; k < 4; ++k) { p0[k] = __shfl_xor(v0[k], 16); p1[k] = __shfl_xor(v1[k], 16); }
                        if (fq < 2) { const f32x4 c0 = *(const f32x4*)(ROPE + (size_t)row * 16), c1 = *(const f32x4*)(ROPE + (size_t)row * 16 + 4), s0 = *(const f32x4*)(ROPE + (size_t)row * 16 + 8), s1 = *(const f32x4*)(ROPE + (size_t)row * 16 + 12);
                            const float sg = fq == 0 ? -1.0f : 1.0f;
                            v0 = v0 * c0 + (p0 * s0) * sg; v1 = v1 * c1 + (p1 * s1) * sg; }
                    }
                    __builtin_nontemporal_store(pack8(v0 * sc, v1 * sc), (u32x4*)(QKV + (size_t)row * NQKV + colbase + bj * 128)); } }
            if (nrm) {
#pragma unroll
                for (int o = 1; o < 16; o <<= 1) { hm0 = fmaxf(hm0, __shfl_xor(hm0, o)); hm1 = fmaxf(hm1, __shfl_xor(hm1, o)); }
                if ((threadIdx.x & 63) == 0) { const int b = (u.pm * 256) >> 12, c0 = (u.pn - 2) * 256 + wc * 32;
                    __hip_atomic_fetch_max(NORM + ((b * 8 + ((c0 >> 6) & 7)) * 4 + (seg == 4 ? 2 : 0) + (wc & 1)), __float_as_uint(hm0 * 1.01f), __ATOMIC_RELAXED, __HIP_MEMORY_SCOPE_AGENT);
                    __hip_atomic_fetch_max(NORM + ((b * 8 + (((c0 + 128) >> 6) & 7)) * 4 + (seg == 4 ? 2 : 0) + (wc & 1)), __float_as_uint(hm1 * 1.01f), __ATOMIC_RELAXED, __HIP_MEMORY_SCOPE_AGENT); } }
        }
    }
};
struct EpiGates {
    static __device__ __forceinline__ bool keep_acc(const Unit&) { return false; } static constexpr bool PERM = true;
    bf16_t* G;
    __device__ __forceinline__ void operator()(const Acc& acc, const Unit& u, int wr, int wc, int fr, int fq) const {
        bf16_t* base = G + (size_t)u.pm * 256 * NGATE + u.pn * 256 + wc * 32 + 8 * fq;
        FOR_ROWS { const int rt = ROW_T;
#pragma unroll
            for (int bj = 0; bj < 2; ++bj) { f32x4 a = acc[ai][bj][m][0], b = acc[ai][bj][m][1];
#pragma unroll
                for (int k = 0; k < 4; ++k) { a[k] = sigmoidf_(a[k]); b[k] = sigmoidf_(b[k]); }
                __builtin_nontemporal_store(pack8(a, b), (u32x4*)(base + (size_t)rt * NGATE + bj * 128)); } }
    }
};
struct EpiGlu {
    static constexpr bool F16 = false; static __device__ __forceinline__ bool keep_acc(const Unit&) { return false; } static constexpr bool PERM = true; static constexpr int NVMEM = 0;
    const bf16_t* Y; bf16_t* O;
    __device__ __forceinline__ void operator()(const Acc& acc, const Unit& u, int wr, int wc, int fr, int fq) const {
        const size_t off0 = (size_t)u.pm * 256 * 512 + u.pn * 256 + wc * 32 + 8 * fq;
#pragma unroll
        for (int ai = 0; ai < 2; ++ai) {
            u32x4 yz[4][2];
#pragma unroll
            for (int m = 0; m < 4; ++m)
#pragma unroll
                for (int bj = 0; bj < 2; ++bj) yz[m][bj] = *(const u32x4*)(Y + off0 + (size_t)ROW_T * 512 + bj * 128);
#pragma unroll
            for (int m = 0; m < 4; ++m)
#pragma unroll
                for (int bj = 0; bj < 2; ++bj) { f32x4 ya, yb; unpack8(yz[m][bj], ya, yb); f32x4 a = acc[ai][bj][m][0], b = acc[ai][bj][m][1];
#pragma unroll
                    for (int k = 0; k < 4; ++k) { a[k] = ya[k] * sigmoidf_(a[k]); b[k] = yb[k] * sigmoidf_(b[k]); }
                    *(u32x4*)(O + off0 + (size_t)ROW_T * 512 + bj * 128) = pack8(a, b); }
            asm volatile("" ::: "memory");
        }
    }

};
struct EpiMerge {
    static constexpr bool F16 = false; static __device__ __forceinline__ bool keep_acc(const Unit& u) { return u.aux < 2; } static constexpr bool PERM = true; static constexpr int NVMEM = 0;
    const bf16_t* G; bf16_t* M;
    __device__ __forceinline__ void operator()(Acc& acc, const Unit& u, int wr, int wc, int fr, int fq) const {
        const int col0 = u.pn * 256 + wc * 32 + 8 * fq; const int n = u.aux;
#pragma unroll
        for (int ai = 0; ai < 2; ++ai)
#pragma unroll
            for (int mp = 0; mp < 2; ++mp) {
                u32x4 gz[2][2], hz[2][2];
#pragma unroll
                for (int mm = 0; mm < 2; ++mm) { const int m = 2 * mp + mm; const size_t row = (size_t)u.pm * 256 + ROW_T;
#pragma unroll
                    for (int bj = 0; bj < 2; ++bj) { gz[mm][bj] = *(const u32x4*)(G + row * NGATE + n * 1024 + col0 + bj * 128); if (n < 2) hz[mm][bj] = *(const u32x4*)(G + row * NGATE + (n + 1) * 1024 + col0 + bj * 128); } }
#pragma unroll
                for (int mm = 0; mm < 2; ++mm) { const int m = 2 * mp + mm; const size_t row = (size_t)u.pm * 256 + ROW_T;
#pragma unroll
                    for (int bj = 0; bj < 2; ++bj) { f32x4 ga, gb; unpack8(gz[mm][bj], ga, gb);
#pragma unroll
                        for (int k = 0; k < 4; ++k) { ga[k] = fmaxf(ga[k], 1.0e-30f); gb[k] = fmaxf(gb[k], 1.0e-30f); }
                        if (n < 2) { f32x4 ha, hb; unpack8(hz[mm][bj], ha, hb);
#pragma unroll
                            for (int k = 0; k < 4; ++k) { ga[k] *= frcp(fmaxf(ha[k], 1.0e-30f)); gb[k] *= frcp(fmaxf(hb[k], 1.0e-30f)); }
                            acc[ai][bj][m][0] *= ga; acc[ai][bj][m][1] *= gb; }
                        else *(u32x4*)(M + row * 1024 + col0 + bj * 128) = pack8(acc[ai][bj][m][0] * ga, acc[ai][bj][m][1] * gb); } }
                asm volatile("" ::: "memory");
            }
    }

};
template <bool INF32> struct EpiResT {
    static __device__ __forceinline__ bool keep_acc(const Unit&) { return false; } static constexpr bool PERM = true; static constexpr int NVMEM = 0;
    unsigned short* ZH; const float* X32; const float* ST; const float* g; const float* b;
    __device__ __forceinline__ void operator()(const Acc& acc, const Unit& u, int wr, int wc, int fr, int fq) const {
        const int col0 = u.pn * 256 + wc * 32 + 8 * fq;
        f32x4 g4[2][2], b4[2][2];
#pragma unroll
        for (int bj = 0; bj < 2; ++bj)
#pragma unroll
            for (int n = 0; n < 2; ++n) { g4[bj][n] = *(const f32x4*)(g + col0 + bj * 128 + n * 4); b4[bj][n] = *(const f32x4*)(b + col0 + bj * 128 + n * 4) * ALPHA; }
#pragma unroll
        for (int ai = 0; ai < 2; ++ai) {
            u32x4 zr[4][2]; f32x2 stv[4];
#pragma unroll
            for (int m = 0; m < 4; ++m) { const size_t row = (size_t)u.pm * 256 + ROW_T; stv[m] = *(const f32x2*)(ST + row * 2);
                if (!INF32) {
#pragma unroll
                    for (int bj = 0; bj < 2; ++bj) zr[m][bj] = *(const u32x4*)(ZH + row * D + col0 + bj * 128); } }
#pragma unroll
            for (int m = 0; m < 4; ++m) { const size_t row = (size_t)u.pm * 256 + ROW_T; const f32x2 st = stv[m]; const float sc = st.y * ALPHA;
#pragma unroll
                for (int bj = 0; bj < 2; ++bj) { const size_t off = row * D + col0 + bj * 128; f32x4 x0, x1;
                    if (INF32) { x0 = *(const f32x4*)(X32 + off); x1 = *(const f32x4*)(X32 + off + 4); } else unpack8h(zr[m][bj], x0, x1);
                    x0 = ((x0 - st.x) * sc) * g4[bj][0] + b4[bj][0] + acc[ai][bj][m][0]; x1 = ((x1 - st.x) * sc) * g4[bj][1] + b4[bj][1] + acc[ai][bj][m][1];
                    *(u32x4*)(ZH + off) = pack8h(x0, x1); } }
            asm volatile("" ::: "memory");
        }
    }
};
struct EpiSwiglu {
    static __device__ __forceinline__ bool keep_acc(const Unit&) { return false; } static constexpr bool PERM = true;
    bf16_t* H; int ldh;
    __device__ __forceinline__ void operator()(const Acc& acc, const Unit& u, int wr, int wc, int fr, int fq) const {
        bf16_t* base = H + (size_t)u.pm * 256 * ldh + u.pn * 128 + wc * 32 + 8 * fq;
        FOR_ROWS { const int rt = ROW_T; f32x4 a = acc[ai][0][m][0], b = acc[ai][0][m][1]; const f32x4 ua = acc[ai][1][m][0], ub = acc[ai][1][m][1];
#pragma unroll
            for (int k = 0; k < 4; ++k) { a[k] = siluf_(a[k]) * ua[k]; b[k] = siluf_(b[k]) * ub[k]; }
            __builtin_nontemporal_store(pack8(a, b), (u32x4*)(base + (size_t)rt * ldh)); }
    }
};
struct EpiS1 {
    static __device__ __forceinline__ bool keep_acc(const Unit&) { return false; } static constexpr bool PERM = false;
    float* SLOC;
    __device__ __forceinline__ void operator()(const Acc& acc, const Unit& u, int wr, int wc, int fr, int fq) const {
        float* base = SLOC + ((size_t)u.aux * 1024 + u.pm * 256) * 128 + wc * 32 + 4 * fq;
        FOR_ROWS { const int rt = ROW_T;
#pragma unroll
            for (int n = 0; n < 2; ++n) *(f32x4*)(base + (size_t)rt * 128 + n * 16) = acc[ai][0][m][n]; }
    }
};
struct EpiS3 {
    static constexpr bool F16 = false; static __device__ __forceinline__ bool keep_acc(const Unit&) { return false; } static constexpr bool PERM = true; static constexpr int NVMEM = 0;
    const bf16_t* UG; const float* dskip; bf16_t* Y;
    __device__ __forceinline__ void operator()(const Acc& acc, const Unit& u, int wr, int wc, int fr, int fq) const {
        const int g = u.aux;
        f32x4 da[2], db[2]; int to[2], co[2];
#pragma unroll
        for (int bj = 0; bj < 2; ++bj) { const int n0 = u.pn * 256 + bj * 128 + wc * 32 + 8 * fq; to[bj] = n0 >> 4; co[bj] = n0 & 15; da[bj] = *(const f32x4*)(dskip + g * 16 + co[bj]); db[bj] = *(const f32x4*)(dskip + g * 16 + co[bj] + 4); }
#pragma unroll
        for (int ai = 0; ai < 2; ++ai) {
            u32x4 uz[4][2];
#pragma unroll
            for (int m = 0; m < 4; ++m)
#pragma unroll
                for (int bj = 0; bj < 2; ++bj) uz[m][bj] = *(const u32x4*)(UG + ((size_t)(g * 1024 + u.pm * 256 + ROW_T) * 640 + to[bj] * 16 + co[bj]));
#pragma unroll
            for (int m = 0; m < 4; ++m) { const int R = u.pm * 256 + ROW_T, b = R >> 7, j = R & 127;
#pragma unroll
                for (int bj = 0; bj < 2; ++bj) { f32x4 ua, ub; unpack8(uz[m][bj], ua, ub);
                    f32x4 a = acc[ai][bj][m][0] + da[bj] * ua, bb = acc[ai][bj][m][1] + db[bj] * ub;
#pragma unroll
                    for (int k = 0; k < 4; ++k) { a[k] = gelu_tanh_(a[k]); bb[k] = gelu_tanh_(bb[k]); }
                    *(u32x4*)(Y + ((size_t)(b * 4096 + j * 32 + to[bj]) * 512 + g * 16 + co[bj])) = pack8(a, bb); } }
            asm volatile("" ::: "memory");
        }
    }

};

namespace att {
__device__ __forceinline__ int crow(int r, int hi) { return (r & 3) + 8 * (r >> 2) + 4 * hi; }
__device__ __forceinline__ float swap_max(float m) { auto rr = __builtin_amdgcn_permlane32_swap(__float_as_uint(m), __float_as_uint(m), false, false); return fmaxf(__uint_as_float(rr[0]), __uint_as_float(rr[1])); }
__device__ __forceinline__ float swap_add(float m) { auto rr = __builtin_amdgcn_permlane32_swap(__float_as_uint(m), __float_as_uint(m), false, false); return __uint_as_float(rr[0]) + __uint_as_float(rr[1]); }
__device__ __forceinline__ float rowmax(const f32x16& p0, const f32x16& p1) {
    float a = fmaxf(p0[0], p1[0]);
#pragma unroll
    for (int r = 1; r < 16; ++r) a = fmaxf(a, fmaxf(p0[r], p1[r]));
    return swap_max(a);
}
__device__ __forceinline__ float max3f(float a, float b, float c) { float r; asm("v_max3_f32 %0, %1, %2, %3" : "=v"(r) : "v"(a), "v"(b), "v"(c)); return r; }
__device__ __forceinline__ float rowmax_fast(const f32x16& p0, const f32x16& p1) {
    float a = max3f(p0[0], p0[1], p1[0]), b = max3f(p0[2], p0[3], p1[1]); a = max3f(a, p1[2], p1[3]);
#pragma unroll
    for (int r = 4; r < 16; r += 4) { a = max3f(a, p0[r], p0[r + 1]); b = max3f(b, p0[r + 2], p0[r + 3]); a = max3f(a, p1[r], p1[r + 1]); b = max3f(b, p1[r + 2], p1[r + 3]); }
    float m; asm("v_max_f32_e32 %0, %1, %2" : "=v"(m) : "v"(a), "v"(b));
    auto rr = __builtin_amdgcn_permlane32_swap(__float_as_uint(m), __float_as_uint(m), false, false);
    float o; asm("v_max_f32_e32 %0, %1, %2" : "=v"(o) : "v"(__uint_as_float(rr[0])), "v"(__uint_as_float(rr[1]))); return o;
}
template <int NK> __device__ __forceinline__ void qkt(f32x16& p0, f32x16& p1, const LAS unsigned char* Kslot, const bf16x8* qr, int r32, int hi) {
    const LAS unsigned char* kb = Kslot + hi * 1024 + r32 * 16;
#pragma unroll
    for (int d0 = 0; d0 < NK; ++d0) {
        const bf16x8 b0 = *(const LAS bf16x8*)(kb + d0 * 2048);
        const bf16x8 b1 = *(const LAS bf16x8*)(kb + d0 * 2048 + 512);
        p0 = __builtin_amdgcn_mfma_f32_32x32x16_bf16(b0, qr[d0], p0, 0, 0, 0);
        p1 = __builtin_amdgcn_mfma_f32_32x32x16_bf16(b1, qr[d0], p1, 0, 0, 0);
    }
}
template <int ND> __device__ __forceinline__ void pv(f32x16* o, unsigned vb, bf16x8 pa0, bf16x8 pa1, bf16x8 pa2, bf16x8 pa3) {
#pragma unroll
    for (int d0 = 0; d0 < ND; ++d0) { s16x4 lo[4], hi[4];
#pragma unroll
        for (int ks = 0; ks < 4; ++ks) {
            asm volatile("ds_read_b64_tr_b16 %0, %1 offset:%c2" : "=&v"(lo[ks]) : "v"(vb), "i"(d0 * 4096 + ks * 1024) : "memory");
            asm volatile("ds_read_b64_tr_b16 %0, %1 offset:%c2" : "=&v"(hi[ks]) : "v"(vb), "i"(d0 * 4096 + ks * 1024 + 512) : "memory"); }
        asm volatile("s_waitcnt lgkmcnt(0)" ::: "memory"); __builtin_amdgcn_sched_barrier(0);
#define ATT_PK(k) (bf16x8){lo[k][0], lo[k][1], lo[k][2], lo[k][3], hi[k][0], hi[k][1], hi[k][2], hi[k][3]}
        o[d0] = __builtin_amdgcn_mfma_f32_32x32x16_bf16(pa0, ATT_PK(0), o[d0], 0, 0, 0);
        o[d0] = __builtin_amdgcn_mfma_f32_32x32x16_bf16(pa1, ATT_PK(1), o[d0], 0, 0, 0);
        o[d0] = __builtin_amdgcn_mfma_f32_32x32x16_bf16(pa2, ATT_PK(2), o[d0], 0, 0, 0);
        o[d0] = __builtin_amdgcn_mfma_f32_32x32x16_bf16(pa3, ATT_PK(3), o[d0], 0, 0, 0);
#undef ATT_PK
    }
}
__device__ __forceinline__ void glds16(const void* gsrc, unsigned lds_dst) { unsigned keep;
    asm volatile("s_mov_b32 %0, m0\n\ts_mov_b32 m0, %2\n\ts_nop 0\n\tglobal_load_lds_dwordx4 %1, off\n\ts_mov_b32 m0, %0" : "=&s"(keep) : "v"(gsrc), "s"(lds_dst) : "memory"); }
#define ATT_WAITBAR() do { asm volatile("s_waitcnt vmcnt(0) lgkmcnt(0)" ::: "memory"); __builtin_amdgcn_s_barrier(); asm volatile("" ::: "memory"); } while (0)
constexpr float NEG = -1.0e30f;

constexpr int ATT_NS = 4, ATT_KSLOT = 10240, ATT_VOFF = ATT_NS * ATT_KSLOT, ATT_OST = ATT_VOFF + ATT_NS * 8192;
template <int MODE>
__device__ __forceinline__ void attn64_unit(LAS unsigned char* lds, LAS float* wsf_all, const bf16_t* Qp, const bf16_t* Kp, const bf16_t* Vp, const long rs,
                                            const int i0, const int t_lo, const int t_hi, const bf16_t* kbias, bf16_t* Op, const long os, float* lsep, const long ls) {
    int tid = threadIdx.x; asm volatile("" : "+v"(tid));
    const int lane = tid & 63, r32 = lane & 31, hi = lane >> 5, wid = __builtin_amdgcn_readfirstlane(tid >> 6);
    LAS float* wsf = wsf_all + wid * 64;
    const int qw0 = i0 + wid * 32, qi = qw0 + r32;
    constexpr float THR = 30.0f;
    int w_lo = t_lo; const int w_hi = ((qw0 + 31) >> 6) + 1;
    if (MODE == 1) { const int lo = (qw0 - 128) >> 6; w_lo = lo > t_lo ? lo : t_lo; }
    float mhat = 0.f, lrun = 0.f; bool started = false; f32x16 o[2]; o[0] = f32x16{}; o[1] = f32x16{};
    f32x16 negm = f32x16{};
    const bf16_t* ksrc = Kp + (long)lane * rs + wid * 8;
    const bf16_t* vsrc = Vp + (long)(16 * (wid & 3) + (lane >> 2)) * rs + (wid >> 2) * 32 + (lane & 3) * 8;
    const unsigned vb0 = (unsigned)(uintptr_t)(lds + ATT_VOFF) + ((lane >> 4) & 1) * 32 + (lane & 3) * 8 + (4 * hi + ((lane & 15) >> 2)) * 64;
#define ATT_ISSUE(tt) do { const int t_ = (tt) < t_hi ? (tt) : t_hi - 1; const int s_ = (tt) & (ATT_NS - 1); const unsigned l0_ = (unsigned)(uintptr_t)lds; \
        glds16(ksrc + (long)t_ * 64 * rs, (unsigned)__builtin_amdgcn_readfirstlane((int)(l0_ + s_ * ATT_KSLOT + wid * 1024))); \
        glds16(vsrc + (long)t_ * 64 * rs, (unsigned)__builtin_amdgcn_readfirstlane((int)(l0_ + ATT_VOFF + s_ * 8192 + wid * 1024))); \
        if (MODE == 0 && wid == 0) glds16(kbias + (long)(t_ * 64 + lane) * 64, (unsigned)__builtin_amdgcn_readfirstlane((int)(l0_ + s_ * ATT_KSLOT + 8192))); } while (0)
#define ATT_QK(tt) do { const LAS unsigned char* Ks_ = lds + ((tt) & (ATT_NS - 1)) * ATT_KSLOT; const LAS unsigned char* kb_ = Ks_ + hi * 1024 + r32 * 16; bf16x8 kf[10]; \
        _Pragma("unroll") for (int d0_ = 0; d0_ < 4; ++d0_) { kf[2 * d0_] = *(const LAS bf16x8*)(kb_ + d0_ * 2048); kf[2 * d0_ + 1] = *(const LAS bf16x8*)(kb_ + d0_ * 2048 + 512); } \
        if (MODE == 0) { const LAS unsigned char* kx_ = Ks_ + 8192 + r32 * 16; kf[8] = *(const LAS bf16x8*)(kx_); kf[9] = *(const LAS bf16x8*)(kx_ + 512); \
            asm volatile("s_waitcnt lgkmcnt(0)" : "+v"(kf[0]), "+v"(kf[1]), "+v"(kf[2]), "+v"(kf[3]), "+v"(kf[4]), "+v"(kf[5]), "+v"(kf[6]), "+v"(kf[7]), "+v"(kf[8]), "+v"(kf[9]) :: "memory"); } \
        else asm volatile("s_waitcnt lgkmcnt(0)" : "+v"(kf[0]), "+v"(kf[1]), "+v"(kf[2]), "+v"(kf[3]), "+v"(kf[4]), "+v"(kf[5]), "+v"(kf[6]), "+v"(kf[7]) :: "memory"); \
        p0 = __builtin_amdgcn_mfma_f32_32x32x16_bf16(kf[0], qr[0], negm, 0, 0, 0); \
        p1 = __builtin_amdgcn_mfma_f32_32x32x16_bf16(kf[1], qr[0], negm, 0, 0, 0); \
        _Pragma("unroll") for (int d0_ = 1; d0_ < 4; ++d0_) { \
            p0 = __builtin_amdgcn_mfma_f32_32x32x16_bf16(kf[2 * d0_], qr[d0_], p0, 0, 0, 0); \
            p1 = __builtin_amdgcn_mfma_f32_32x32x16_bf16(kf[2 * d0_ + 1], qr[d0_], p1, 0, 0, 0); } \
        if (MODE == 0) { p0 = __builtin_amdgcn_mfma_f32_32x32x16_bf16(kf[8], qr[4], p0, 0, 0, 0); p1 = __builtin_amdgcn_mfma_f32_32x32x16_bf16(kf[9], qr[4], p1, 0, 0, 0); } \
        asm volatile("s_nop 15\n\ts_nop 7" : "+v"(p0), "+v"(p1)); } while (0)
#define ATT_WAIT_TILES(n2, n3) do { if (MODE == 0 && wid == 0) asm volatile("s_waitcnt vmcnt(" #n3 ") lgkmcnt(0)" ::: "memory"); else asm volatile("s_waitcnt vmcnt(" #n2 ") lgkmcnt(0)" ::: "memory"); \
        __builtin_amdgcn_s_barrier(); asm volatile("" ::: "memory"); } while (0)
    ATT_ISSUE(t_lo); ATT_ISSUE(t_lo + 1); ATT_ISSUE(t_lo + 2);
    bf16x8 qr[5];
#pragma unroll
    for (int d0 = 0; d0 < 4; ++d0) qr[d0] = *(const bf16x8*)(Qp + (long)qi * rs + d0 * 16 + hi * 8);
    { const short one = hi == 0 ? (short)0x3F80 : (short)0; qr[4] = (bf16x8){one, one, one, 0, 0, 0, 0, 0}; }
    asm volatile("s_waitcnt vmcnt(0)" : "+v"(qr[0]), "+v"(qr[1]), "+v"(qr[2]), "+v"(qr[3]) :: "memory");
    const bool stag = wid >= 4;
    f32x16 p0 = f32x16{}, p1 = f32x16{};
    ATT_WAIT_TILES(4, 6);
    if (stag && t_lo >= w_lo && t_lo < w_hi) ATT_QK(t_lo);
    for (int t = t_lo; t < t_hi; ++t) {
        ATT_WAIT_TILES(2, 3);
        ATT_ISSUE(t + 3);
        const bool a0 = (t >= w_lo && t < w_hi), a1 = (t + 1 >= w_lo && t + 1 < w_hi);
        if (!stag && a0) ATT_QK(t);
        if (a0) {
            const int kvb = 64 * t + 4 * hi;
            if (MODE == 0) {
                if (64 * t + 63 > qw0) {
#pragma unroll
                    for (int r = 0; r < 16; ++r) { const int kv = kvb + (r & 3) + 8 * (r >> 2); if (kv > qi) p0[r] = -INFINITY; if (kv + 32 > qi) p1[r] = -INFINITY; }
                }
            } else {
                if (64 * t + 63 > qw0 || 64 * t < qw0 + 31 - 128) {
#pragma unroll
                    for (int r = 0; r < 16; ++r) { const int dd = qi - (kvb + (r & 3) + 8 * (r >> 2)); if (dd < 0 || dd > 128) p0[r] = -INFINITY; if (dd - 32 < 0 || dd - 32 > 128) p1[r] = -INFINITY; }
                }
            }
            const float rm = rowmax_fast(p0, p1);
            const bool need = started ? (rm > THR) : (rm > -1.0e30f);
            bool resc = false;
            if (__any(need)) {
                const float dl = need ? rm : 0.f; mhat += dl;
#pragma unroll
                for (int r = 0; r < 16; ++r) { p0[r] -= dl; p1[r] -= dl; }
#pragma unroll
                for (int r = 0; r < 16; ++r) negm[r] = -mhat;
                const float f = (need && started) ? fexp2(-dl) : 1.0f; lrun *= f; started = started || need;
                if (hi == 0) wsf[r32] = f; resc = true;
            }
            float ps = 0.f;
#pragma unroll
            for (int r = 0; r < 16; ++r) { p0[r] = fexp2(p0[r]); p1[r] = fexp2(p1[r]); ps += p0[r] + p1[r]; }
            lrun += ps;
            if (resc) {
                asm volatile("s_waitcnt lgkmcnt(0)" ::: "memory");
#pragma unroll
                for (int g = 0; g < 4; ++g) { const f32x4 fv = *(const LAS f32x4*)(wsf + 8 * g + 4 * hi);
#pragma unroll
                    for (int k = 0; k < 4; ++k) { o[0][4 * g + k] *= fv[k]; o[1][4 * g + k] *= fv[k]; } }
            }
            u32x4 pw0, pw1, pw2, pw3;
            pw0 = (u32x4){cvt_pk_bf16(p0[0], p0[1]), cvt_pk_bf16(p0[2], p0[3]), cvt_pk_bf16(p0[4], p0[5]), cvt_pk_bf16(p0[6], p0[7])};
            pw1 = (u32x4){cvt_pk_bf16(p0[8], p0[9]), cvt_pk_bf16(p0[10], p0[11]), cvt_pk_bf16(p0[12], p0[13]), cvt_pk_bf16(p0[14], p0[15])};
            pw2 = (u32x4){cvt_pk_bf16(p1[0], p1[1]), cvt_pk_bf16(p1[2], p1[3]), cvt_pk_bf16(p1[4], p1[5]), cvt_pk_bf16(p1[6], p1[7])};
            pw3 = (u32x4){cvt_pk_bf16(p1[8], p1[9]), cvt_pk_bf16(p1[10], p1[11]), cvt_pk_bf16(p1[12], p1[13]), cvt_pk_bf16(p1[14], p1[15])};
            pv<2>(o, vb0 + (t & (ATT_NS - 1)) * 8192, __builtin_bit_cast(bf16x8, pw0), __builtin_bit_cast(bf16x8, pw1), __builtin_bit_cast(bf16x8, pw2), __builtin_bit_cast(bf16x8, pw3));
        }
        if (stag && a1) ATT_QK(t + 1);
    }
#undef ATT_ISSUE
#undef ATT_QK
#undef ATT_WAIT_TILES
    const float ltot = swap_add(lrun);
    if (hi == 0) { wsf[32 + r32] = ltot; if (MODE == 1) lsep[(long)qi * ls] = mhat + __builtin_amdgcn_logf(ltot); }
    asm volatile("s_waitcnt lgkmcnt(0)" ::: "memory");
    LAS bf16_t* stg = (LAS bf16_t*)(lds + ATT_OST) + wid * 2048;
#pragma unroll
    for (int g = 0; g < 4; ++g) { const f32x4 lv = *(const LAS f32x4*)(wsf + 32 + 8 * g + 4 * hi);
#pragma unroll
        for (int k = 0; k < 4; ++k) { const int r = 4 * g + k; const float rl = frcp(lv[k]); LAS bf16_t* srow = stg + crow(r, hi) * 64 + r32;
            srow[0] = (bf16_t)(cvt_pk_bf16(o[0][r] * rl, 0.f) & 0xffffu); srow[32] = (bf16_t)(cvt_pk_bf16(o[1][r] * rl, 0.f) & 0xffffu); } }
    asm volatile("s_waitcnt lgkmcnt(0)" ::: "memory");
#pragma unroll
    for (int i = 0; i < 4; ++i) { const int row = i * 8 + (lane >> 3), ch = lane & 7; const u32x4 v = *(const LAS u32x4*)(stg + row * 64 + ch * 8); *(u32x4*)(Op + (long)(qw0 + row) * os + ch * 8) = v; }
    ATT_WAITBAR();
}

__device__ __forceinline__ s16x4 vtr(const LAS unsigned char* p) { return __builtin_amdgcn_ds_read_tr16_b64_v4i16((LAS s16x4*)p); }
#define FX_MX3(a, b, c) __builtin_fmaxf(__builtin_fmaxf((a), (b)), (c))
__device__ __forceinline__ float rowmax_b(const f32x16& p0, const f32x16& p1) {
    float a = FX_MX3(p0[0], p0[1], p1[0]), b = FX_MX3(p0[2], p0[3], p1[1]); a = FX_MX3(a, p1[2], p1[3]);
#pragma unroll
    for (int r = 4; r < 16; r += 4) { a = FX_MX3(a, p0[r], p0[r + 1]); b = FX_MX3(b, p0[r + 2], p0[r + 3]); a = FX_MX3(a, p1[r], p1[r + 1]); b = FX_MX3(b, p1[r + 2], p1[r + 3]); }
    const float m = __builtin_fmaxf(a, b); auto rr = __builtin_amdgcn_permlane32_swap(__float_as_uint(m), __float_as_uint(m), false, false);
    return __builtin_fmaxf(__uint_as_float(rr[0]), __uint_as_float(rr[1])); }
__device__ __forceinline__ void fox_unit(LAS unsigned char* lds, LAS float* wsf_all, const bf16_t* Qp, const bf16_t* Kp, const bf16_t* Vp, const long rs,
                                         const int i0, const int t_lo, const int t_hi, const bf16_t* kbias, bf16_t* Op, const long os) {
    int tid = threadIdx.x; asm volatile("" : "+v"(tid));
    const int lane = tid & 63, r32 = lane & 31, hi = lane >> 5, wid = __builtin_amdgcn_readfirstlane(tid >> 6);
    LAS float* wsf = wsf_all + wid * 64;
    const int qw0 = i0 + wid * 32, qi = qw0 + r32;
    constexpr float THR = 30.0f;
#define FX_SBAR() __builtin_amdgcn_sched_barrier(0)
#define FX_PIN(x) asm volatile("" : "+v"(x))
#define FX_MF(a, b, c) __builtin_amdgcn_mfma_f32_32x32x16_bf16(a, b, c, 0, 0, 0)
    float mhat = 0.f, lrun = 0.f; f32x16 o[2]; o[0] = f32x16{}; o[1] = f32x16{};
    const bf16_t* ksrc = Kp + (long)lane * rs + wid * 8;
    const bf16_t* vsrc = Vp + (long)(16 * (wid & 3) + (lane >> 2)) * rs + (wid >> 2) * 32 + (lane & 3) * 8;
    const LAS unsigned char* vp0 = lds + ATT_VOFF + ((lane >> 4) & 1) * 32 + (lane & 3) * 8 + (4 * hi + ((lane & 15) >> 2)) * 64;
    const LAS unsigned char* kp0 = lds + hi * 1024 + r32 * 16;
    const LAS unsigned char* kx0 = lds + 8192 + r32 * 16;
#define FX_DMA_K(tt) do { const int t_ = (tt) < t_hi ? (tt) : t_hi - 1; const int s_ = (tt) & (ATT_NS - 1); const unsigned l0_ = (unsigned)(uintptr_t)lds; \
        glds16(ksrc + (long)t_ * 64 * rs, (unsigned)__builtin_amdgcn_readfirstlane((int)(l0_ + s_ * ATT_KSLOT + wid * 1024))); \
        if (wid == 0) glds16(kbias + (long)(t_ * 64 + lane) * 64, (unsigned)__builtin_amdgcn_readfirstlane((int)(l0_ + s_ * ATT_KSLOT + 8192))); } while (0)
#define FX_DMA_V(tt) do { const int t_ = (tt) < t_hi ? (tt) : t_hi - 1; const int s_ = (tt) & (ATT_NS - 1); const unsigned l0_ = (unsigned)(uintptr_t)lds; \
        glds16(vsrc + (long)t_ * 64 * rs, (unsigned)__builtin_amdgcn_readfirstlane((int)(l0_ + ATT_VOFF + s_ * 8192 + wid * 1024))); } while (0)
#define FX_WAIT_BAR() do { if (wid == 0) asm volatile("s_waitcnt vmcnt(4) lgkmcnt(0)\n\ts_barrier" ::: "memory"); else asm volatile("s_waitcnt vmcnt(3) lgkmcnt(0)\n\ts_barrier" ::: "memory"); } while (0)
#define FX_KLOAD2(kp_, d0) do { kf[2 * (d0)] = *(const LAS bf16x8*)((kp_) + (d0) * 2048); kf[2 * (d0) + 1] = *(const LAS bf16x8*)((kp_) + (d0) * 2048 + 512); } while (0)
#define FX_KLOADX(kx_) do { kf[8] = *(const LAS bf16x8*)(kx_); kf[9] = *(const LAS bf16x8*)((kx_) + 512); } while (0)
#define FX_MASK(C0, C1, tt) do { if (64 * (tt) + 63 > qw0) { const int kvb_ = 64 * (tt) + 4 * hi; \
        _Pragma("unroll") for (int r = 0; r < 16; ++r) { const int kv = kvb_ + (r & 3) + 8 * (r >> 2); if (kv > qi) C0[r] = -INFINITY; if (kv + 32 > qi) C1[r] = -INFINITY; } } } while (0)
#define FX_SETREF() do { const float nm_ = -mhat; const unsigned h1_ = cvt_pk_bf16(nm_, 0.f) & 0xffffu; const float r1_ = nm_ - bf_lo(h1_); const unsigned h2_ = cvt_pk_bf16(r1_, 0.f) & 0xffffu; \
        const float r2_ = r1_ - bf_lo(h2_); const unsigned h3_ = cvt_pk_bf16(r2_, 0.f) & 0xffffu; \
        u32x4 q4_; q4_.x = q4d0; q4_.y = hi == 0 ? (0x3F80u | (h1_ << 16)) : 0u; q4_.z = hi == 0 ? (h2_ | (h3_ << 16)) : 0u; q4_.w = 0u; qr[4] = __builtin_bit_cast(bf16x8, q4_); } while (0)
    FX_DMA_K(t_lo); FX_DMA_K(t_lo + 1); FX_DMA_V(t_lo); FX_DMA_K(t_lo + 2); FX_DMA_V(t_lo + 1); FX_DMA_K(t_lo + 3); FX_DMA_V(t_lo + 2);
    bf16x8 qr[5];
#pragma unroll
    for (int d0 = 0; d0 < 4; ++d0) qr[d0] = *(const bf16x8*)(Qp + (long)qi * rs + d0 * 16 + hi * 8);
    unsigned q4d0 = hi == 0 ? 0x3F803F80u : 0u; asm volatile("" : "+v"(q4d0));
    { u32x4 q4_; q4_.x = q4d0; q4_.y = hi == 0 ? 0x3F80u : 0u; q4_.z = 0u; q4_.w = 0u; qr[4] = __builtin_bit_cast(bf16x8, q4_); }
    asm volatile("s_waitcnt vmcnt(0)" : "+v"(qr[0]), "+v"(qr[1]), "+v"(qr[2]), "+v"(qr[3]) :: "memory");
    asm volatile("s_barrier" ::: "memory");
    f32x16 pA0, pA1, pB0, pB1; bf16x8 kf[10]; s16x4 vlo[8], vhi[8]; u32x4 pw0, pw1, pw2, pw3; bool resc = false;
    { const LAS unsigned char* kp_ = kp0 + (t_lo & (ATT_NS - 1)) * ATT_KSLOT;
      FX_KLOAD2(kp_, 0); FX_KLOAD2(kp_, 1); FX_KLOAD2(kp_, 2); FX_KLOAD2(kp_, 3); FX_KLOADX(kx0 + (t_lo & (ATT_NS - 1)) * ATT_KSLOT); }
    pA0 = FX_MF(kf[8], qr[4], (f32x16){}); pA1 = FX_MF(kf[9], qr[4], (f32x16){});
#pragma unroll
    for (int d0 = 0; d0 < 4; ++d0) { pA0 = FX_MF(kf[2 * d0], qr[d0], pA0); pA1 = FX_MF(kf[2 * d0 + 1], qr[d0], pA1); }
    FX_MASK(pA0, pA1, t_lo);
    { const float rm = rowmax_b(pA0, pA1); mhat = rm;
#pragma unroll
      for (int r = 0; r < 16; ++r) { pA0[r] = fexp2(pA0[r] - rm); pA1[r] = fexp2(pA1[r] - rm); }
      FX_SETREF(); }
    { const LAS unsigned char* kp_ = kp0 + ((t_lo + 1) & (ATT_NS - 1)) * ATT_KSLOT;
      FX_KLOAD2(kp_, 0); FX_KLOAD2(kp_, 1); FX_KLOAD2(kp_, 2); FX_KLOAD2(kp_, 3); FX_KLOADX(kx0 + ((t_lo + 1) & (ATT_NS - 1)) * ATT_KSLOT); }
    asm volatile("s_waitcnt lgkmcnt(0)\n\ts_barrier" ::: "memory");
#define FX_PKW(P, i) cvt_pk_bf16(P[i], P[(i) + 1])
#define FX_PAF(k) __builtin_bit_cast(bf16x8, pw##k)
#define FX_VFR(i) (bf16x8){vlo[i][0], vlo[i][1], vlo[i][2], vlo[i][3], vhi[i][0], vhi[i][1], vhi[i][2], vhi[i][3]}
#define FX_VRD(i) do { vlo[i] = vtr(vp_ + (((i) >> 2) * 4096 + ((i) & 3) * 1024)); vhi[i] = vtr(vp_ + (((i) >> 2) * 4096 + ((i) & 3) * 1024 + 512)); } while (0)
#define FX_GAPA(MF, a0, a1, a2, W0, W1, PW) do { MF; sacc += a0; sacc += a1; sacc += a2; W0; W1; FX_PIN(PW); FX_PIN(sacc); FX_SBAR(); } while (0)
#define FX_GAPA3(MF, a0, a1, a2) do { MF; sacc += a0; sacc += a1; sacc += a2; FX_PIN(sacc); FX_SBAR(); } while (0)
#define FX_GAPB(MF, X, i) do { MF; X[i] = fexp2(X[i]); X[(i) + 1] = fexp2(X[(i) + 1]); X[(i) + 2] = fexp2(X[(i) + 2]); X[(i) + 3] = fexp2(X[(i) + 3]); FX_PIN(X); FX_SBAR(); } while (0)
#define FX_STEP(C0, C1, P0, P1, t, MASK) do { FX_SBAR(); \
    const LAS unsigned char* vp_ = vp0 + (((t) - 1) & (ATT_NS - 1)) * 8192; \
    FX_VRD(0); FX_SBAR(); float sacc = P0[0] + P0[1]; \
                       FX_GAPA(C0 = FX_MF(kf[8], qr[4], (f32x16){}), P0[2], P0[3], P0[4],    pw0[0] = FX_PKW(P0, 0),  pw0[1] = FX_PKW(P0, 2),  pw0); \
    FX_VRD(4); FX_SBAR(); FX_GAPA(C1 = FX_MF(kf[9], qr[4], (f32x16){}), P0[5], P0[6], P0[7],    pw0[2] = FX_PKW(P0, 4),  pw0[3] = FX_PKW(P0, 6),  pw0); \
    FX_VRD(1); FX_SBAR(); FX_GAPA(C0 = FX_MF(kf[0], qr[0], C0),   P0[8], P0[9], P0[10],   pw1[0] = FX_PKW(P0, 8),  pw1[1] = FX_PKW(P0, 10), pw1); \
    FX_VRD(5); FX_SBAR(); FX_GAPA(C1 = FX_MF(kf[1], qr[0], C1),   P0[11], P0[12], P0[13], pw1[2] = FX_PKW(P0, 12), pw1[3] = FX_PKW(P0, 14), pw1); \
    FX_VRD(2); FX_SBAR(); FX_GAPA(C0 = FX_MF(kf[2], qr[1], C0),   P0[14], P0[15], P1[0],  pw2[0] = FX_PKW(P1, 0),  pw2[1] = FX_PKW(P1, 2),  pw2); \
    FX_VRD(6); FX_SBAR(); FX_GAPA(C1 = FX_MF(kf[3], qr[1], C1),   P1[1], P1[2], P1[3],    pw2[2] = FX_PKW(P1, 4),  pw2[3] = FX_PKW(P1, 6),  pw2); \
    FX_VRD(3); FX_SBAR(); FX_GAPA(C0 = FX_MF(kf[4], qr[2], C0),   P1[4], P1[5], P1[6],    pw3[0] = FX_PKW(P1, 8),  pw3[1] = FX_PKW(P1, 10), pw3); \
    FX_VRD(7); FX_SBAR(); FX_GAPA(C1 = FX_MF(kf[5], qr[2], C1),   P1[7], P1[8], P1[9],    pw3[2] = FX_PKW(P1, 12), pw3[3] = FX_PKW(P1, 14), pw3); \
    FX_GAPA3(C0 = FX_MF(kf[6], qr[3], C0), P1[10], P1[11], P1[12]); \
    FX_GAPA3(C1 = FX_MF(kf[7], qr[3], C1), P1[13], P1[14], P1[15]); \
    lrun += sacc; \
    FX_DMA_K((t) + 3); FX_DMA_V((t) + 2);                                  \
    if (MASK) FX_MASK(C0, C1, t); \
    { const float rm = rowmax_b(C0, C1); resc = false;                     \
      if (__builtin_expect(__any(rm > THR), 0)) { const float dl = __builtin_fmaxf(rm, 0.f); mhat += dl;        \
          _Pragma("unroll") for (int r = 0; r < 16; ++r) { C0[r] -= dl; C1[r] -= dl; } \
          FX_SETREF(); \
          const float f = fexp2(-dl); lrun *= f; if (hi == 0) wsf[r32] = f; resc = true; } } \
    FX_SBAR(); \
    const LAS unsigned char* kp_ = kp0 + (((t) + 1) & (ATT_NS - 1)) * ATT_KSLOT; \
    FX_GAPB(o[0] = FX_MF(FX_PAF(0), FX_VFR(0), o[0]), C0, 0);                              FX_GAPB(o[1] = FX_MF(FX_PAF(0), FX_VFR(4), o[1]), C0, 4); \
    FX_KLOAD2(kp_, 0); FX_SBAR(); FX_GAPB(o[0] = FX_MF(FX_PAF(1), FX_VFR(1), o[0]), C0, 8);   FX_KLOAD2(kp_, 1); FX_SBAR(); FX_GAPB(o[1] = FX_MF(FX_PAF(1), FX_VFR(5), o[1]), C0, 12); \
    FX_KLOAD2(kp_, 2); FX_SBAR(); FX_GAPB(o[0] = FX_MF(FX_PAF(2), FX_VFR(2), o[0]), C1, 0);   FX_KLOAD2(kp_, 3); FX_SBAR(); FX_GAPB(o[1] = FX_MF(FX_PAF(2), FX_VFR(6), o[1]), C1, 4); \
    FX_KLOADX(kx0 + (((t) + 1) & (ATT_NS - 1)) * ATT_KSLOT); FX_SBAR(); FX_GAPB(o[0] = FX_MF(FX_PAF(3), FX_VFR(3), o[0]), C1, 8);   FX_GAPB(o[1] = FX_MF(FX_PAF(3), FX_VFR(7), o[1]), C1, 12); \
    FX_WAIT_BAR(); \
    if (resc) { _Pragma("unroll") for (int g = 0; g < 4; ++g) { const f32x4 fv = *(const LAS f32x4*)(wsf + 8 * g + 4 * hi); \
        _Pragma("unroll") for (int k = 0; k < 4; ++k) { o[0][4 * g + k] *= fv[k]; o[1][4 * g + k] *= fv[k]; } } } \
    } while (0)
#define FX_DRAIN(P0, P1) do { float sacc = P0[0] + P0[1]; \
      _Pragma("unroll") for (int r = 2; r < 16; ++r) sacc += P0[r]; \
      _Pragma("unroll") for (int r = 0; r < 16; ++r) sacc += P1[r]; \
      lrun += sacc; \
      pw0 = (u32x4){FX_PKW(P0, 0), FX_PKW(P0, 2), FX_PKW(P0, 4), FX_PKW(P0, 6)}; pw1 = (u32x4){FX_PKW(P0, 8), FX_PKW(P0, 10), FX_PKW(P0, 12), FX_PKW(P0, 14)}; \
      pw2 = (u32x4){FX_PKW(P1, 0), FX_PKW(P1, 2), FX_PKW(P1, 4), FX_PKW(P1, 6)}; pw3 = (u32x4){FX_PKW(P1, 8), FX_PKW(P1, 10), FX_PKW(P1, 12), FX_PKW(P1, 14)}; \
      const LAS unsigned char* vp_ = vp0 + ((t_hi - 1) & (ATT_NS - 1)) * 8192; _Pragma("unroll") for (int i = 0; i < 8; ++i) FX_VRD(i); \
      o[0] = FX_MF(FX_PAF(0), FX_VFR(0), o[0]); o[1] = FX_MF(FX_PAF(0), FX_VFR(4), o[1]); o[0] = FX_MF(FX_PAF(1), FX_VFR(1), o[0]); o[1] = FX_MF(FX_PAF(1), FX_VFR(5), o[1]); \
      o[0] = FX_MF(FX_PAF(2), FX_VFR(2), o[0]); o[1] = FX_MF(FX_PAF(2), FX_VFR(6), o[1]); o[0] = FX_MF(FX_PAF(3), FX_VFR(3), o[0]); o[1] = FX_MF(FX_PAF(3), FX_VFR(7), o[1]); } while (0)
    int t = t_lo + 1; const int t_band = t_hi - 4;
    for (; t + 1 < t_band; t += 2) {
        FX_STEP(pB0, pB1, pA0, pA1, t, false);
        FX_STEP(pA0, pA1, pB0, pB1, t + 1, false);
    }
    for (; t + 1 < t_hi; t += 2) {
        FX_STEP(pB0, pB1, pA0, pA1, t, true);
        FX_STEP(pA0, pA1, pB0, pB1, t + 1, true);
    }
    if (t < t_hi) { FX_STEP(pB0, pB1, pA0, pA1, t, true); FX_DRAIN(pB0, pB1); } else FX_DRAIN(pA0, pA1);
    const float ltot = swap_add(lrun);
    if (hi == 0) wsf[32 + r32] = ltot;
    asm volatile("s_waitcnt lgkmcnt(0)" ::: "memory");
    LAS bf16_t* stg = (LAS bf16_t*)(lds + ATT_OST) + wid * 2048;
#pragma unroll
    for (int g = 0; g < 4; ++g) { const f32x4 lv = *(const LAS f32x4*)(wsf + 32 + 8 * g + 4 * hi);
#pragma unroll
        for (int k = 0; k < 4; ++k) { const int r = 4 * g + k; const float rl = frcp(lv[k]); LAS bf16_t* srow = stg + crow(r, hi) * 64 + r32;
            srow[0] = (bf16_t)(cvt_pk_bf16(o[0][r] * rl, 0.f) & 0xffffu); srow[32] = (bf16_t)(cvt_pk_bf16(o[1][r] * rl, 0.f) & 0xffffu); } }
    asm volatile("s_waitcnt lgkmcnt(0)" ::: "memory");
#pragma unroll
    for (int i = 0; i < 4; ++i) { const int row = i * 8 + (lane >> 3), ch = lane & 7; const u32x4 v = *(const LAS u32x4*)(stg + row * 64 + ch * 8); *(u32x4*)(Op + (long)(qw0 + row) * os + ch * 8) = v; }
    ATT_WAITBAR();
#undef FX_SBAR
#undef FX_SETREF
#undef FX_PIN
#undef FX_MF
#undef FX_DMA_K
#undef FX_DMA_V
#undef FX_WAIT_BAR
#undef FX_KLOAD2
#undef FX_KLOADX
#undef FX_MASK
#undef FX_PKW
#undef FX_PAF
#undef FX_VFR
#undef FX_VRD
#undef FX_GAPA
#undef FX_GAPA3
#undef FX_GAPB
#undef FX_STEP
#undef FX_DRAIN
}

template <bool ISO>
__device__ __forceinline__ void dil_sweep(LAS unsigned char* lds, LAS float* wsf_all, const bf16_t* Qp, const bf16_t* Kp, const bf16_t* Vp, const long rs, const int B0, const int NB,
                                          bf16_t* Op, const long os, float* lsep, const long ls, const long bst, const long obst, const long lbst) {
    int tid = threadIdx.x; asm volatile("" : "+v"(tid));
    const int lane = tid & 63, r32 = lane & 31, hi = lane >> 5, wid = __builtin_amdgcn_readfirstlane(tid >> 6);
    LAS float* wsf = wsf_all + wid * 64;
    const int NT = 4 * (B0 + NB), T0 = ISO ? 4 * B0 : (B0 > 0 ? 4 * B0 - 2 : 0), wh = wid >> 1;
    constexpr float THR = 30.0f;
    float mhat = 0.f, lrun = 0.f; bool started = false; f32x16 o[2]; o[0] = f32x16{}; o[1] = f32x16{};
    f32x16 negm = f32x16{};
    const bf16_t* ksrc = Kp + (long)lane * rs + wid * 8;
    const bf16_t* vsrc = Vp + (long)(16 * (wid & 3) + (lane >> 2)) * rs + (wid >> 2) * 32 + (lane & 3) * 8;
    const LAS unsigned char* vp0 = lds + ATT_VOFF + ((lane >> 4) & 1) * 32 + (lane & 3) * 8 + (4 * hi + ((lane & 15) >> 2)) * 64;
    LAS bf16_t* stg = (LAS bf16_t*)(lds + ATT_OST) + wid * 2048;
#define DS_ISSUE(tt) do { const int t_ = (tt) < NT ? (tt) : NT - 1; const int s_ = (tt) & (ATT_NS - 1); const unsigned l0_ = (unsigned)(uintptr_t)lds; \
        const long to_ = ISO ? (long)(t_ >> 2) * bst + (long)(t_ & 3) * 64 * rs : (long)t_ * 64 * rs; \
        glds16(ksrc + to_, (unsigned)__builtin_amdgcn_readfirstlane((int)(l0_ + s_ * ATT_KSLOT + wid * 1024))); \
        glds16(vsrc + to_, (unsigned)__builtin_amdgcn_readfirstlane((int)(l0_ + ATT_VOFF + s_ * 8192 + wid * 1024))); } while (0)
#define DS_QDMA(bq) do { const unsigned sb_ = (unsigned)(uintptr_t)stg; \
        _Pragma("unroll") for (int i_ = 0; i_ < 4; ++i_) glds16(Qp + (ISO ? (long)(bq) * bst : (long)256 * (bq) * rs) + (long)(32 * wid + 8 * i_ + (lane >> 3)) * rs + (lane & 7) * 8, (unsigned)__builtin_amdgcn_readfirstlane((int)(sb_ + i_ * 1024))); } while (0)
#define DS_WAITBAR(n) do { asm volatile("s_waitcnt vmcnt(" #n ") lgkmcnt(0)" ::: "memory"); __builtin_amdgcn_s_barrier(); asm volatile("" ::: "memory"); } while (0)
    DS_ISSUE(T0); DS_ISSUE(T0 + 1); DS_ISSUE(T0 + 2); DS_QDMA(B0);
    DS_WAITBAR(0);
    bf16x8 qr[4]; f32x16 p0 = f32x16{}, p1 = f32x16{};
#pragma unroll
    for (int d0 = 0; d0 < 4; ++d0) qr[d0] = bf16x8{};
    for (int t = T0; t <= NT; ++t) {
        const int u = t - 4 * B0 - wh + 2, rel = u & 3, blk = B0 + (u >> 2);
        const bool act = (u >= 0) && (rel != 3) && (blk < B0 + NB) && (!ISO || t >= 4 * blk);
        if (rel == 0) DS_WAITBAR(2); else DS_WAITBAR(4);
        if (rel == 3 && u > 0 && blk < B0 + NB) {
            const int qw0 = (ISO ? 0 : 256 * blk) + 32 * wid, qi = qw0 + r32;
            bf16_t* Ob_ = Op + (ISO ? (long)blk * obst : 0L); float* lb_ = lsep + (ISO ? (long)blk * lbst : 0L);
            const float ltot = swap_add(lrun);
            if (hi == 0) { wsf[32 + r32] = ltot; lb_[(long)qi * ls] = mhat + __builtin_amdgcn_logf(ltot); }
            asm volatile("s_waitcnt lgkmcnt(0)" ::: "memory");
#pragma unroll
            for (int g = 0; g < 4; ++g) { const f32x4 lv = *(const LAS f32x4*)(wsf + 32 + 8 * g + 4 * hi);
#pragma unroll
                for (int k = 0; k < 4; ++k) { const int r = 4 * g + k; const float rl = frcp(lv[k]); LAS bf16_t* srow = stg + crow(r, hi) * 64 + r32;
                    srow[0] = (bf16_t)(cvt_pk_bf16(o[0][r] * rl, 0.f) & 0xffffu); srow[32] = (bf16_t)(cvt_pk_bf16(o[1][r] * rl, 0.f) & 0xffffu); } }
            asm volatile("s_waitcnt lgkmcnt(0)" ::: "memory");
#pragma unroll
            for (int i = 0; i < 4; ++i) { const int row = i * 8 + (lane >> 3), ch = lane & 7; const u32x4 v = *(const LAS u32x4*)(stg + row * 64 + ch * 8); *(u32x4*)(Ob_ + (long)(qw0 + row) * os + ch * 8) = v; }
            if (blk + 1 < B0 + NB) DS_QDMA(blk + 1);
        }
        DS_ISSUE(t + 3);
        if (act) {
            const int qw0 = (ISO ? 0 : 256 * blk) + 32 * wid, qi = qw0 + r32, tk = ISO ? t - 4 * blk : t;
            if (ISO ? (t == 4 * blk + (wh > 2 ? wh - 2 : 0)) : (rel == 0 || t == 0)) {
#pragma unroll
                for (int d0 = 0; d0 < 4; ++d0) qr[d0] = *(const LAS bf16x8*)((const LAS unsigned char*)stg + r32 * 128 + d0 * 32 + hi * 16);
                asm volatile("s_waitcnt lgkmcnt(0)" : "+v"(qr[0]), "+v"(qr[1]), "+v"(qr[2]), "+v"(qr[3]) :: "memory");
                o[0] = f32x16{}; o[1] = f32x16{}; negm = f32x16{}; mhat = 0.f; lrun = 0.f; started = false;
            }
            { const LAS unsigned char* Ks_ = lds + (t & (ATT_NS - 1)) * ATT_KSLOT; const LAS unsigned char* kb_ = Ks_ + hi * 1024 + r32 * 16; bf16x8 kf[8];
#pragma unroll
              for (int d0_ = 0; d0_ < 4; ++d0_) { kf[2 * d0_] = *(const LAS bf16x8*)(kb_ + d0_ * 2048); kf[2 * d0_ + 1] = *(const LAS bf16x8*)(kb_ + d0_ * 2048 + 512); }
              asm volatile("s_waitcnt lgkmcnt(0)" : "+v"(kf[0]), "+v"(kf[1]), "+v"(kf[2]), "+v"(kf[3]), "+v"(kf[4]), "+v"(kf[5]), "+v"(kf[6]), "+v"(kf[7]) :: "memory");
              p0 = __builtin_amdgcn_mfma_f32_32x32x16_bf16(kf[0], qr[0], negm, 0, 0, 0);
              p1 = __builtin_amdgcn_mfma_f32_32x32x16_bf16(kf[1], qr[0], negm, 0, 0, 0);
#pragma unroll
              for (int d0_ = 1; d0_ < 4; ++d0_) {
                  p0 = __builtin_amdgcn_mfma_f32_32x32x16_bf16(kf[2 * d0_], qr[d0_], p0, 0, 0, 0);
                  p1 = __builtin_amdgcn_mfma_f32_32x32x16_bf16(kf[2 * d0_ + 1], qr[d0_], p1, 0, 0, 0); }
              asm volatile("s_nop 15\n\ts_nop 7" : "+v"(p0), "+v"(p1)); }
            s16x4 vlo[8], vhi[8];
            { const LAS unsigned char* vp_ = vp0 + (t & (ATT_NS - 1)) * 8192;
#pragma unroll
              for (int i = 0; i < 8; ++i) { vlo[i] = vtr(vp_ + ((i >> 2) * 4096 + (i & 3) * 1024)); vhi[i] = vtr(vp_ + ((i >> 2) * 4096 + (i & 3) * 1024 + 512)); } }
            __builtin_amdgcn_sched_barrier(0);
            if (64 * tk + 63 > qw0 || 64 * tk < qw0 + 31 - 128) { const int kvb = 64 * tk + 4 * hi;
#pragma unroll
                for (int r = 0; r < 16; ++r) { const int dd = qi - (kvb + (r & 3) + 8 * (r >> 2)); if (dd < 0 || dd > 128) p0[r] = -INFINITY; if (dd - 32 < 0 || dd - 32 > 128) p1[r] = -INFINITY; }
            }
            const float rm = rowmax_fast(p0, p1);
            const bool need = started ? (rm > THR) : (rm > -1.0e30f);
            bool resc = false;
            if (__any(need)) {
                const float dl = need ? rm : 0.f; mhat += dl;
#pragma unroll
                for (int r = 0; r < 16; ++r) { p0[r] -= dl; p1[r] -= dl; }
#pragma unroll
                for (int r = 0; r < 16; ++r) negm[r] = -mhat;
                const float f = (need && started) ? fexp2(-dl) : 1.0f; lrun *= f; started = started || need;
                if (hi == 0) wsf[r32] = f; resc = true;
            }
#pragma unroll
            for (int r = 0; r < 16; ++r) { p0[r] = fexp2(p0[r]); p1[r] = fexp2(p1[r]); }
            if (resc) {
                asm volatile("s_waitcnt lgkmcnt(0)" ::: "memory");
#pragma unroll
                for (int g = 0; g < 4; ++g) { const f32x4 fv = *(const LAS f32x4*)(wsf + 8 * g + 4 * hi);
#pragma unroll
                    for (int k = 0; k < 4; ++k) { o[0][4 * g + k] *= fv[k]; o[1][4 * g + k] *= fv[k]; } }
            }
            u32x4 pw0, pw1, pw2, pw3;
            pw0 = (u32x4){cvt_pk_bf16(p0[0], p0[1]), cvt_pk_bf16(p0[2], p0[3]), cvt_pk_bf16(p0[4], p0[5]), cvt_pk_bf16(p0[6], p0[7])};
            pw1 = (u32x4){cvt_pk_bf16(p0[8], p0[9]), cvt_pk_bf16(p0[10], p0[11]), cvt_pk_bf16(p0[12], p0[13]), cvt_pk_bf16(p0[14], p0[15])};
            pw2 = (u32x4){cvt_pk_bf16(p1[0], p1[1]), cvt_pk_bf16(p1[2], p1[3]), cvt_pk_bf16(p1[4], p1[5]), cvt_pk_bf16(p1[6], p1[7])};
            pw3 = (u32x4){cvt_pk_bf16(p1[8], p1[9]), cvt_pk_bf16(p1[10], p1[11]), cvt_pk_bf16(p1[12], p1[13]), cvt_pk_bf16(p1[14], p1[15])};
#define DS_VF(i) (bf16x8){vlo[i][0], vlo[i][1], vlo[i][2], vlo[i][3], vhi[i][0], vhi[i][1], vhi[i][2], vhi[i][3]}
#define DS_GP(d, PW, i, P, r0) do { o[d] = __builtin_amdgcn_mfma_f32_32x32x16_bf16(__builtin_bit_cast(bf16x8, PW), DS_VF(i), o[d], 0, 0, 0); \
        ps += P[r0]; ps += P[(r0) + 1]; ps += P[(r0) + 2]; ps += P[(r0) + 3]; asm volatile("" : "+v"(ps)); __builtin_amdgcn_sched_barrier(0); } while (0)
            { float ps = 0.f; __builtin_amdgcn_sched_barrier(0);
              DS_GP(0, pw0, 0, p0, 0); DS_GP(1, pw0, 4, p0, 4); DS_GP(0, pw1, 1, p0, 8); DS_GP(1, pw1, 5, p0, 12);
              DS_GP(0, pw2, 2, p1, 0); DS_GP(1, pw2, 6, p1, 4); DS_GP(0, pw3, 3, p1, 8); DS_GP(1, pw3, 7, p1, 12);
              lrun += ps; }
#undef DS_VF
#undef DS_GP
        }
    }
    ATT_WAITBAR();
#undef DS_ISSUE
#undef DS_QDMA
#undef DS_WAITBAR
}

__device__ __forceinline__ void xattn_unit(LAS unsigned char* lds, LAS float* wsf_all, const bf16_t* Qp, const bf16_t* Kp, const bf16_t* Vp, bf16_t* Op) {
    int tid = threadIdx.x; asm volatile("" : "+v"(tid));
    const int lane = tid & 63, r32 = lane & 31, hi = lane >> 5, wid = __builtin_amdgcn_readfirstlane(tid >> 6);
    LAS float* wsf = wsf_all + wid * 64;
    const int qi = wid * 32 + r32;
#define XA_ISSUE(s_) do { const unsigned sl_ = (unsigned)(uintptr_t)lds + ((s_) & 3) * 32768; \
        if ((s_) < 4) { _Pragma("unroll") for (int i_ = 0; i_ < 4; ++i_) { const int c_ = wid + 8 * i_; \
            glds16(Kp + (long)((s_) * 64 + lane) * D + c_ * 8, (unsigned)__builtin_amdgcn_readfirstlane((int)(sl_ + c_ * 1024))); } } \
        else { _Pragma("unroll") for (int i_ = 0; i_ < 4; ++i_) { const int pi_ = wid + 8 * i_, db_ = pi_ >> 2, kg_ = pi_ & 3; \
            glds16(Vp + (long)(((s_) - 4) * 64 + 16 * kg_ + (lane >> 2)) * D + db_ * 32 + (lane & 3) * 8, (unsigned)__builtin_amdgcn_readfirstlane((int)(sl_ + pi_ * 1024))); } } } while (0)
#define XA_WAITBAR(n) do { asm volatile("s_waitcnt vmcnt(" #n ") lgkmcnt(0)" ::: "memory"); __builtin_amdgcn_s_barrier(); asm volatile("" ::: "memory"); } while (0)
    XA_ISSUE(0);
    bf16x8 qr[16];
#pragma unroll
    for (int d0 = 0; d0 < 16; ++d0) qr[d0] = *(const bf16x8*)(Qp + (long)qi * D + d0 * 16 + hi * 8);
    asm volatile("s_waitcnt vmcnt(0)" : "+v"(qr[0]), "+v"(qr[1]), "+v"(qr[2]), "+v"(qr[3]), "+v"(qr[4]), "+v"(qr[5]), "+v"(qr[6]), "+v"(qr[7]),
                 "+v"(qr[8]), "+v"(qr[9]), "+v"(qr[10]), "+v"(qr[11]), "+v"(qr[12]), "+v"(qr[13]), "+v"(qr[14]), "+v"(qr[15]) :: "memory");
    XA_ISSUE(1); XA_ISSUE(2); XA_ISSUE(3);
    __builtin_amdgcn_s_barrier(); asm volatile("" ::: "memory");
    f32x16 p[4][2];
#pragma unroll
    for (int s = 0; s < 4; ++s) {
        if (s > 0) { XA_WAITBAR(8);
                     XA_ISSUE(s + 3); }
        p[s][0] = f32x16{}; p[s][1] = f32x16{};
        qkt<16>(p[s][0], p[s][1], lds + (s & 3) * 32768, qr, r32, hi);
    }
    float a = NEG;
#pragma unroll
    for (int s = 0; s < 4; ++s)
#pragma unroll
        for (int r = 0; r < 16; ++r) a = fmaxf(a, fmaxf(p[s][0][r], p[s][1][r]));
    const float mx = swap_max(a);
    float ps = 0.f; u32x4 pw[4][4];
#pragma unroll
    for (int s = 0; s < 4; ++s) {
#pragma unroll
        for (int r = 0; r < 16; ++r) { p[s][0][r] = fexp2(p[s][0][r] - mx); p[s][1][r] = fexp2(p[s][1][r] - mx); ps += p[s][0][r] + p[s][1][r]; }
#pragma unroll
        for (int h2 = 0; h2 < 2; ++h2) {
            pw[s][2 * h2] = (u32x4){cvt_pk_bf16(p[s][h2][0], p[s][h2][1]), cvt_pk_bf16(p[s][h2][2], p[s][h2][3]), cvt_pk_bf16(p[s][h2][4], p[s][h2][5]), cvt_pk_bf16(p[s][h2][6], p[s][h2][7])};
            pw[s][2 * h2 + 1] = (u32x4){cvt_pk_bf16(p[s][h2][8], p[s][h2][9]), cvt_pk_bf16(p[s][h2][10], p[s][h2][11]), cvt_pk_bf16(p[s][h2][12], p[s][h2][13]), cvt_pk_bf16(p[s][h2][14], p[s][h2][15])}; }
    }
    const float ltot = swap_add(ps);
    f32x16 o[8];
#pragma unroll
    for (int d0 = 0; d0 < 8; ++d0) o[d0] = f32x16{};
    const unsigned vb0 = (unsigned)(uintptr_t)lds + ((lane >> 4) & 1) * 32 + (lane & 3) * 8 + (4 * hi + ((lane & 15) >> 2)) * 64;
#pragma unroll
    for (int s = 4; s < 8; ++s) {
        if (s < 6) XA_WAITBAR(8); else if (s == 6) XA_WAITBAR(4); else XA_WAITBAR(0);
        if (s == 4) XA_ISSUE(7);
        pv<8>(o, vb0 + (s & 3) * 32768, __builtin_bit_cast(bf16x8, pw[s - 4][0]), __builtin_bit_cast(bf16x8, pw[s - 4][1]), __builtin_bit_cast(bf16x8, pw[s - 4][2]), __builtin_bit_cast(bf16x8, pw[s - 4][3]));
    }
#undef XA_ISSUE
    if (hi == 0) wsf[32 + r32] = ltot;
    XA_WAITBAR(0);
#undef XA_WAITBAR
    LAS bf16_t* stg = (LAS bf16_t*)(lds + wid * 16384);
#pragma unroll
    for (int g = 0; g < 4; ++g) { const f32x4 lv = *(const LAS f32x4*)(wsf + 32 + 8 * g + 4 * hi);
#pragma unroll
        for (int k = 0; k < 4; ++k) { const int r = 4 * g + k; const float rl = frcp(lv[k]); LAS bf16_t* srow = stg + crow(r, hi) * 256 + r32;
#pragma unroll
            for (int d0 = 0; d0 < 8; ++d0) srow[d0 * 32] = (bf16_t)(cvt_pk_bf16(o[d0][r] * rl, 0.f) & 0xffffu); } }
    asm volatile("s_waitcnt lgkmcnt(0)" ::: "memory");
#pragma unroll
    for (int i = 0; i < 16; ++i) { const int row = i * 2 + (lane >> 5), ch = lane & 31; const u32x4 v = *(const LAS u32x4*)(stg + row * 256 + ch * 8); *(u32x4*)(Op + (long)(wid * 32 + row) * D + ch * 8) = v; }
    ATT_WAITBAR();
}
}

constexpr size_t MiB = 1u << 20;
constexpr size_t WS_CTL = 0, CTL_ZERO_BYTES = 1 * MiB;
constexpr size_t WS_ROPE = 1 * MiB;
constexpr size_t WS_FLOG = 3 * MiB;
constexpr size_t WS_CL = 4 * MiB;
constexpr size_t WS_LSE = 5 * MiB;
constexpr size_t WS_TOKE = 8 * MiB;
constexpr size_t WS_TOKW = WS_TOKE + 256 * 1024;
constexpr size_t WS_TOKP = WS_TOKW + 256 * 1024;
constexpr size_t WS_SLOC = 9 * MiB;
constexpr size_t WS_POW = 25 * MiB;
constexpr size_t WS_BBAR = 28 * MiB;
constexpr size_t WS_KMAT = 29 * MiB;
constexpr size_t WS_ONES = 33 * MiB, WS_ZEROS = 33 * MiB + 4096, WS_STATS = 33 * MiB + 65536;
constexpr size_t WS_XB = 34 * MiB;
constexpr size_t WS_WL = 98 * MiB;
constexpr size_t WL_WIN = 0, WL_WGLU = 13 * MiB, WL_WB = WL_WGLU + MiB / 2, WL_WOUT = WL_WB + 3 * MiB, WL_XQ = WL_WOUT + 2 * MiB, WL_XO = WL_XQ + 2 * MiB, WL_TF = WL_XO + 2 * MiB, WL_E = WL_TF + 20 * MiB;
constexpr size_t WS_FFNW = 148 * MiB;
constexpr size_t WS_UG = 214 * MiB;
constexpr size_t WS_QKV = 254 * MiB;
constexpr size_t WS_YS = 446 * MiB;
constexpr size_t WS_KBIAS = 606 * MiB;
constexpr size_t WS_ZH = 610 * MiB;
constexpr size_t WS_END = 674 * MiB;
static_assert(WL_E + 4 * MiB + MiB / 4 <= 50 * MiB, "WL map");
constexpr int CW_TMO = 0, CW_BAR = 4096, CW_CNT = 16384, CW_FILL = 16384 + 2048, CW_QUEUE = 16384 + 4096, CW_NORM = 32768;
constexpr int RING_BYTES = 131072, MISC_OFF = RING_BYTES, WSF_OFF = RING_BYTES + 512, LDS_BYTES = 147456;
constexpr int NWAVES = 8, PTR_OFF = RING_BYTES + 3072;
__device__ __forceinline__ const void* inptr(LAS unsigned char* lds, int k) { const unsigned long long v = ((volatile LAS unsigned long long*)(lds + PTR_OFF))[k];
    const unsigned lo = (unsigned)__builtin_amdgcn_readfirstlane((int)(unsigned)v), hi = (unsigned)__builtin_amdgcn_readfirstlane((int)(unsigned)(v >> 32)); return (const void*)(GAS const void*)(((unsigned long long)hi << 32) | lo); }

typedef GAS unsigned gu32;
#define RLX_AGENT __ATOMIC_RELAXED, __HIP_MEMORY_SCOPE_AGENT

#define XB_TMO      128
#define XB_XCNT(j)  (256  + 64 * (j))
#define XB_XSUB(j)  (1280 + 64 * (j))
#define XB_XGEN(j)  (2304 + 64 * (j))
#define XB_TOP      3328
#define XB_TOPGEN   3392
#define XCD_BAR_WORDS 3456
#define XB_SPIN_CAP (1u << 22)
__device__ __forceinline__ unsigned xb_ld(unsigned* p)              { return __hip_atomic_load(p, __ATOMIC_RELAXED, __HIP_MEMORY_SCOPE_AGENT); }
__device__ __forceinline__ unsigned xb_add(unsigned* p, unsigned v) { return __hip_atomic_fetch_add(p, v, __ATOMIC_RELAXED, __HIP_MEMORY_SCOPE_AGENT); }
__device__ __forceinline__ unsigned xb_xcc_id() { return (unsigned)__builtin_amdgcn_s_getreg((3 << 11) | 20) & 0xFu; }
#define XB_SPIN(cond, bar) do { unsigned _sp = 0; while (cond) { __builtin_amdgcn_s_sleep(1); \
    if ((++_sp & 255u) == 0u) { if (xb_ld(&(bar)[XB_TMO])) break; if (_sp > XB_SPIN_CAP) { atomicAdd(&(bar)[XB_TMO], 1u); break; } } } } while (0)
struct XcdBarrier { unsigned* bar; unsigned x; volatile LAS unsigned* st; };
__device__ __forceinline__ XcdBarrier xcd_barrier_post(unsigned* bar, volatile LAS unsigned* st) {
    XcdBarrier b; b.bar = bar; b.x = xb_xcc_id(); b.st = st;
    if (threadIdx.x == 0) (void)xb_add(&bar[XB_XCNT(b.x)], 1u);
    return b;
}
__device__ __forceinline__ void xcd_barrier_complete(unsigned* bar, unsigned x, unsigned& nloc, unsigned& nx) {
    const unsigned G = gridDim.x * gridDim.y * gridDim.z;
    unsigned sum, cnt, mine, sp = 0u;
    for (;;) {
        sum = 0u; cnt = 0u; mine = 0u;
#pragma unroll
        for (unsigned j = 0; j < 16; ++j) { const unsigned c = xb_ld(&bar[XB_XCNT(j)]); sum += c; cnt += (c > 0u) ? 1u : 0u; mine = (j == x) ? c : mine; }
        if (sum == G) break;
        __builtin_amdgcn_s_sleep(1);
        if ((++sp & 255u) == 0u) { if (xb_ld(&bar[XB_TMO])) break; if (sp > XB_SPIN_CAP) { atomicAdd(&bar[XB_TMO], 1u); break; } }
    }
    nloc = mine > 0u ? mine : 1u; nx = cnt > 0u ? cnt : 1u;
}
__device__ __forceinline__ void xcd_barrier(const XcdBarrier& b) {
    asm volatile("s_waitcnt vmcnt(0)" ::: "memory");
    __syncthreads();
    if (threadIdx.x == 0) {
        unsigned* bar = b.bar;
        __builtin_amdgcn_s_waitcnt(0);
        unsigned nloc = b.st[0], nx = b.st[1];
        if (nloc == 0u) { xcd_barrier_complete(bar, b.x, nloc, nx); b.st[0] = nloc; b.st[1] = nx; }
        const unsigned old = xb_add(&bar[XB_XSUB(b.x)], 1u);
        const unsigned gen = old / nloc;
        if (old + 1u == (gen + 1u) * nloc) {
            __builtin_amdgcn_fence(__ATOMIC_RELEASE, "agent");
            asm volatile("s_waitcnt vmcnt(0)" ::: "memory");
            const unsigned og = xb_add(&bar[XB_TOP], 1u);
            const unsigned tg = og / nx;
            if (og + 1u == (tg + 1u) * nx) xb_add(&bar[XB_TOPGEN], 1u);
            else XB_SPIN(xb_ld(&bar[XB_TOPGEN]) == tg, bar);
            __builtin_amdgcn_fence(__ATOMIC_ACQUIRE, "agent");
            xb_add(&bar[XB_XGEN(b.x)], 1u);
            asm volatile("s_waitcnt vmcnt(0)" ::: "memory");
        } else {
            XB_SPIN(xb_ld(&bar[XB_XGEN(b.x)]) == gen, bar);
            __builtin_amdgcn_fence(__ATOMIC_ACQUIRE, "agent");
            asm volatile("s_waitcnt vmcnt(0)" ::: "memory");
        }
    }
    __syncthreads();
}

__device__ __forceinline__ void conv_mat(int& rot, int gw, int NGW, LAS float* scr, int lane, const float* W, int K, int ldn, int nblk, int mode, bf16_t* WT, int dstrow0) {
    asm volatile("" : "+v"(lane));
    const int nitems = (K / 64) * nblk;
    int it = gw - rot; if (it < 0) it += NGW;
    rot += nitems % NGW; if (rot >= NGW) rot -= NGW;
    const int kr = lane >> 3, n4 = (lane & 7) * 4;
    f32x4 v[8];
#define CM_COL(it_) ((mode == 1 && 32 * ((it_) % nblk) >= 3584) ? 32 * ((it_) % nblk) + 8 : 32 * ((it_) % nblk))
    if (it < nitems) { const float* sp = W + (size_t)(64 * (it / nblk) + kr) * ldn + CM_COL(it) + n4;
#pragma unroll
        for (int i = 0; i < 8; ++i) v[i] = *(const f32x4*)(sp + (size_t)(8 * i) * ldn); }
    while (it < nitems) {
        const int kb = it / nblk, n0 = 32 * (it % nblk), k0 = 64 * kb;
        const int drow = (mode == 2) ? dstrow0 + 256 * (n0 >> 7) + (n0 & 127) : dstrow0 + n0;
#pragma unroll
        for (int i = 0; i < 8; ++i)
#pragma unroll
            for (int q = 0; q < 4; ++q) scr[(8 * i + kr) * 33 + n4 + q] = v[i][q];
        const int nx = it + NGW;
        if (nx < nitems) { const float* sp = W + (size_t)(64 * (nx / nblk) + kr) * ldn + CM_COL(nx) + n4;
#pragma unroll
            for (int i = 0; i < 8; ++i) v[i] = *(const f32x4*)(sp + (size_t)(8 * i) * ldn); }
        asm volatile("" ::: "memory");
        const int c = lane & 7;
#pragma unroll
        for (int j = 0; j < 4; ++j) { const int n = (lane >> 3) + 8 * j; const LAS float* sl = scr + (8 * c) * 33 + n;
            u32x4 o; o.x = cvt_pk_bf16(sl[0 * 33], sl[1 * 33]); o.y = cvt_pk_bf16(sl[2 * 33], sl[3 * 33]); o.z = cvt_pk_bf16(sl[4 * 33], sl[5 * 33]); o.w = cvt_pk_bf16(sl[6 * 33], sl[7 * 33]);
            *(u32x4*)(WT + (size_t)(drow + n) * K + k0 + 8 * c) = o; }
        asm volatile("s_waitcnt lgkmcnt(0)" ::: "memory");
        it = nx;
    }
#undef CM_COL
}
__device__ __forceinline__ void dsincos(double x, double& s, double& c) {
    const double q = __builtin_rint(x * 0.63661977236758134308);
    const double r = (x - q * 1.57079632679489655800) - q * 6.12323399573676603587e-17;
    const double r2 = r * r;
    double sp = 1.0 / 6227020800.0; sp = sp * r2 - 1.0 / 39916800.0; sp = sp * r2 + 1.0 / 362880.0; sp = sp * r2 - 1.0 / 5040.0; sp = sp * r2 + 1.0 / 120.0; sp = sp * r2 - 1.0 / 6.0; sp = sp * r2 + 1.0; sp = sp * r;
    double cp = -1.0 / 87178291200.0; cp = cp * r2 + 1.0 / 479001600.0; cp = cp * r2 - 1.0 / 3628800.0; cp = cp * r2 + 1.0 / 40320.0; cp = cp * r2 - 1.0 / 720.0; cp = cp * r2 + 1.0 / 24.0; cp = cp * r2 - 0.5; cp = cp * r2 + 1.0;
    const int qi = (int)((long long)q & 3);
    s = (qi == 0) ? sp : (qi == 1) ? cp : (qi == 2) ? -sp : -cp;
    c = (qi == 0) ? cp : (qi == 1) ? -sp : (qi == 2) ? -cp : sp;
}

template <int SRC, bool ROUTER, bool FLOG, bool WF32>
__device__ __forceinline__ void ln_pass(int gw, int NGW, int lane, unsigned short* ZH, float* OUT32, const float* xin, bf16_t* XB, float* ST, const float* gam, const float* bet, const float* gp, const float* bp,
                                        const bf16_t* Y2, const int* TOKP, const float* TOKW_in,
                                        const float* wrt, int wrt_ld, const float* brt, int* TOKE, float* TOKW, LAS unsigned* hist, float* FLOGo) {
    f32x4 g4[4], b4[4];
    if (SRC != 2) {
#pragma unroll
        for (int j = 0; j < 4; ++j) { g4[j] = *(const f32x4*)(gam + 4 * lane + 256 * j); b4[j] = *(const f32x4*)(bet + 4 * lane + 256 * j); }
    }
    f32x4 wq[16][2];
    if (ROUTER || FLOG) {
#pragma unroll
        for (int j = 0; j < 4; ++j)
#pragma unroll
            for (int k = 0; k < 4; ++k) { const float* wp = wrt + (size_t)(4 * lane + 256 * j + k) * wrt_ld; wq[4 * j + k][0] = *(const f32x4*)wp; wq[4 * j + k][1] = *(const f32x4*)(wp + 4); }
    }
    f32x4 xN[4]; u32x2 hN[4]; f32x2 stN; int p0N, p1N; float w0N, w1N; u32x2 yaC[4], ybC[4];
#define LN_LOAD1(r_) do { if (SRC == 2) { _Pragma("unroll") for (int j = 0; j < 4; ++j) xN[j] = *(const f32x4*)(xin + (size_t)(r_) * D + 4 * lane + 256 * j); } \
        else { _Pragma("unroll") for (int j = 0; j < 4; ++j) hN[j] = *(const u32x2*)(ZH + (size_t)(r_) * D + 4 * lane + 256 * j); \
            if (SRC == 1) { stN = *(const f32x2*)(ST + (size_t)(r_) * 2); p0N = TOKP[2 * (r_)]; p1N = TOKP[2 * (r_) + 1]; w0N = TOKW_in[2 * (r_)]; w1N = TOKW_in[2 * (r_) + 1]; } } } while (0)
#define LN_LOAD2() do { if (SRC == 1) { _Pragma("unroll") for (int j = 0; j < 4; ++j) { yaC[j] = *(const u32x2*)(Y2 + (size_t)p0N * D + 4 * lane + 256 * j); ybC[j] = *(const u32x2*)(Y2 + (size_t)p1N * D + 4 * lane + 256 * j); } } } while (0)
    LN_LOAD1(gw); LN_LOAD2();
    for (int row = gw; row < T; row += NGW) {
        f32x4 v[4]; u32x2 hC[4]; f32x2 stp; float w0, w1; u32x2 ya[4], yb[4];
        if (SRC == 1) { stp = stN; w0 = w0N; w1 = w1N; }
#pragma unroll
        for (int j = 0; j < 4; ++j) { if (SRC == 2) v[j] = xN[j]; else hC[j] = hN[j]; if (SRC == 1) { ya[j] = yaC[j]; yb[j] = ybC[j]; } }
        const int nrow = row + NGW < T ? row + NGW : row;
        LN_LOAD1(nrow);
        if (SRC == 2) {
            if (lane == 0) *(f32x2*)(ST + (size_t)row * 2) = (f32x2){0.f, 1.f};
        } else {
#pragma unroll
            for (int j = 0; j < 4; ++j) { const u32x2 hz = hC[j]; const f32x2 h0 = unpk_f16(hz.x), h1 = unpk_f16(hz.y); v[j] = (f32x4){h0.x, h0.y, h1.x, h1.y}; }
            if (SRC == 1) {
#pragma unroll
                for (int j = 0; j < 4; ++j) { const u32x2 a = ya[j], b = yb[j];
                    const f32x4 gq = *(const f32x4*)(gp + 4 * lane + 256 * j), bq = *(const f32x4*)(bp + 4 * lane + 256 * j);
                    const f32x4 xp = ((v[j] - stp.x) * stp.y) * gq + bq;
                    v[j] = xp * ALPHA + (f32x4){bf_lo(a.x), bf_hi(a.x), bf_lo(a.y), bf_hi(a.y)} * w0 + (f32x4){bf_lo(b.x), bf_hi(b.x), bf_lo(b.y), bf_hi(b.y)} * w1;
                    if (!WF32) { u32x2 hz; hz.x = cvt_pk_f16(v[j][0], v[j][1]); hz.y = cvt_pk_f16(v[j][2], v[j][3]); *(u32x2*)(ZH + (size_t)row * D + 4 * lane + 256 * j) = hz;
                        const f32x2 h0 = unpk_f16(hz.x), h1 = unpk_f16(hz.y); v[j] = (f32x4){h0.x, h0.y, h1.x, h1.y}; } }
            }
            float s = 0.f;
#pragma unroll
            for (int j = 0; j < 4; ++j) s += (v[j][0] + v[j][1]) + (v[j][2] + v[j][3]);
            const float mean = wave_sum(s) * (1.f / D); float s2 = 0.f;
#pragma unroll
            for (int j = 0; j < 4; ++j) { v[j] = v[j] - mean; s2 += (v[j][0] * v[j][0] + v[j][1] * v[j][1]) + (v[j][2] * v[j][2] + v[j][3] * v[j][3]); }
            const float rstd = 1.f / sqrtf(wave_sum(s2) * (1.f / D) + LN_EPS);
            if (!WF32 && lane == 0) *(f32x2*)(ST + (size_t)row * 2) = (f32x2){mean, rstd};
#pragma unroll
            for (int j = 0; j < 4; ++j) v[j] = v[j] * rstd * g4[j] + b4[j];
        }
        LN_LOAD2();
#pragma unroll
        for (int j = 0; j < 4; ++j) { if (WF32) *(f32x4*)(OUT32 + (size_t)row * D + 4 * lane + 256 * j) = v[j];
            u32x2 o; o.x = cvt_pk_bf16(v[j][0], v[j][1]); o.y = cvt_pk_bf16(v[j][2], v[j][3]); *(u32x2*)(XB + (size_t)row * D + 4 * lane + 256 * j) = o; }
        if (ROUTER || FLOG) {
            f32x4 a0 = (f32x4){0.f, 0.f, 0.f, 0.f}, a1 = a0;
#pragma unroll
            for (int j = 0; j < 4; ++j)
#pragma unroll
                for (int k = 0; k < 4; ++k) { a0 += wq[4 * j + k][0] * v[j][k]; a1 += wq[4 * j + k][1] * v[j][k]; }
            float lg[8];
#pragma unroll
            for (int k = 0; k < 4; ++k) { lg[k] = wave_sum(a0[k]); lg[4 + k] = wave_sum(a1[k]); }
            if (FLOG) { if (lane == 0) { *(f32x4*)(FLOGo + (size_t)row * 8) = (f32x4){lg[0], lg[1], lg[2], lg[3]}; *(f32x4*)(FLOGo + (size_t)row * 8 + 4) = (f32x4){lg[4], lg[5], lg[6], lg[7]}; } }
            if (ROUTER) {
#pragma unroll
                for (int k = 0; k < 8; ++k) lg[k] += brt[k];
                int i1 = 0; float v1 = lg[0];
#pragma unroll
                for (int k = 1; k < 8; ++k) if (lg[k] > v1) { v1 = lg[k]; i1 = k; }
                int i2 = -1; float v2 = -3.0e38f;
#pragma unroll
                for (int k = 0; k < 8; ++k) if (k != i1 && lg[k] > v2) { v2 = lg[k]; i2 = k; }
                const float w2 = 1.0f / (1.0f + expf(v1 - v2)), w1 = 1.0f - w2;
                if (lane == 0) { TOKE[2 * row] = i1; TOKE[2 * row + 1] = i2; TOKW[2 * row] = w1; TOKW[2 * row + 1] = w2;
                    __hip_atomic_fetch_add(hist + i1, 1u, __ATOMIC_RELAXED, __HIP_MEMORY_SCOPE_WORKGROUP); __hip_atomic_fetch_add(hist + i2, 1u, __ATOMIC_RELAXED, __HIP_MEMORY_SCOPE_WORKGROUP); }
            }
        }
    }
#undef LN_LOAD1
#undef LN_LOAD2
}

struct Args { const void* in[34]; float* out; unsigned char* ws; int ph_lo, ph_hi; };
constexpr int NPH_TOTAL = 2 + 2 * 13 + 2 * 14;

__global__ void __launch_bounds__(NWAVES * 64, 2) hybrid_fwd(Args args) {
    extern __shared__ __attribute__((aligned(16))) unsigned char lds_raw[];
    LAS unsigned char* lds = (LAS unsigned char*)lds_raw;
    volatile LAS unsigned* MISC = (volatile LAS unsigned*)(lds + MISC_OFF);
    LAS unsigned* hist = (LAS unsigned*)(lds + MISC_OFF + 64);
    LAS float* wsf_all = (LAS float*)(lds + WSF_OFF);
    const int G = gridDim.x; const int bx = blockIdx.x; const int vcu = (G % 8 == 0) ? (bx % 8) * (G / 8) + bx / 8 : bx;
    const int NGW = G * NWAVES, NGT = G * NWAVES * 64;
    unsigned char* ws = args.ws;
    unsigned* ctl = (unsigned*)(ws + WS_CTL);
    for (int u = threadIdx.x; u < (LDS_BYTES - MISC_OFF) / 4; u += NWAVES * 64) ((LAS unsigned*)(lds + MISC_OFF))[u] = 0u;
    __syncthreads();
    const int lo = args.ph_lo, hi = args.ph_hi;
    XcdBarrier bar; bar.bar = ctl + CW_BAR; bar.x = 0; bar.st = nullptr;
    if (hi - lo > 1) bar = xcd_barrier_post(ctl + CW_BAR, MISC + 8);
    int pid = 0;
#define PH_BEGIN if (pid >= lo && pid < hi) { int tid = threadIdx.x; asm volatile("" : "+v"(tid)); const int lane = tid & 63, wave = __builtin_amdgcn_readfirstlane(tid >> 6); \
        const int gw = vcu * NWAVES + wave, gt = vcu * (NWAVES * 64) + tid; LAS float* scr = (LAS float*)(lds + wave * 16384); int rot = 0; (void)rot; unsigned long long wsl_ = (unsigned long long)(uintptr_t)ws; asm volatile("" : "+s"(wsl_)); unsigned char* wsl = (unsigned char*)(GAS unsigned char*)wsl_; (void)lane; (void)gw; (void)gt; (void)scr;
#define PH_END } if (pid >= lo && pid + 1 < hi) xcd_barrier(bar); ++pid;
#define LOAD_TOFF() int toff[9]; { int acc_t = 0; _Pragma("unroll") for (int e = 0; e < 8; ++e) { toff[e] = acc_t; \
        const unsigned c = (unsigned)__builtin_amdgcn_readfirstlane((int)__hip_atomic_load(ctl + CW_CNT + (li2 * 8 + e) * 64, RLX_AGENT)); acc_t += (int)((c + 255u) >> 8); } toff[8] = acc_t; }
#define CONVERT_MIXER(LL) do { const int LL_ = (LL); \
            conv_mat(rot, gw, NGW, scr, lane, w_in + (size_t)LL_ * D * NIN, D, NIN, 208, 1, WIN_T, 0); \
            conv_mat(rot, gw, NGW, scr, lane, w_glu + (size_t)LL_ * 512 * 512, 512, 512, 16, 0, WGLU_T, 0); \
            for (int n = 0; n < 3; ++n) conv_mat(rot, gw, NGW, scr, lane, w_branch + ((size_t)LL_ * 3 + n) * 512 * D, 512, D, 32, 0, WB_T + (size_t)n * D * 512, 0); \
            conv_mat(rot, gw, NGW, scr, lane, w_mix_out + (size_t)LL_ * D * D, D, D, 32, 0, WOUT_T, 0); \
            conv_mat(rot, gw, NGW, scr, lane, w_xq + (size_t)LL_ * D * D, D, D, 32, 0, XQ_T, 0); \
            conv_mat(rot, gw, NGW, scr, lane, w_xo + (size_t)LL_ * D * D, D, D, 32, 0, XO_T, 0); \
    } while (0)
#define CONVERT_FFN(LL) do { const int LL_ = (LL); \
            if (!(LL_ & 1)) { \
                conv_mat(rot, gw, NGW, scr, lane, ffn_wg + (size_t)(LL_ >> 1) * D * DFF, D, DFF, 88, 2, FFN_GU, 0); \
                conv_mat(rot, gw, NGW, scr, lane, ffn_wu + (size_t)(LL_ >> 1) * D * DFF, D, DFF, 88, 2, FFN_GU, 128); \
                conv_mat(rot, gw, NGW, scr, lane, ffn_wd + (size_t)(LL_ >> 1) * DFF * D, DFF, D, 32, 0, FFN_D_DENSE, 0); \
            } else { \
                for (int e = 0; e < NEXP; ++e) { \
                    conv_mat(rot, gw, NGW, scr, lane, moe_wg + ((size_t)(LL_ >> 1) * NEXP + e) * D * DFFE, D, DFFE, 44, 2, FFN_GU + (size_t)e * 2 * DFFE * D, 0); \
                    conv_mat(rot, gw, NGW, scr, lane, moe_wu + ((size_t)(LL_ >> 1) * NEXP + e) * D * DFFE, D, DFFE, 44, 2, FFN_GU + (size_t)e * 2 * DFFE * D, 128); \
                    conv_mat(rot, gw, NGW, scr, lane, moe_wd + ((size_t)(LL_ >> 1) * NEXP + e) * DFFE * D, DFFE, D, 32, 0, FFN_D_MOE + (size_t)e * D * DFFE, 0); \
                } \
            } \
    } while (0)
#define SUBSYNC() do { asm volatile("s_waitcnt vmcnt(0) lgkmcnt(0)" ::: "memory"); __syncthreads(); } while (0)

    if (threadIdx.x < 34) ((LAS unsigned long long*)(lds + PTR_OFF))[threadIdx.x] = (unsigned long long)(uintptr_t)args.in[threadIdx.x];
    __syncthreads();
#define INP(k) ((const float*)inptr(lds, (k)))
#define x_in INP(0)
#define mem_in INP(1)
#define pos_in ((const int*)inptr(lds, 2))
#define w_in INP(3)
#define b_forget INP(4)
#define lam_re INP(5)
#define lam_im INP(6)
#define log_dt INP(7)
#define ssm_bre INP(8)
#define ssm_bim INP(9)
#define ssm_cre INP(10)
#define ssm_cim INP(11)
#define ssm_d INP(12)
#define w_glu INP(13)
#define w_branch INP(14)
#define w_mix_out INP(15)
#define ln_mix_g INP(16)
#define ln_mix_b INP(17)
#define w_xq INP(18)
#define w_xk INP(19)
#define w_xv INP(20)
#define w_xo INP(21)
#define ln_x_g INP(22)
#define ln_x_b INP(23)
#define ffn_wg INP(24)
#define ffn_wu INP(25)
#define ffn_wd INP(26)
#define moe_wr INP(27)
#define moe_br INP(28)
#define moe_wg INP(29)
#define moe_wu INP(30)
#define moe_wd INP(31)
#define ln_ffn_g INP(32)
#define ln_ffn_b INP(33)
    float* OUTF = args.out;
#define ZHP ((unsigned short*)(wsl + WS_ZH))
#define ROPE ((float*)(wsl + WS_ROPE))
#define FLOG ((float*)(wsl + WS_FLOG))
#define KBIAS ((bf16_t*)(wsl + WS_KBIAS))
#define LSE ((float*)(wsl + WS_LSE))
#define TOKE ((int*)(wsl + WS_TOKE))
#define TOKW ((float*)(wsl + WS_TOKW))
#define TOKP ((int*)(wsl + WS_TOKP))
#define INV16 ((unsigned short*)(wsl + WS_TOKP + 256 * 1024))
#define SLOC ((float*)(wsl + WS_SLOC))
#define POW ((f32x2*)(wsl + WS_POW))
#define BBAR ((f32x2*)(wsl + WS_BBAR))
#define KMAT ((float*)(wsl + WS_KMAT))
#define XB ((bf16_t*)(wsl + WS_XB))
#define STATS ((float*)(wsl + WS_STATS))
#define ONESV ((const float*)(wsl + WS_ONES))
#define ZEROSV ((const float*)(wsl + WS_ZEROS))
#define XKV ((bf16_t*)OUTF)
#define WIN_T ((bf16_t*)(wsl + WS_WL + WL_WIN))
#define WGLU_T ((bf16_t*)(wsl + WS_WL + WL_WGLU))
#define WB_T ((bf16_t*)(wsl + WS_WL + WL_WB))
#define WOUT_T ((bf16_t*)(wsl + WS_WL + WL_WOUT))
#define XQ_T ((bf16_t*)(wsl + WS_WL + WL_XQ))
#define XO_T ((bf16_t*)(wsl + WS_WL + WL_XO))
#define TF ((bf16_t*)(wsl + WS_WL + WL_TF))
#define ETAB ((bf16_t*)(wsl + WS_WL + WL_E))
#define FFN_GU ((bf16_t*)(wsl + WS_FFNW))
#define FFN_D_DENSE ((bf16_t*)(wsl + WS_FFNW + 11 * MiB))
#define FFN_D_MOE ((bf16_t*)(wsl + WS_FFNW + 44 * MiB))
#define UG ((bf16_t*)(wsl + WS_UG))
#define YSSM2 ((bf16_t*)(wsl + WS_UG))
#define QKV ((bf16_t*)(wsl + WS_QKV))
#define GATES ((bf16_t*)(wsl + WS_QKV))
#define XQ ((bf16_t*)(wsl + WS_QKV))
#define HBUF ((bf16_t*)(wsl + WS_QKV))
#define WKV_T ((bf16_t*)(wsl + WS_QKV))
#define MEMB ((bf16_t*)(wsl + WS_QKV + 16 * MiB))
#define YSSM ((bf16_t*)(wsl + WS_YS))
#define O1 ((bf16_t*)(wsl + WS_YS + 32 * MiB))
#define O2 ((bf16_t*)(wsl + WS_YS + 64 * MiB))
#define O3 ((bf16_t*)(wsl + WS_YS + 96 * MiB))
#define YFOX ((bf16_t*)(wsl + WS_YS + 128 * MiB))
#define MERGED O2
#define XG ((bf16_t*)(wsl + WS_YS))
#define Y2 ((bf16_t*)(wsl + WS_YS))

    PH_BEGIN
        ln_pass<2, false, true, false>(gw, NGW, lane, ZHP, OUTF, x_in, XB, STATS, nullptr, nullptr, nullptr, nullptr, nullptr, nullptr, nullptr, w_in + 3584, NIN, nullptr, nullptr, nullptr, hist, FLOG);
        for (int it = gt; it < 1024; it += NGT) { ((float*)(wsl + WS_ONES))[it] = 1.0f; ((float*)(wsl + WS_ZEROS))[it] = 0.0f; }
        for (int it = gt; it < T * 8; it += NGT) { const int row = it >> 3, j = it & 7;
            const float inv = (float)exp(-(double)j * 0.125 * 13.122363377404328);
            const float ang = (float)pos_in[row] * inv; double s, c; dsincos((double)ang, s, c);
            ROPE[(size_t)row * 16 + j] = (float)c; ROPE[(size_t)row * 16 + 8 + j] = (float)s; }
        for (int i2 = gt; i2 < DEPTH * 32 * 64 * 33; i2 += NGT) { const int it = i2 / 33, k = i2 - it * 33, g = (it >> 6) & 31, l = it >> 11;
            const double lr = lam_re[it], li = lam_im[it], dt = exp((double)log_dt[l * 32 + g]);
            const double mg = exp(k * dt * lr); double s, c; dsincos(k * dt * li, s, c); POW[(size_t)it * 33 + k] = (f32x2){(float)(mg * c), (float)(mg * s)}; }
        for (int i2 = gt; i2 < DEPTH * 32 * 64 * 16; i2 += NGT) { const int it = i2 >> 4, cc = i2 & 15, g = (it >> 6) & 31, l = it >> 11;
            const double lr = lam_re[it], li = lam_im[it], dt = exp((double)log_dt[l * 32 + g]);
            const double mg = exp(dt * lr); double s, c; dsincos(dt * li, s, c);
            const double nr = mg * c - 1.0, ni = mg * s, den = lr * lr + li * li, qr = (nr * lr + ni * li) / den, qi = (ni * lr - nr * li) / den;
            const double br = ssm_bre[(size_t)it * 16 + cc], bi = ssm_bim[(size_t)it * 16 + cc];
            BBAR[(size_t)it * 16 + cc] = (f32x2){(float)(qr * br - qi * bi), (float)(qr * bi + qi * br)}; }
        for (int it = gt; it < NB * NMEM * D / 4; it += NGT) { const f32x4 v = *(const f32x4*)(mem_in + (size_t)it * 4); u32x2 o; o.x = cvt_pk_bf16(v[0], v[1]); o.y = cvt_pk_bf16(v[2], v[3]); *(u32x2*)(MEMB + (size_t)it * 4) = o; }
        for (int l = 0; l < DEPTH; ++l) { conv_mat(rot, gw, NGW, scr, lane, w_xk + (size_t)l * D * D, D, D, 32, 0, WKV_T + (size_t)(2 * l) * D * D, 0);
                                          conv_mat(rot, gw, NGW, scr, lane, w_xv + (size_t)l * D * D, D, D, 32, 0, WKV_T + (size_t)(2 * l + 1) * D * D, 0); }
        CONVERT_MIXER(0); CONVERT_FFN(0);
    PH_END
    PH_BEGIN
        { SchedBatched S{(const char*)MEMB, (const char*)WKV_T, 0, (size_t)D * D * 2, D, D, 8, 4, 8, G, bx};
          EpiScale E{XKV, D, 1.0f, (size_t)NB * NMEM * D};
          pg8::gemm_phase(lds, D, D, D / 64, S, E); }
        for (int i2 = gt; i2 < DEPTH * 32 * 32 * 16 * 2; i2 += NGT) { const int it = i2 >> 1, hf = i2 & 1, co = it & 15, lag = (it >> 4) & 31, lg = it >> 9;
            float acc[16];
#pragma unroll
            for (int c = 0; c < 16; ++c) acc[c] = 0.f;
            for (int p = 32 * hf; p < 32 * hf + 32; ++p) { const f32x2 pw = POW[((size_t)lg * 64 + p) * 33 + lag]; const float cr = ssm_cre[((size_t)lg * 16 + co) * 64 + p], ci = ssm_cim[((size_t)lg * 16 + co) * 64 + p];
                const float zr = cr * pw.x - ci * pw.y, zi = cr * pw.y + ci * pw.x; const f32x2* bb = BBAR + ((size_t)lg * 64 + p) * 16;
#pragma unroll
                for (int c = 0; c < 16; ++c) acc[c] += zr * bb[c].x - zi * bb[c].y; }
#pragma unroll
            for (int c = 0; c < 16; ++c) acc[c] += __shfl_xor(acc[c], 1);
            if (hf == 0) {
#pragma unroll
                for (int c = 0; c < 16; ++c) KMAT[(((size_t)lg * 32 + lag) * 16 + co) * 16 + c] = acc[c]; } }
    PH_END

    for (int l = 0; l < DEPTH; ++l) {
        const bool moe = (l & 1) != 0; const int li2 = l >> 1;
        PH_BEGIN
            for (int step = 0; step < 2; ++step) { if ((step == 0) != ((vcu & 1) != 0)) {
            { SchedBatched S{(const char*)XB, (const char*)WIN_T, 0, 0, D, D, 128, 14, 1, G, bx};
              EpiInProj E{UG, QKV, ROPE, ctl + CW_NORM + l * 256};
              pg8::gemm_phase(lds, D, D, D / 64, S, E); }
            } else {
            for (int it = gt; it < 32 * 512 * 80; it += NGT) { const int k8 = it % 80, n = (it / 80) & 511, g = it / (80 * 512); const int k0 = 8 * k8, to = n >> 4, co = n & 15; const int lg = l * 32 + g;
                f32x4 a = (f32x4){0.f, 0.f, 0.f, 0.f}, b = a;
                if (k0 < 512) { const int ti = k0 >> 4, ci0 = k0 & 15, lag = to - ti;
                    if (lag >= 0) { const float* kp = KMAT + (((size_t)lg * 32 + lag) * 16 + co) * 16 + ci0; a = *(const f32x4*)kp; b = *(const f32x4*)(kp + 4); } }
                else { const int j0 = k0 - 512, part = j0 >> 6, p0 = j0 & 63; float v[8];
#pragma unroll
                    for (int q = 0; q < 8; ++q) { const int p = p0 + q; const f32x2 pw = POW[((size_t)lg * 64 + p) * 33 + to + 1]; const float cr = ssm_cre[((size_t)lg * 16 + co) * 64 + p], ci = ssm_cim[((size_t)lg * 16 + co) * 64 + p];
                        v[q] = part == 0 ? (cr * pw.x - ci * pw.y) : -(cr * pw.y + ci * pw.x); }
                    a = (f32x4){v[0], v[1], v[2], v[3]}; b = (f32x4){v[4], v[5], v[6], v[7]}; }
                *(u32x4*)(TF + ((size_t)g * 512 + n) * 640 + k0) = pack8(a, b); }
            for (int it = gt; it < 32 * 128 * 64; it += NGT) { const int k8 = it & 63, rowi = (it >> 6) & 127, g = it >> 13; const int k0 = 8 * k8, ti = k0 >> 4, ci0 = k0 & 15, part = rowi >> 6, p = rowi & 63; const int lg = l * 32 + g;
                const f32x2 pw = POW[((size_t)lg * 64 + p) * 33 + 31 - ti]; const f32x2* bb = BBAR + ((size_t)lg * 64 + p) * 16 + ci0; float v[8];
#pragma unroll
                for (int q = 0; q < 8; ++q) v[q] = part == 0 ? (pw.x * bb[q].x - pw.y * bb[q].y) : (pw.x * bb[q].y + pw.y * bb[q].x);
                *(u32x4*)(ETAB + ((size_t)g * 128 + rowi) * 512 + k0) = pack8((f32x4){v[0], v[1], v[2], v[3]}, (f32x4){v[4], v[5], v[6], v[7]}); }
            } SUBSYNC(); }
        PH_END
        PH_BEGIN
            auto fox_pro = [&](const int b, const int h) {
                    const float bf = b_forget[l * 8 + h]; const int p0 = wave * 512 + lane * 8; float ls8[8]; float run = 0.f;
#pragma unroll
                    for (int q = 0; q < 8; ++q) { const float z = FLOG[((size_t)b * SEQ + p0 + q) * 8 + h] + bf; run += fminf(z, 0.f) - 0.6931471805599453f * __builtin_amdgcn_logf(1.0f + fexp2(-fabsf(z) * LOG2E)); ls8[q] = run; }
                    float incl = run;
#pragma unroll
                    for (int o = 1; o < 64; o <<= 1) { const float t = __shfl_up(incl, o); if (lane >= o) incl += t; }
                    LAS float* wtot = (LAS float*)(lds + 65536); LAS float* betaL = (LAS float*)lds;
                    if (lane == 63) wtot[wave] = incl;
                    const unsigned* nr_ = ctl + CW_NORM + l * 256 + (b * 8 + h) * 4;
                    float qm = __uint_as_float(__hip_atomic_load(nr_, RLX_AGENT)) + __uint_as_float(__hip_atomic_load(nr_ + 1, RLX_AGENT));
                    float km = __uint_as_float(__hip_atomic_load(nr_ + 2, RLX_AGENT)) + __uint_as_float(__hip_atomic_load(nr_ + 3, RLX_AGENT));
                    SUBSYNC();
                    float base = incl - run;
                    for (int w = 0; w < wave; ++w) base += wtot[w];
#pragma unroll
                    for (int q = 0; q < 8; ++q) { const float beta = -(base + ls8[q]) * LOG2E;
                        const unsigned b1 = cvt_pk_bf16(beta, 0.f) & 0xffffu; const float r1 = beta - bf_lo(b1); const unsigned b2 = cvt_pk_bf16(r1, 0.f) & 0xffffu; const float r2 = r1 - bf_lo(b2); const unsigned b3 = cvt_pk_bf16(r2, 0.f) & 0xffffu;
                        *(u32x4*)(KBIAS + (((size_t)b * SEQ + p0 + q) * 8 + h) * 8) = (u32x4){b1 | (b2 << 16), b3 | 0x3F800000u, 0x3F803F80u, 0u}; betaL[p0 + q] = beta; }
                    SUBSYNC();
                    { const float need_d = 2.0f * sqrtf(qm * km) + 36.0f;
#pragma unroll
                      for (int jj = 0; jj < 2; ++jj) { const int j = 2 * wave + jj; const bool cnd = (lane < 4 * j) && (betaL[256 * j] - betaL[64 * lane + 63] >= need_d);
                          const unsigned long long mk = __ballot(cnd); if (lane == 0) MISC[32 + j] = (unsigned)__popcll(mk); } }
                    SUBSYNC();
            };
            int prev_bh = -1;
            if (vcu < 1024) { const int bh0 = (vcu & 255) >> 2; fox_pro(bh0 >> 3, bh0 & 7); prev_bh = bh0; }
            for (int c0 = vcu; c0 < 256; c0 += G) { const int pq = c0 >> 1, g = pq >> 2, pm = pq & 3, pn = c0 & 1; const int lg = l * 32 + g;
                const char* Ag = (const char*)(UG + ((size_t)g * 1024 + pm * 256) * 640);
                { SchedOne S; S.u.A = Ag; S.u.B = (const char*)(ETAB + (size_t)g * 128 * 512); S.u.pm = pm; S.u.pn = 0; S.u.aux = g;
                  EpiS1 E{SLOC};
                  pg8::gemm_phase(lds, 640, 512, 512 / 64, S, E); }
                SUBSYNC();
                if (wave < 2) { const int b = 2 * pm + wave;
                    const f32x2 a = POW[((size_t)lg * 64 + lane) * 33 + 32]; float sr = 0.f, si = 0.f;
                    float lr[16], lim[16];
#pragma unroll
                    for (int q = 0; q < 16; ++q) { const float* sp = SLOC + ((size_t)g * 1024 + b * 128 + q) * 128; lr[q] = sp[lane]; lim[q] = sp[64 + lane]; }
                    for (int j0 = 0; j0 < 128; j0 += 16) { float nlr[16], nlim[16]; const int jn = j0 + 16 < 128 ? j0 + 16 : j0;
#pragma unroll
                        for (int q = 0; q < 16; ++q) { const float* sp = SLOC + ((size_t)g * 1024 + b * 128 + jn + q) * 128; nlr[q] = sp[lane]; nlim[q] = sp[64 + lane]; }
#pragma unroll
                        for (int q = 0; q < 16; ++q) { bf16_t* up = UG + ((size_t)g * 1024 + b * 128 + j0 + q) * 640 + 512;
                            up[lane] = (bf16_t)(cvt_pk_bf16(sr, 0.f) & 0xffffu); up[64 + lane] = (bf16_t)(cvt_pk_bf16(si, 0.f) & 0xffffu);
                            const float nr = a.x * sr - a.y * si + lr[q], ni = a.x * si + a.y * sr + lim[q]; sr = nr; si = ni; }
#pragma unroll
                        for (int q = 0; q < 16; ++q) { lr[q] = nlr[q]; lim[q] = nlim[q]; } } }
                SUBSYNC();
                { SchedOne S; S.u.A = Ag; S.u.B = (const char*)(TF + ((size_t)g * 512 + pn * 256) * 640); S.u.pm = pm; S.u.pn = pn; S.u.aux = g;
                  EpiS3 E{UG, ssm_d + l * 512, YSSM};
                  pg8::gemm_phase(lds, 640, 640, 640 / 64, S, E); }
            }
            {
              for (int k = vcu; k < 1024; k += G) { const int v8 = k & 255, i = k >> 8, bh = v8 >> 2, s = v8 & 3, b = bh >> 3, h = bh & 7; const int qb = (i == 0) ? s : (i == 1) ? 7 - s : (i == 2) ? 8 + s : 15 - s;
                if (bh != prev_bh) { prev_bh = bh; fox_pro(b, h); }
                const int tlo_u = (int)MISC[32 + qb];
                const size_t row0 = (size_t)b * SEQ;
                att::fox_unit(lds, wsf_all, QKV + row0 * NQKV + 1536 + h * 64, QKV + row0 * NQKV + 2048 + h * 64, QKV + row0 * NQKV + 2560 + h * 64, (long)NQKV, qb * 256, tlo_u, (qb * 256 + 256) >> 6,
                                    KBIAS + ((size_t)b * SEQ * 8 + h) * 8, YFOX + row0 * 512 + h * 64, 512); } }
            { unsigned* qctr = ctl + CW_QUEUE + l * 64; unsigned kn = 0u;
              if (tid == 0) MISC[48] = __hip_atomic_fetch_add(qctr, 1u, RLX_AGENT);
              SUBSYNC();
              int k = (int)MISC[48];
              while (k < 960) {
                if (tid == 0) kn = __hip_atomic_fetch_add(qctr, 1u, RLX_AGENT);
                {
                  if (k < 256) { const int bh = k >> 2, j = k & 3, b = bh >> 3, h = bh & 7; const size_t row0 = (size_t)b * SEQ;
                      att::dil_sweep<false>(lds, wsf_all, QKV + row0 * NQKV + h * 64, QKV + row0 * NQKV + 512 + h * 64, QKV + row0 * NQKV + 1024 + h * 64, (long)NQKV, 4 * j, 4,
                                            O1 + row0 * 512 + h * 64, 512L, LSE + row0 * 8 + h, 8L, 0L, 0L, 0L); }
                  else if (k < 512) { const int bh = (k - 256) >> 2, j = k & 3, b = bh >> 3, h = bh & 7; const size_t row0 = (size_t)b * SEQ + j;
                      att::dil_sweep<false>(lds, wsf_all, QKV + row0 * NQKV + h * 64, QKV + row0 * NQKV + 512 + h * 64, QKV + row0 * NQKV + 1024 + h * 64, 4L * NQKV, 0, 4,
                                            O2 + row0 * 512 + h * 64, 4L * 512, LSE + (size_t)T * 8 + row0 * 8 + h, 4L * 8, 0L, 0L, 0L); }
                  else { int bh, b0, nb; if (k < 704) { bh = (k - 512) / 3; b0 = 4 * ((k - 512) % 3); nb = 4; } else { bh = (k - 704) >> 2; b0 = 12 + ((k - 704) & 3); nb = 1; }
                      const int b = bh >> 3, h = bh & 7; const size_t row0 = (size_t)b * SEQ;
                      att::dil_sweep<true>(lds, wsf_all, QKV + row0 * NQKV + h * 64, QKV + row0 * NQKV + 512 + h * 64, QKV + row0 * NQKV + 1024 + h * 64, 16L * NQKV, b0, nb,
                                           O3 + row0 * 512 + h * 64, 16L * 512, LSE + (size_t)2 * T * 8 + row0 * 8 + h, 16L * 8, (long)NQKV, 512L, 8L); } }
                if (tid == 0) MISC[48] = kn;
                SUBSYNC();
                k = (int)MISC[48];
              } }
        PH_END
        PH_BEGIN
            for (int step = 0; step < 2; ++step) { if ((step == 0) != ((vcu & 1) != 0)) {
            { SchedBatched S{(const char*)XB, (const char*)(WIN_T + (size_t)3584 * D), 0, 0, D, D, 128, 12, 1, G, bx};
              EpiGates E{GATES};
              pg8::gemm_phase(lds, D, D, D / 64, S, E); }
            } else {
            { SchedBatched S{(const char*)YSSM, (const char*)WGLU_T, 0, 0, 512, 512, 128, 2, 1, G, bx};
              EpiGlu E{YSSM, YSSM2};
              pg8::gemm_phase(lds, 512, 512, 512 / 64, S, E); }
            { const int h = lane >> 3; float l0n, l1n, l2n; u32x4 q1n, q2n, q3n;
#define MIX_LOAD(r_) do { const size_t off_ = (size_t)(r_) * 512 + lane * 8; l0n = LSE[(size_t)(r_) * 8 + h]; l1n = LSE[(size_t)T * 8 + (size_t)(r_) * 8 + h]; l2n = LSE[(size_t)2 * T * 8 + (size_t)(r_) * 8 + h]; \
        q1n = *(const u32x4*)(O1 + off_); q2n = *(const u32x4*)(O2 + off_); q3n = *(const u32x4*)(O3 + off_); } while (0)
              MIX_LOAD(gw);
              for (int row = gw; row < T; row += NGW) { const size_t off = (size_t)row * 512 + lane * 8;
                const float l0 = l0n, l1 = l1n, l2 = l2n; const u32x4 q1 = q1n, q2 = q2n, q3 = q3n;
                const int nrow = row + NGW < T ? row + NGW : row; MIX_LOAD(nrow);
                const float mx = fmaxf(l0, fmaxf(l1, l2)); float e0 = fexp2(l0 - mx), e1 = fexp2(l1 - mx), e2 = fexp2(l2 - mx); const float rs = frcp(e0 + e1 + e2); e0 *= rs; e1 *= rs; e2 *= rs;
                f32x4 a0, b0, a1, b1, a2, b2; unpack8(q1, a0, b0); unpack8(q2, a1, b1); unpack8(q3, a2, b2);
                *(u32x4*)(O1 + off) = pack8(a0 * e0 + a1 * e1 + a2 * e2, b0 * e0 + b1 * e1 + b2 * e2); }
#undef MIX_LOAD
            }
            } SUBSYNC(); }
        PH_END
        PH_BEGIN
            { SchedMerge S{(const char*)YSSM2, (const char*)O1, (const char*)YFOX, (const char*)WB_T, G, bx};
              EpiMerge E{GATES, MERGED};
              pg8::gemm_phase(lds, 512, 512, 512 / 64, S, E); }
        PH_END
        PH_BEGIN
            { SchedBatched S{(const char*)MERGED, (const char*)WOUT_T, 0, 0, D, D, 128, 4, 1, G, bx};
              if (l == 0) { EpiResT<true> E{ZHP, x_in, STATS, ONESV, ZEROSV}; pg8::gemm_phase(lds, D, D, D / 64, S, E); }
              else { EpiResT<false> E{ZHP, nullptr, STATS, ln_ffn_g + (l - 1) * D, ln_ffn_b + (l - 1) * D}; pg8::gemm_phase(lds, D, D, D / 64, S, E); } }
        PH_END
        PH_BEGIN
            ln_pass<0, false, false, false>(gw, NGW, lane, ZHP, OUTF, nullptr, XB, STATS, ln_mix_g + l * D, ln_mix_b + l * D, nullptr, nullptr, nullptr, nullptr, nullptr, nullptr, 0, nullptr, nullptr, nullptr, hist, nullptr);
        PH_END
        PH_BEGIN
            { SchedBatched S{(const char*)XB, (const char*)XQ_T, 0, 0, D, D, 128, 4, 1, G, bx};
              EpiScale E{XQ, D, C2_256, 0};
              pg8::gemm_phase(lds, D, D, D / 64, S, E); }
        PH_END
        PH_BEGIN
            for (int k = vcu; k < 512; k += G) { const int b = k >> 6, h = (k >> 4) & 3, qb = k & 15; const size_t qrow = (size_t)b * SEQ + qb * 256;
                const bf16_t* Kx = XKV + (size_t)(2 * l) * NB * NMEM * D + (size_t)b * NMEM * D + h * 256; const bf16_t* Vx = Kx + (size_t)NB * NMEM * D;
                att::xattn_unit(lds, wsf_all, XQ + qrow * D + h * 256, Kx, Vx, XQ + qrow * D + h * 256); }
        PH_END
        PH_BEGIN
            { SchedBatched S{(const char*)XQ, (const char*)XO_T, 0, 0, D, D, 128, 4, 1, G, bx};
              EpiResT<false> E{ZHP, nullptr, STATS, ln_mix_g + l * D, ln_mix_b + l * D};
              pg8::gemm_phase(lds, D, D, D / 64, S, E); }
        PH_END
        PH_BEGIN
            if (!moe) ln_pass<0, false, false, false>(gw, NGW, lane, ZHP, OUTF, nullptr, XB, STATS, ln_x_g + l * D, ln_x_b + l * D, nullptr, nullptr, nullptr, nullptr, nullptr, nullptr, 0, nullptr, nullptr, nullptr, hist, nullptr);
            else {
                ln_pass<0, true, false, false>(gw, NGW, lane, ZHP, OUTF, nullptr, XB, STATS, ln_x_g + l * D, ln_x_b + l * D, nullptr, nullptr, nullptr, nullptr, nullptr, moe_wr + (size_t)li2 * D * NEXP, NEXP, moe_br + li2 * NEXP, TOKE, TOKW, hist, nullptr);
                SUBSYNC();
                if (tid < NEXP) { const unsigned c = hist[tid]; if (c) __hip_atomic_fetch_add(ctl + CW_CNT + (li2 * 8 + tid) * 64, c, RLX_AGENT); hist[tid] = 0u; }
                { int stp_ = NGT; asm volatile("" : "+s"(stp_));
                  unsigned z_ = 0u; asm volatile("" : "+v"(z_));
                  for (int it = gt; it < 264 * 256 / 2; it += stp_) ((unsigned*)INV16)[it] = z_; }
            }
        PH_END
        if (!moe) {
            PH_BEGIN
                for (int step = 0; step < 2; ++step) { if ((step == 0) != ((vcu & 1) != 0)) {
                { SchedBatched S{(const char*)XB, (const char*)FFN_GU, 0, 0, D, D, 128, 22, 1, G, bx};
                  EpiSwiglu E{HBUF, DFF};
                  pg8::gemm_phase(lds, D, D, D / 64, S, E); }
                } else { if (l + 1 < DEPTH) CONVERT_MIXER(l + 1); } SUBSYNC(); }
            PH_END
            PH_BEGIN
                { SchedBatched S{(const char*)HBUF, (const char*)FFN_D_DENSE, 0, 0, DFF, DFF, 128, 4, 1, G, bx};
                  EpiResT<false> E{ZHP, nullptr, STATS, ln_x_g + l * D, ln_x_b + l * D};
                  pg8::gemm_phase(lds, DFF, DFF, DFF / 64, S, E); }
            PH_END
            PH_BEGIN
                if (l + 1 < DEPTH) ln_pass<0, false, true, false>(gw, NGW, lane, ZHP, OUTF, nullptr, XB, STATS, ln_ffn_g + l * D, ln_ffn_b + l * D, nullptr, nullptr, nullptr, nullptr, nullptr, w_in + (size_t)(l + 1) * D * NIN + 3584, NIN, nullptr, nullptr, nullptr, hist, FLOG);
                else ln_pass<0, false, false, true>(gw, NGW, lane, ZHP, OUTF, nullptr, XB, STATS, ln_ffn_g + l * D, ln_ffn_b + l * D, nullptr, nullptr, nullptr, nullptr, nullptr, nullptr, 0, nullptr, nullptr, nullptr, hist, nullptr);
                if (l + 1 < DEPTH) { SUBSYNC(); { int tq_ = threadIdx.x; asm volatile("" : "+v"(tq_)); const int lane = tq_ & 63; CONVERT_FFN(l + 1); } }
            PH_END
        } else {
            PH_BEGIN
                LOAD_TOFF();
                for (int t0 = gw * 64; t0 < T; t0 += NGW * 64) { const int t = t0 + lane; const int e0 = TOKE[2 * t], e1 = TOKE[2 * t + 1];
                    int r0 = 0, r1 = 0, tb0 = 0, tb1 = 0; unsigned cme = 0u; const unsigned long long lt = (1ull << lane) - 1ull;
#pragma unroll
                    for (int e = 0; e < 8; ++e) { const unsigned long long m0 = __ballot(e0 == e), m1 = __ballot(e1 == e); const int n0 = __popcll(m0), n1 = __popcll(m1);
                        if (lane == e) cme = (unsigned)(n0 + n1);
                        if (e0 == e) { r0 = __popcll(m0 & lt); tb0 = toff[e] * 256; }
                        if (e1 == e) { r1 = n0 + __popcll(m1 & lt); tb1 = toff[e] * 256; } }
                    unsigned base = 0u; if (lane < 8 && cme) base = __hip_atomic_fetch_add(ctl + CW_FILL + (li2 * 8 + lane) * 64, cme, RLX_AGENT);
                    const int pos0 = tb0 + (int)__shfl(base, e0) + r0, pos1 = tb1 + (int)__shfl(base, e1) + r1;
                    TOKP[2 * t] = pos0; TOKP[2 * t + 1] = pos1; INV16[pos0] = (unsigned short)t; INV16[pos1] = (unsigned short)t; }
            PH_END
            PH_BEGIN
                for (int step = 0; step < 2; ++step) { if ((step == 0) != ((vcu & 1) != 0)) {
                LOAD_TOFF();
                { LAS unsigned short* linv = (LAS unsigned short*)(lds + 135168);
                  { int tq = tid; asm volatile("" : "+v"(tq));
#pragma unroll 1
                    for (int q = tq; q < 12 * 256; q += NWAVES * 64) { const int i = q >> 8; const int L = i * G + bx; if (L < toff[8] * 11) linv[q] = INV16[(L / 11) * 256 + (q & 255)]; } }
                  SUBSYNC(); }
                { SchedMoeG S; S.Abase = (const char*)XB; S.linv = (const LAS unsigned short*)(lds + 135168); S.Bbase = (const char*)FFN_GU; S.strideB = (size_t)2 * DFFE * D * 2; S.lda = D; S.ldb = D; S.G = G; S.c = bx;
#pragma unroll
                  for (int e = 0; e < 9; ++e) S.toff[e] = toff[e];
                  EpiSwiglu E{HBUF, DFFE};
                  pg8::gemm_phase(lds, D, D, D / 64, S, E); }
                } else { if (l + 1 < DEPTH) CONVERT_MIXER(l + 1); } SUBSYNC(); }
            PH_END
            PH_BEGIN
                LOAD_TOFF();
                { SchedMoe S; S.Abase = (const char*)HBUF; S.Bbase = (const char*)FFN_D_MOE; S.strideB = (size_t)D * DFFE * 2; S.lda = DFFE; S.ldb = DFFE; S.nN = 4; S.G = G; S.c = bx;
#pragma unroll
                  for (int e = 0; e < 9; ++e) S.toff[e] = toff[e];
                  EpiScale E{Y2, D, 1.0f, 0};
                  pg8::gemm_phase(lds, DFFE, DFFE, DFFE / 64, S, E); }
            PH_END
            PH_BEGIN
                if (l + 1 < DEPTH) ln_pass<1, false, true, false>(gw, NGW, lane, ZHP, OUTF, nullptr, XB, STATS, ln_ffn_g + l * D, ln_ffn_b + l * D, ln_x_g + l * D, ln_x_b + l * D, Y2, TOKP, TOKW, w_in + (size_t)(l + 1) * D * NIN + 3584, NIN, nullptr, nullptr, nullptr, hist, FLOG);
                else ln_pass<1, false, false, true>(gw, NGW, lane, ZHP, OUTF, nullptr, XB, STATS, ln_ffn_g + l * D, ln_ffn_b + l * D, ln_x_g + l * D, ln_x_b + l * D, Y2, TOKP, TOKW, nullptr, 0, nullptr, nullptr, nullptr, hist, nullptr);
                if (l + 1 < DEPTH) { SUBSYNC(); { int tq_ = threadIdx.x; asm volatile("" : "+v"(tq_)); const int lane = tq_ & 63; CONVERT_FFN(l + 1); } }
            PH_END
        }
    }
}

#ifndef SPLIT_LAUNCH
#define SPLIT_LAUNCH 0
#endif
extern "C" void kernel_launch(void* const* d_in, const int* in_sizes, int n_in, void* d_out, int out_size, void* d_ws, size_t ws_size, hipStream_t stream) {
    static int grid = 0;
    if (grid == 0) {
        if (n_in != 34 || out_size != T * D || ws_size < WS_END) { fprintf(stderr, "kernel_launch: unexpected shapes (n_in %d out %d ws %zu)\n", n_in, out_size, ws_size); grid = -1; return; }
        int dev = 0, cus = 0;
        if (hipGetDevice(&dev) != hipSuccess || hipDeviceGetAttribute(&cus, hipDeviceAttributeMultiprocessorCount, dev) != hipSuccess) { grid = -1; return; }
        if (hipFuncSetAttribute((const void*)hybrid_fwd, hipFuncAttributeMaxDynamicSharedMemorySize, LDS_BYTES) != hipSuccess) { grid = -1; return; }
        int per_cu = 0;
        if (hipOccupancyMaxActiveBlocksPerMultiprocessor(&per_cu, (const void*)hybrid_fwd, NWAVES * 64, LDS_BYTES) != hipSuccess || per_cu < 1) { fprintf(stderr, "kernel_launch: occupancy query says %d\n", per_cu); }
        (void)hipGetLastError();
        grid = cus;
    }
    if (grid < 0) return;
    if (hipMemsetAsync((char*)d_ws + WS_CTL, 0, CTL_ZERO_BYTES, stream) != hipSuccess) return;
    Args a{};
    for (int i = 0; i < 34; ++i) a.in[i] = d_in[i];
    a.out = (float*)d_out; a.ws = (unsigned char*)d_ws;
#if SPLIT_LAUNCH
    for (int ph = 0; ph < NPH_TOTAL; ++ph) { a.ph_lo = ph; a.ph_hi = ph + 1; hipLaunchKernelGGL(hybrid_fwd, dim3(grid), dim3(NWAVES * 64), LDS_BYTES, stream, a); }
#else
    a.ph_lo = 0; a.ph_hi = NPH_TOTAL;
    hipLaunchKernelGGL(hybrid_fwd, dim3(grid), dim3(NWAVES * 64), LDS_BYTES, stream, a);
#endif
}
```

```cpp
#include <hip/hip_runtime.h>
#include <cstdio>
#include <cstdint>

#define GAS __attribute__((address_space(1)))
#define LAS __attribute__((address_space(3)))
typedef unsigned short bf16_t;
typedef short bf16x8 __attribute__((ext_vector_type(8)));
typedef short s16x4 __attribute__((ext_vector_type(4)));
typedef float f32x2 __attribute__((ext_vector_type(2)));
typedef float f32x4 __attribute__((ext_vector_type(4)));
typedef float f32x16 __attribute__((ext_vector_type(16)));
typedef unsigned u32x2 __attribute__((ext_vector_type(2)));
typedef unsigned u32x4 __attribute__((ext_vector_type(4)));

constexpr int NB = 8, SEQ = 4096, T = NB * SEQ, D = 1024;
constexpr int DEPTH = 4, NIN = 6664, NQKV = 3072, NGATE = 3072;
constexpr int DFF = 2816, DFFE = 1408, NEXP = 8, NMEM = 256;
constexpr int XG_ROWS = 2 * T + 8 * 256;
constexpr float LOG2E = 1.4426950408889634f;
constexpr float C2_64 = 0.125f * LOG2E;
constexpr float C2_256 = 0.0625f * LOG2E;
constexpr float ALPHA = 1.681792830507429f;
constexpr float LN_EPS = 1e-5f;

typedef __bf16 bf16x2_t __attribute__((ext_vector_type(2)));
__device__ __forceinline__ unsigned cvt_pk_bf16(float lo, float hi) { const f32x2 v = {lo, hi}; const bf16x2_t b = __builtin_convertvector(v, bf16x2_t); return __builtin_bit_cast(unsigned, b); }
typedef _Float16 h16x2_t __attribute__((ext_vector_type(2)));
__device__ __forceinline__ unsigned cvt_pk_f16(float lo, float hi) { const f32x2 v = {lo, hi}; const h16x2_t h = __builtin_convertvector(v, h16x2_t); return __builtin_bit_cast(unsigned, h); }
__device__ __forceinline__ f32x2 unpk_f16(unsigned u) { return __builtin_convertvector(__builtin_bit_cast(h16x2_t, u), f32x2); }
__device__ __forceinline__ u32x4 pack8h(const f32x4 a, const f32x4 b) { u32x4 w; w.x = cvt_pk_f16(a[0], a[1]); w.y = cvt_pk_f16(a[2], a[3]); w.z = cvt_pk_f16(b[0], b[1]); w.w = cvt_pk_f16(b[2], b[3]); return w; }
__device__ __forceinline__ void unpack8h(const u32x4 w, f32x4& a, f32x4& b) { const f32x2 p0 = unpk_f16(w.x), p1 = unpk_f16(w.y), p2 = unpk_f16(w.z), p3 = unpk_f16(w.w); a = (f32x4){p0.x, p0.y, p1.x, p1.y}; b = (f32x4){p2.x, p2.y, p3.x, p3.y}; }
__device__ __forceinline__ float bf_lo(unsigned u) { return __uint_as_float(u << 16); }
__device__ __forceinline__ float bf_hi(unsigned u) { return __uint_as_float(u & 0xffff0000u); }
__device__ __forceinline__ float fexp2(float x) { return __builtin_amdgcn_exp2f(x); }
__device__ __forceinline__ float frcp(float x) { return __builtin_amdgcn_rcpf(x); }
__device__ __forceinline__ float sigmoidf_(float x) { return frcp(1.0f + fexp2(-x * LOG2E)); }
__device__ __forceinline__ float siluf_(float x) { return x * sigmoidf_(x); }
__device__ __forceinline__ float gelu_tanh_(float x) { const float u = 0.7978845608028654f * (x + 0.044715f * x * x * x); return x * sigmoidf_(2.0f * u); }
template <int CTRL, int RM> __device__ __forceinline__ float dpp_mov0(float v) { return __builtin_bit_cast(float, __builtin_amdgcn_update_dpp(0, __builtin_bit_cast(int, v), CTRL, RM, 0xf, false)); }
__device__ __forceinline__ float wave_sum(float v) {
    v += dpp_mov0<0xB1, 0xf>(v); v += dpp_mov0<0x4E, 0xf>(v); v += dpp_mov0<0x141, 0xf>(v); v += dpp_mov0<0x140, 0xf>(v);
    v += dpp_mov0<0x142, 0xa>(v); v += dpp_mov0<0x143, 0xc>(v);
    return __builtin_bit_cast(float, __builtin_amdgcn_readlane(__builtin_bit_cast(int, v), 63));
}
__device__ __forceinline__ u32x4 pack8(const f32x4 a, const f32x4 b) { u32x4 w; w.x = cvt_pk_bf16(a[0], a[1]); w.y = cvt_pk_bf16(a[2], a[3]); w.z = cvt_pk_bf16(b[0], b[1]); w.w = cvt_pk_bf16(b[2], b[3]); return w; }
__device__ __forceinline__ void unpack8(const u32x4 w, f32x4& a, f32x4& b) { a = (f32x4){bf_lo(w.x), bf_hi(w.x), bf_lo(w.y), bf_hi(w.y)}; b = (f32x4){bf_lo(w.z), bf_hi(w.z), bf_lo(w.w), bf_hi(w.w)}; }

namespace pg8 {
constexpr int BM = 256, BK = 64, HALF = 128, HTB = HALF * BK * 2, STAGE_BYTES = 8 * HTB, NXCD = 8, WGM = 8;
__host__ __device__ __forceinline__ int lds_byte(int r, int c) { const int st = (r >> 4) * 2 + (c >> 5), rr = r & 15, cc = c & 31, ob = rr * 64 + cc * 2; return st * 1024 + (ob ^ (((ob >> 9) & 1) << 5)); }
__host__ __device__ __forceinline__ void stage_rc(int b, int& R, int& C) { const int st = b / 1024, sb = b % 1024, swz = sb ^ (((sb >> 9) & 1) << 5); R = (st >> 1) * 16 + swz / 64; C = (st & 1) * 32 + (swz % 64) / 2; }
__host__ __device__ __forceinline__ int perm32(int rho) { const int n = rho >> 4, i = rho & 15; return 8 * (i >> 2) + 4 * n + (i & 3); }

struct Unit { const char* A; const char* B; int pm, pn, aux; };

__device__ __forceinline__ bool static_order(int nM, int nN, int G, int c, int i, int& pm, int& pn) {
    const int nwg = nM * nN; const long L = (long)i * G + c; if (L >= nwg) return false;
    int wgid = (int)L; { const int q = nwg / NXCD, r = nwg % NXCD, xcd = wgid % NXCD, off = wgid / NXCD; wgid = (xcd < r ? xcd * (q + 1) : r * (q + 1) + (xcd - r) * q) + off; }
    const int nig = WGM * nN, gid = wgid / nig, fm = gid * WGM, gsz = (nM - fm) < WGM ? (nM - fm) : WGM;
    pm = fm + ((wgid % nig) % gsz); pn = (wgid % nig) / gsz; return true;
}

template <class Epi, class Sched, bool ALIGN_EPI = true, bool SP2 = true>
__device__ __forceinline__ void gemm_phase(LAS unsigned char* lds, const int lda, const int ldb, const int nt, const Sched& S, const Epi& E) {
    int tid = threadIdx.x; asm volatile("" : "+v"(tid));
    const int wid = __builtin_amdgcn_readfirstlane(tid >> 6), lane = tid & 63, wr = wid >> 2, wc = wid & 3, fr = lane & 15, fq = lane >> 4;
    constexpr bool GA = Sched::GATHER; static_assert(!GA || SP2, "gathered A: SP2 stream only");
    unsigned voffA[2], voffB[2]; int RA[2], CA[2];
#pragma unroll
    for (int i = 0; i < 2; ++i) { int R, C; stage_rc(tid * 16 + i * 8192, R, C); const int Rb = Epi::PERM ? ((R & ~31) + perm32(R & 31)) : R; RA[i] = R; CA[i] = C;
        voffA[i] = (unsigned)(R * lda + C) * 2u; voffB[i] = (unsigned)(Rb * ldb + C) * 2u; }
    unsigned vC0[2] = {0u, 0u}, vC1[2] = {0u, 0u}, vN0[2] = {0u, 0u}, vN1[2] = {0u, 0u};
    const size_t kstep = (size_t)(BK * 2);
    const size_t hstepA = (size_t)HALF * lda * 2, hstepB = (size_t)HALF * ldb * 2;
    const unsigned ldsw = (unsigned)wid * 1024u;
    const int aoff = lds_byte(wr * 64 + fr, fq * 8), boff = lds_byte(wc * 32 + fr, fq * 8);
#define PG8_SA(b, h) (((b) * 2 + (h)) * HTB)
#define PG8_SB(b, h) ((4 + (b) * 2 + (h)) * HTB)
#define PG8_STAGE(bufoff, gbase, voff) do { _Pragma("unroll") for (int _i = 0; _i < 2; ++_i) \
        __builtin_amdgcn_global_load_lds((const unsigned*)((const char*)(gbase) + (voff)[_i]), (LAS unsigned*)(lds + (bufoff) + ldsw + _i * 8192), 16, 0, 0); } while (0)
#define PG8_STAGE_A(b, h, ptr, nx) do { if constexpr (GA) { const unsigned o0_ = (nx) ? ((h) ? vN1[0] : vN0[0]) : ((h) ? vC1[0] : vC0[0]), o1_ = (nx) ? ((h) ? vN1[1] : vN0[1]) : ((h) ? vC1[1] : vC0[1]); \
        __builtin_amdgcn_global_load_lds((const unsigned*)((const char*)(ptr) + o0_), (LAS unsigned*)(lds + PG8_SA(b, h) + ldsw), 16, 0, 0); \
        __builtin_amdgcn_global_load_lds((const unsigned*)((const char*)(ptr) + o1_), (LAS unsigned*)(lds + PG8_SA(b, h) + ldsw + 8192), 16, 0, 0); } \
        else PG8_STAGE(PG8_SA(b, h), (ptr) + ((h) ? hstepA : (size_t)0), voffA); } while (0)
#define PG8_LDA(dst, b, h) do { _Pragma("unroll") for (int m = 0; m < 4; ++m) _Pragma("unroll") for (int k = 0; k < 2; ++k) dst[m][k] = *(const LAS bf16x8*)(lds + PG8_SA(b, h) + aoff + m * 2048 + k * 1024); } while (0)
#define PG8_LDB(dst, b, h) do { _Pragma("unroll") for (int n = 0; n < 2; ++n) _Pragma("unroll") for (int k = 0; k < 2; ++k) dst[n][k] = *(const LAS bf16x8*)(lds + PG8_SB(b, h) + boff + n * 2048 + k * 1024); } while (0)
#define PG8_MMA(ai, bj, At, Bt) do { __builtin_amdgcn_s_setprio(1); _Pragma("unroll") for (int m = 0; m < 4; ++m) _Pragma("unroll") for (int n = 0; n < 2; ++n) _Pragma("unroll") for (int k = 0; k < 2; ++k) \
        acc[ai][bj][m][n] = __builtin_amdgcn_mfma_f32_16x16x32_bf16(Bt[n][k], At[m][k], acc[ai][bj][m][n], 0, 0, 0); __builtin_amdgcn_s_setprio(0); } while (0)
#define PG8_WAIT_V(n) asm volatile("s_waitcnt vmcnt(" #n ")" ::: "memory")
#define PG8_WAIT_L(n) asm volatile("s_waitcnt lgkmcnt(" #n ")" ::: "memory")
#define PG8_BAR __builtin_amdgcn_s_barrier()
#define PG8_SCHED __builtin_amdgcn_sched_barrier(0)
    Unit cur, nxt; int ui = 0;
    if (!S.next(0, cur)) return;
    f32x4 acc[2][2][4][2];
#pragma unroll
    for (int a = 0; a < 2; ++a)
#pragma unroll
        for (int b = 0; b < 2; ++b)
#pragma unroll
            for (int m = 0; m < 4; ++m)
#pragma unroll
                for (int n = 0; n < 2; ++n) acc[a][b][m][n] = (f32x4){0.f, 0.f, 0.f, 0.f};
    bf16x8 At[4][2], B0[2][2], B1[2][2];
    const char* cA = cur.A; const char* cB = cur.B;
    if constexpr (GA) S.gather(0, RA, CA, vC0, vC1);
    if constexpr (SP2) {
        PG8_STAGE(PG8_SB(0, 0), cB, voffB); PG8_STAGE(PG8_SB(0, 1), cB + hstepB, voffB); PG8_STAGE_A(0, 0, cA, false); PG8_STAGE_A(0, 1, cA, false);
        if (wr == 1) PG8_BAR;
        PG8_WAIT_V(2); PG8_BAR;
        PG8_STAGE(PG8_SB(1, 0), cB + kstep, voffB); PG8_STAGE_A(1, 0, cA + kstep, false); PG8_STAGE(PG8_SB(1, 1), cB + hstepB + kstep, voffB);
        PG8_WAIT_V(6); PG8_BAR;
    } else {
        PG8_STAGE(PG8_SB(0, 0), cB, voffB); PG8_STAGE(PG8_SA(0, 0), cA, voffA); PG8_STAGE(PG8_SB(0, 1), cB + hstepB, voffB); PG8_STAGE(PG8_SA(0, 1), cA + hstepA, voffA);
        if (wr == 1) PG8_BAR;
        PG8_WAIT_V(4); PG8_BAR;
        PG8_STAGE(PG8_SB(1, 0), cB + kstep, voffB); PG8_STAGE(PG8_SA(1, 0), cA + kstep, voffA); PG8_STAGE(PG8_SB(1, 1), cB + hstepB + kstep, voffB);
        PG8_WAIT_V(6); PG8_BAR;
    }
    for (;;) {
        const bool has_next = S.next(ui + 1, nxt);
        const char* nA = has_next ? nxt.A : cA; const char* nB = has_next ? nxt.B : cB;
        if constexpr (GA) { if (has_next) S.gather(ui + 1, RA, CA, vN0, vN1); else { vN0[0] = vC0[0]; vN0[1] = vC0[1]; vN1[0] = vC1[0]; vN1[1] = vC1[1]; } }
        for (int t = 0; t < nt; t += 2) {
            const bool last = (t == nt - 2);
            const char* a1 = cA + (size_t)(t + 1) * kstep;
            const char* a2 = last ? nA : cA + (size_t)(t + 2) * kstep; const char* b2 = last ? nB : cB + (size_t)(t + 2) * kstep;
            const char* a3 = a2 + kstep; const char* b3 = b2 + kstep;
            if constexpr (SP2) {
            PG8_LDB(B0, 0, 0); PG8_LDB(B1, 0, 1); PG8_SCHED; PG8_LDA(At, 0, 0); PG8_STAGE_A(1, 1, a1, false);
            PG8_WAIT_V(8); PG8_WAIT_L(0); PG8_BAR; PG8_MMA(0, 0, At, B0); PG8_MMA(0, 1, At, B1); PG8_BAR; PG8_SCHED;
            PG8_LDA(At, 0, 1); PG8_STAGE(PG8_SB(0, 0), b2, voffB); PG8_STAGE(PG8_SB(0, 1), b2 + hstepB, voffB); PG8_STAGE_A(0, 0, a2, last);
            PG8_WAIT_V(8); PG8_WAIT_L(0); PG8_BAR; PG8_MMA(1, 0, At, B0); PG8_MMA(1, 1, At, B1); PG8_BAR; PG8_SCHED;
            PG8_LDB(B0, 1, 0); PG8_LDB(B1, 1, 1); PG8_SCHED; PG8_LDA(At, 1, 0); PG8_STAGE_A(0, 1, a2, last);
            PG8_WAIT_V(8); PG8_WAIT_L(0); PG8_BAR; PG8_MMA(0, 0, At, B0); PG8_MMA(0, 1, At, B1); PG8_BAR; PG8_SCHED;
            PG8_LDA(At, 1, 1); PG8_STAGE(PG8_SB(1, 0), b3, voffB); PG8_STAGE(PG8_SB(1, 1), b3 + hstepB, voffB); PG8_STAGE_A(1, 0, a3, last);
            PG8_WAIT_V(8); PG8_WAIT_L(0); PG8_BAR; PG8_MMA(1, 0, At, B0); PG8_MMA(1, 1, At, B1); PG8_BAR; PG8_SCHED;
            } else {
            PG8_LDB(B0, 0, 0); PG8_SCHED; PG8_LDA(At, 0, 0); PG8_STAGE(PG8_SA(1, 1), a1 + hstepA, voffA);
            PG8_WAIT_L(8); PG8_BAR; PG8_WAIT_L(0); PG8_MMA(0, 0, At, B0); PG8_BAR; PG8_SCHED;
            PG8_LDB(B1, 0, 1); PG8_STAGE(PG8_SB(0, 0), b2, voffB);
            PG8_BAR; PG8_WAIT_L(0); PG8_MMA(0, 1, At, B1); PG8_BAR;
            PG8_LDA(At, 0, 1); PG8_STAGE(PG8_SA(0, 0), a2, voffA);
            PG8_BAR; PG8_WAIT_L(0); PG8_MMA(1, 0, At, B0); PG8_BAR; PG8_SCHED;
            PG8_STAGE(PG8_SB(0, 1), b2 + hstepB, voffB);
            PG8_WAIT_V(6); PG8_BAR; PG8_MMA(1, 1, At, B1); PG8_BAR;
            PG8_LDB(B0, 1, 0); PG8_SCHED; PG8_LDA(At, 1, 0); PG8_STAGE(PG8_SA(0, 1), a2 + hstepA, voffA);
            PG8_WAIT_L(8); PG8_BAR; PG8_WAIT_L(0); PG8_MMA(0, 0, At, B0); PG8_BAR; PG8_SCHED;
            PG8_LDB(B1, 1, 1); PG8_STAGE(PG8_SB(1, 0), b3, voffB);
            PG8_BAR; PG8_WAIT_L(0); PG8_MMA(0, 1, At, B1); PG8_BAR;
            PG8_LDA(At, 1, 1); PG8_STAGE(PG8_SA(1, 0), a3, voffA);
            PG8_BAR; PG8_WAIT_L(0); PG8_MMA(1, 0, At, B0); PG8_BAR; PG8_SCHED;
            PG8_STAGE(PG8_SB(1, 1), b3 + hstepB, voffB);
            PG8_WAIT_V(6); PG8_BAR; PG8_MMA(1, 1, At, B1); PG8_BAR;
            }
        }
        if constexpr (ALIGN_EPI) { if (wr == 0) PG8_BAR; }
        { int fr2 = fr, fq2 = fq; asm volatile("" : "+v"(fr2), "+v"(fq2)); E(acc, cur, wr, wc, fr2, fq2); }
        if (!has_next) break;
        if (!Epi::keep_acc(cur)) {
#pragma unroll
        for (int a = 0; a < 2; ++a)
#pragma unroll
            for (int b = 0; b < 2; ++b)
#pragma unroll
                for (int m = 0; m < 4; ++m)
#pragma unroll
                    for (int n = 0; n < 2; ++n) acc[a][b][m][n] = (f32x4){0.f, 0.f, 0.f, 0.f};
        }
        cur = nxt; cA = nA; cB = nB; ++ui;
        if constexpr (GA) { vC0[0] = vN0[0]; vC0[1] = vN0[1]; vC1[0] = vN1[0]; vC1[1] = vN1[1]; }
        if constexpr (ALIGN_EPI) { if (wr == 1) PG8_BAR; }
    }
    PG8_WAIT_V(0);
    if constexpr (!ALIGN_EPI) { if (wr == 0) PG8_BAR; }
    PG8_BAR;
#undef PG8_SA
#undef PG8_SB
#undef PG8_STAGE
#undef PG8_STAGE_A
#undef PG8_LDA
#undef PG8_LDB
#undef PG8_MMA
#undef PG8_WAIT_V
#undef PG8_WAIT_L
#undef PG8_BAR
#undef PG8_SCHED
}
}
using pg8::Unit;
typedef f32x4 Acc[2][2][4][2];

struct SchedBatched { static constexpr bool GATHER = false;
    const char* Abase; const char* Bbase; size_t strideA, strideB; int lda, ldb, nM, nN, nbatch, G, c;
    __device__ __forceinline__ bool next(int i, Unit& u) const {
        if (nbatch == 1) { int pm, pn; if (!pg8::static_order(nM, nN, G, c, i, pm, pn)) return false;
            u.pm = pm; u.pn = pn; u.aux = 0; u.A = Abase + (size_t)pm * 256 * lda * 2; u.B = Bbase + (size_t)pn * 256 * ldb * 2; return true; }
        const long L = (long)i * G + c; const int per = nM * nN; if (L >= (long)per * nbatch) return false;
        const int g = (int)(L / per), r = (int)(L % per); u.pm = r / nN; u.pn = r % nN; u.aux = g;
        u.A = Abase + (size_t)g * strideA + (size_t)u.pm * 256 * lda * 2; u.B = Bbase + (size_t)g * strideB + (size_t)u.pn * 256 * ldb * 2; return true;
    }
};
struct SchedOne { static constexpr bool GATHER = false; Unit u; __device__ __forceinline__ bool next(int i, Unit& o) const { if (i != 0) return false; o = u; return true; } };
struct SchedMerge { static constexpr bool GATHER = false;
    const char* A0; const char* A1; const char* A2; const char* Bbase; int G, c;
    __device__ __forceinline__ bool next(int i, Unit& u) const {
        const int n = i % 3; int pm, pn; if (!pg8::static_order(128, 4, G, c, i / 3, pm, pn)) return false;
        u.pm = pm; u.pn = pn; u.aux = n;
        const char* a = n == 0 ? A0 : (n == 1 ? A1 : A2);
        u.A = a + (size_t)pm * 256 * 512 * 2; u.B = Bbase + (size_t)n * (1024 * 512 * 2) + (size_t)pn * 256 * 512 * 2; return true;
    }
};
struct SchedMoe { static constexpr bool GATHER = false;
    const char* Abase; const char* Bbase; size_t strideB; int lda, ldb, nN, G, c; int toff[9];
    __device__ __forceinline__ bool next(int i, Unit& u) const {
        const long L = (long)i * G + c; if (L >= (long)toff[8] * nN) return false;
        const int pm = (int)(L / nN), pn = (int)(L % nN); int e = 0;
#pragma unroll
        for (int k = 1; k < 8; ++k) e += (pm >= toff[k]) ? 1 : 0;
        u.pm = pm; u.pn = pn; u.aux = e; u.A = Abase + (size_t)pm * 256 * lda * 2; u.B = Bbase + (size_t)e * strideB + (size_t)pn * 256 * ldb * 2; return true;
    }
};

struct SchedMoeG { static constexpr bool GATHER = true;
    static constexpr int nN = 11; const char* Abase; const char* Bbase; size_t strideB; int lda, ldb, G, c; int toff[9]; const LAS unsigned short* linv;
    __device__ __forceinline__ bool next(int i, Unit& u) const {
        const long L = (long)i * G + c; if (L >= (long)toff[8] * nN) return false;
        const int pm = (int)(L / nN), pn = (int)(L % nN); int e = 0;
#pragma unroll
        for (int k = 1; k < 8; ++k) e += (pm >= toff[k]) ? 1 : 0;
        u.pm = pm; u.pn = pn; u.aux = e; u.A = Abase; u.B = Bbase + (size_t)e * strideB + (size_t)pn * 256 * ldb * 2; return true;
    }
    __device__ __forceinline__ void gather(int ord, const int* R, const int* C, unsigned* v0, unsigned* v1) const {
#pragma unroll
        for (int i = 0; i < 2; ++i) { const unsigned t0 = linv[ord * 256 + R[i]], t1 = linv[ord * 256 + 128 + R[i]];
            v0[i] = (t0 * (unsigned)lda + (unsigned)C[i]) * 2u; v1[i] = (t1 * (unsigned)lda + (unsigned)C[i]) * 2u; }
    }
};

#define FOR_ROWS _Pragma("unroll") for (int ai = 0; ai < 2; ++ai) _Pragma("unroll") for (int m = 0; m < 4; ++m)
#define ROW_T (ai * 128 + wr * 64 + m * 16 + fr)

struct EpiScale {
    static __device__ __forceinline__ bool keep_acc(const Unit&) { return false; } static constexpr bool PERM = true;
    bf16_t* O; int ldc; float scale; size_t auxstride;
    __device__ __forceinline__ void operator()(const Acc& acc, const Unit& u, int wr, int wc, int fr, int fq) const {
        bf16_t* base = O + (size_t)u.aux * auxstride + (size_t)u.pm * 256 * ldc + u.pn * 256 + wc * 32 + 8 * fq;
        FOR_ROWS { const int rt = ROW_T;
#pragma unroll
            for (int bj = 0; bj < 2; ++bj) { __builtin_nontemporal_store(pack8(acc[ai][bj][m][0] * scale, acc[ai][bj][m][1] * scale), (u32x4*)(base + (size_t)rt * ldc + bj * 128)); } }
    }
};
struct EpiInProj {
    static __device__ __forceinline__ bool keep_acc(const Unit&) { return false; } static constexpr bool PERM = true;
    bf16_t* UG; bf16_t* QKV; const float* ROPE; unsigned* NORM;
    __device__ __forceinline__ void operator()(const Acc& acc, const Unit& u, int wr, int wc, int fr, int fq) const {
        if (u.pn < 2) {
            FOR_ROWS { const int rt = ROW_T; const int row = u.pm * 256 + rt, b = row >> 12, t = row & 4095, j = t >> 5, ti = t & 31;
#pragma unroll
                for (int bj = 0; bj < 2; ++bj) { const int c0 = u.pn * 256 + bj * 128 + wc * 32 + 8 * fq, g = c0 >> 4, ci = c0 & 15;
                    __builtin_nontemporal_store(pack8(acc[ai][bj][m][0], acc[ai][bj][m][1]), (u32x4*)(UG + ((size_t)(g * 1024 + b * 128 + j) * 640 + ti * 16 + ci))); } }
        } else {
            const int seg = (u.pn - 2) >> 1; const float sc = (seg == 0 || seg == 3) ? C2_64 : 1.0f; const bool rope = (seg < 2) && ((wc & 1) == 0);
            const int colbase = (u.pn - 2) * 256 + wc * 32 + 8 * fq;
            const bool nrm = (seg == 3 || seg == 4); float hm0 = 0.f, hm1 = 0.f;
            FOR_ROWS { const int rt = ROW_T; const int row = u.pm * 256 + rt;
#pragma unroll
                for (int bj = 0; bj < 2; ++bj) { f32x4 v0 = acc[ai][bj][m][0], v1 = acc[ai][bj][m][1];
                    if (nrm) { const f32x4 w0 = v0 * sc, w1 = v1 * sc; const f32x4 q2 = w0 * w0 + w1 * w1; float ss = (q2[0] + q2[1]) + (q2[2] + q2[3]);
                        ss += __shfl_xor(ss, 16); ss += __shfl_xor(ss, 32);
                        if (bj == 0) hm0 = fmaxf(hm0, ss); else hm1 = fmaxf(hm1, ss); }
                    if (rope) {
                        f32x4 p0, p1;
#pragma unroll
                        for (int k = 0; k < 4; ++k) { p0[k] = __shfl_xor(v0[k], 16); p1[k] = __shfl_xor(v1[k], 16); }
                        if (fq < 2) { const f32x4 c0 = *(const f32x4*)(ROPE + (size_t)row * 16), c1 = *(const f32x4*)(ROPE + (size_t)row * 16 + 4), s0 = *(const f32x4*)(ROPE + (size_t)row * 16 + 8), s1 = *(const f32x4*)(ROPE + (size_t)row * 16 + 12);
                            const float sg = fq == 0 ? -1.0f : 1.0f;
                            v0 = v0 * c0 + (p0 * s0) * sg; v1 = v1 * c1 + (p1 * s1) * sg; }
                    }
                    __builtin_nontemporal_store(pack8(v0 * sc, v1 * sc), (u32x4*)(QKV + (size_t)row * NQKV + colbase + bj * 128)); } }
            if (nrm) {
#pragma unroll
                for (int o = 1; o < 16; o <<= 1) { hm0 = fmaxf(hm0, __shfl_xor(hm0, o)); hm1 = fmaxf(hm1, __shfl_xor(hm1, o)); }
                if ((threadIdx.x & 63) == 0) { const int b = (u.pm * 256) >> 12, c0 = (u.pn - 2) * 256 + wc * 32;
                    __hip_atomic_fetch_max(NORM + ((b * 8 + ((c0 >> 6) & 7)) * 4 + (seg == 4 ? 2 : 0) + (wc & 1)), __float_as_uint(hm0 * 1.01f), __ATOMIC_RELAXED, __HIP_MEMORY_SCOPE_AGENT);
                    __hip_atomic_fetch_max(NORM + ((b * 8 + (((c0 + 128) >> 6) & 7)) * 4 + (seg == 4 ? 2 : 0) + (wc & 1)), __float_as_uint(hm1 * 1.01f), __ATOMIC_RELAXED, __HIP_MEMORY_SCOPE_AGENT); } }
        }
    }
};
struct EpiGates {
    static __device__ __forceinline__ bool keep_acc(const Unit&) { return false; } static constexpr bool PERM = true;
    bf16_t* G;
    __device__ __forceinline__ void operator()(const Acc& acc, const Unit& u, int wr, int wc, int fr, int fq) const {
        bf16_t* base = G + (size_t)u.pm * 256 * NGATE + u.pn * 256 + wc * 32 + 8 * fq;
        FOR_ROWS { const int rt = ROW_T;
#pragma unroll
            for (int bj = 0; bj < 2; ++bj) { f32x4 a = acc[ai][bj][m][0], b = acc[ai][bj][m][1];
#pragma unroll
                for (int k = 0; k < 4; ++k) { a[k] = sigmoidf_(a[k]); b[k] = sigmoidf_(b[k]); }
                __builtin_nontemporal_store(pack8(a, b), (u32x4*)(base + (size_t)rt * NGATE + bj * 128)); } }
    }
};
struct EpiGlu {
    static constexpr bool F16 = false; static __device__ __forceinline__ bool keep_acc(const Unit&) { return false; } static constexpr bool PERM = true; static constexpr int NVMEM = 0;
    const bf16_t* Y; bf16_t* O;
    __device__ __forceinline__ void operator()(const Acc& acc, const Unit& u, int wr, int wc, int fr, int fq) const {
        const size_t off0 = (size_t)u.pm * 256 * 512 + u.pn * 256 + wc * 32 + 8 * fq;
#pragma unroll
        for (int ai = 0; ai < 2; ++ai) {
            u32x4 yz[4][2];
#pragma unroll
            for (int m = 0; m < 4; ++m)
#pragma unroll
                for (int bj = 0; bj < 2; ++bj) yz[m][bj] = *(const u32x4*)(Y + off0 + (size_t)ROW_T * 512 + bj * 128);
#pragma unroll
            for (int m = 0; m < 4; ++m)
#pragma unroll
                for (int bj = 0; bj < 2; ++bj) { f32x4 ya, yb; unpack8(yz[m][bj], ya, yb); f32x4 a = acc[ai][bj][m][0], b = acc[ai][bj][m][1];
#pragma unroll
                    for (int k = 0; k < 4; ++k) { a[k] = ya[k] * sigmoidf_(a[k]); b[k] = yb[k] * sigmoidf_(b[k]); }
                    *(u32x4*)(O + off0 + (size_t)ROW_T * 512 + bj * 128) = pack8(a, b); }
            asm volatile("" ::: "memory");
        }
    }

};
struct EpiMerge {
    static constexpr bool F16 = false; static __device__ __forceinline__ bool keep_acc(const Unit& u) { return u.aux < 2; } static constexpr bool PERM = true; static constexpr int NVMEM = 0;
    const bf16_t* G; bf16_t* M;
    __device__ __forceinline__ void operator()(Acc& acc, const Unit& u, int wr, int wc, int fr, int fq) const {
        const int col0 = u.pn * 256 + wc * 32 + 8 * fq; const int n = u.aux;
#pragma unroll
        for (int ai = 0; ai < 2; ++ai)
#pragma unroll
            for (int mp = 0; mp < 2; ++mp) {
                u32x4 gz[2][2], hz[2][2];
#pragma unroll
                for (int mm = 0; mm < 2; ++mm) { const int m = 2 * mp + mm; const size_t row = (size_t)u.pm * 256 + ROW_T;
#pragma unroll
                    for (int bj = 0; bj < 2; ++bj) { gz[mm][bj] = *(const u32x4*)(G + row * NGATE + n * 1024 + col0 + bj * 128); if (n < 2) hz[mm][bj] = *(const u32x4*)(G + row * NGATE + (n + 1) * 1024 + col0 + bj * 128); } }
#pragma unroll
                for (int mm = 0; mm < 2; ++mm) { const int m = 2 * mp + mm; const size_t row = (size_t)u.pm * 256 + ROW_T;
#pragma unroll
                    for (int bj = 0; bj < 2; ++bj) { f32x4 ga, gb; unpack8(gz[mm][bj], ga, gb);
#pragma unroll
                        for (int k = 0; k < 4; ++k) { ga[k] = fmaxf(ga[k], 1.0e-30f); gb[k] = fmaxf(gb[k], 1.0e-30f); }
                        if (n < 2) { f32x4 ha, hb; unpack8(hz[mm][bj], ha, hb);
#pragma unroll
                            for (int k = 0; k < 4; ++k) { ga[k] *= frcp(fmaxf(ha[k], 1.0e-30f)); gb[k] *= frcp(fmaxf(hb[k], 1.0e-30f)); }
                            acc[ai][bj][m][0] *= ga; acc[ai][bj][m][1] *= gb; }
                        else *(u32x4*)(M + row * 1024 + col0 + bj * 128) = pack8(acc[ai][bj][m][0] * ga, acc[ai][bj][m][1] * gb); } }
                asm volatile("" ::: "memory");
            }
    }

};
template <bool INF32> struct EpiResT {
    static __device__ __forceinline__ bool keep_acc(const Unit&) { return false; } static constexpr bool PERM = true; static constexpr int NVMEM = 0;
    unsigned short* ZH; const float* X32; const float* ST; const float* g; const float* b;
    __device__ __forceinline__ void operator()(const Acc& acc, const Unit& u, int wr, int wc, int fr, int fq) const {
        const int col0 = u.pn * 256 + wc * 32 + 8 * fq;
        f32x4 g4[2][2], b4[2][2];
#pragma unroll
        for (int bj = 0; bj < 2; ++bj)
#pragma unroll
            for (int n = 0; n < 2; ++n) { g4[bj][n] = *(const f32x4*)(g + col0 + bj * 128 + n * 4); b4[bj][n] = *(const f32x4*)(b + col0 + bj * 128 + n * 4) * ALPHA; }
#pragma unroll
        for (int ai = 0; ai < 2; ++ai) {
            u32x4 zr[4][2]; f32x2 stv[4];
#pragma unroll
            for (int m = 0; m < 4; ++m) { const size_t row = (size_t)u.pm * 256 + ROW_T; stv[m] = *(const f32x2*)(ST + row * 2);
                if (!INF32) {
#pragma unroll
                    for (int bj = 0; bj < 2; ++bj) zr[m][bj] = *(const u32x4*)(ZH + row * D + col0 + bj * 128); } }
#pragma unroll
            for (int m = 0; m < 4; ++m) { const size_t row = (size_t)u.pm * 256 + ROW_T; const f32x2 st = stv[m]; const float sc = st.y * ALPHA;
#pragma unroll
                for (int bj = 0; bj < 2; ++bj) { const size_t off = row * D + col0 + bj * 128; f32x4 x0, x1;
                    if (INF32) { x0 = *(const f32x4*)(X32 + off); x1 = *(const f32x4*)(X32 + off + 4); } else unpack8h(zr[m][bj], x0, x1);
                    x0 = ((x0 - st.x) * sc) * g4[bj][0] + b4[bj][0] + acc[ai][bj][m][0]; x1 = ((x1 - st.x) * sc) * g4[bj][1] + b4[bj][1] + acc[ai][bj][m][1];
                    *(u32x4*)(ZH + off) = pack8h(x0, x1); } }
            asm volatile("" ::: "memory");
        }
    }
};
struct EpiSwiglu {
    static __device__ __forceinline__ bool keep_acc(const Unit&) { return false; } static constexpr bool PERM = true;
    bf16_t* H; int ldh;
    __device__ __forceinline__ void operator()(const Acc& acc, const Unit& u, int wr, int wc, int fr, int fq) const {
        bf16_t* base = H + (size_t)u.pm * 256 * ldh + u.pn * 128 + wc * 32 + 8 * fq;
        FOR_ROWS { const int rt = ROW_T; f32x4 a = acc[ai][0][m][0], b = acc[ai][0][m][1]; const f32x4 ua = acc[ai][1][m][0], ub = acc[ai][1][m][1];
#pragma unroll
            for (int k = 0; k < 4; ++k) { a[k] = siluf_(a[k]) * ua[k]; b[k] = siluf_(b[k]) * ub[k]; }
            __builtin_nontemporal_store(pack8(a, b), (u32x4*)(base + (size_t)rt * ldh)); }
    }
};
struct EpiS1 {
    static __device__ __forceinline__ bool keep_acc(const Unit&) { return false; } static constexpr bool PERM = false;
    float* SLOC;
    __device__ __forceinline__ void operator()(const Acc& acc, const Unit& u, int wr, int wc, int fr, int fq) const {
        float* base = SLOC + ((size_t)u.aux * 1024 + u.pm * 256) * 128 + wc * 32 + 4 * fq;
        FOR_ROWS { const int rt = ROW_T;
#pragma unroll
            for (int n = 0; n < 2; ++n) *(f32x4*)(base + (size_t)rt * 128 + n * 16) = acc[ai][0][m][n]; }
    }
};
struct EpiS3 {
    static constexpr bool F16 = false; static __device__ __forceinline__ bool keep_acc(const Unit&) { return false; } static constexpr bool PERM = true; static constexpr int NVMEM = 0;
    const bf16_t* UG; const float* dskip; bf16_t* Y;
    __device__ __forceinline__ void operator()(const Acc& acc, const Unit& u, int wr, int wc, int fr, int fq) const {
        const int g = u.aux;
        f32x4 da[2], db[2]; int to[2], co[2];
#pragma unroll
        for (int bj = 0; bj < 2; ++bj) { const int n0 = u.pn * 256 + bj * 128 + wc * 32 + 8 * fq; to[bj] = n0 >> 4; co[bj] = n0 & 15; da[bj] = *(const f32x4*)(dskip + g * 16 + co[bj]); db[bj] = *(const f32x4*)(dskip + g * 16 + co[bj] + 4); }
#pragma unroll
        for (int ai = 0; ai < 2; ++ai) {
            u32x4 uz[4][2];
#pragma unroll
            for (int m = 0; m < 4; ++m)
#pragma unroll
                for (int bj = 0; bj < 2; ++bj) uz[m][bj] = *(const u32x4*)(UG + ((size_t)(g * 1024 + u.pm * 256 + ROW_T) * 640 + to[bj] * 16 + co[bj]));
#pragma unroll
            for (int m = 0; m < 4; ++m) { const int R = u.pm * 256 + ROW_T, b = R >> 7, j = R & 127;
#pragma unroll
                for (int bj = 0; bj < 2; ++bj) { f32x4 ua, ub; unpack8(uz[m][bj], ua, ub);
                    f32x4 a = acc[ai][bj][m][0] + da[bj] * ua, bb = acc[ai][bj][m][1] + db[bj] * ub;
#pragma unroll
                    for (int k = 0; k < 4; ++k) { a[k] = gelu_tanh_(a[k]); bb[k] = gelu_tanh_(bb[k]); }
                    *(u32x4*)(Y + ((size_t)(b * 4096 + j * 32 + to[bj]) * 512 + g * 16 + co[bj])) = pack8(a, bb); } }
            asm volatile("" ::: "memory");
        }
    }

};

namespace att {
__device__ __forceinline__ int crow(int r, int hi) { return (r & 3) + 8 * (r >> 2) + 4 * hi; }
__device__ __forceinline__ float swap_max(float m) { auto rr = __builtin_amdgcn_permlane32_swap(__float_as_uint(m), __float_as_uint(m), false, false); return fmaxf(__uint_as_float(rr[0]), __uint_as_float(rr[1])); }
__device__ __forceinline__ float swap_add(float m) { auto rr = __builtin_amdgcn_permlane32_swap(__float_as_uint(m), __float_as_uint(m), false, false); return __uint_as_float(rr[0]) + __uint_as_float(rr[1]); }
__device__ __forceinline__ float rowmax(const f32x16& p0, const f32x16& p1) {
    float a = fmaxf(p0[0], p1[0]);
#pragma unroll
    for (int r = 1; r < 16; ++r) a = fmaxf(a, fmaxf(p0[r], p1[r]));
    return swap_max(a);
}
__device__ __forceinline__ float max3f(float a, float b, float c) { float r; asm("v_max3_f32 %0, %1, %2, %3" : "=v"(r) : "v"(a), "v"(b), "v"(c)); return r; }
__device__ __forceinline__ float rowmax_fast(const f32x16& p0, const f32x16& p1) {
    float a = max3f(p0[0], p0[1], p1[0]), b = max3f(p0[2], p0[3], p1[1]); a = max3f(a, p1[2], p1[3]);
#pragma unroll
    for (int r = 4; r < 16; r += 4) { a = max3f(a, p0[r], p0[r + 1]); b = max3f(b, p0[r + 2], p0[r + 3]); a = max3f(a, p1[r], p1[r + 1]); b = max3f(b, p1[r + 2], p1[r + 3]); }
    float m; asm("v_max_f32_e32 %0, %1, %2" : "=v"(m) : "v"(a), "v"(b));
    auto rr = __builtin_amdgcn_permlane32_swap(__float_as_uint(m), __float_as_uint(m), false, false);
    float o; asm("v_max_f32_e32 %0, %1, %2" : "=v"(o) : "v"(__uint_as_float(rr[0])), "v"(__uint_as_float(rr[1]))); return o;
}
template <int NK> __device__ __forceinline__ void qkt(f32x16& p0, f32x16& p1, const LAS unsigned char* Kslot, const bf16x8* qr, int r32, int hi) {
    const LAS unsigned char* kb = Kslot + hi * 1024 + r32 * 16;
#pragma unroll
    for (int d0 = 0; d0 < NK; ++d0) {
        const bf16x8 b0 = *(const LAS bf16x8*)(kb + d0 * 2048);
        const bf16x8 b1 = *(const LAS bf16x8*)(kb + d0 * 2048 + 512);
        p0 = __builtin_amdgcn_mfma_f32_32x32x16_bf16(b0, qr[d0], p0, 0, 0, 0);
        p1 = __builtin_amdgcn_mfma_f32_32x32x16_bf16(b1, qr[d0], p1, 0, 0, 0);
    }
}
template <int ND> __device__ __forceinline__ void pv(f32x16* o, unsigned vb, bf16x8 pa0, bf16x8 pa1, bf16x8 pa2, bf16x8 pa3) {
#pragma unroll
    for (int d0 = 0; d0 < ND; ++d0) { s16x4 lo[4], hi[4];
#pragma unroll
        for (int ks = 0; ks < 4; ++ks) {
            asm volatile("ds_read_b64_tr_b16 %0, %1 offset:%c2" : "=&v"(lo[ks]) : "v"(vb), "i"(d0 * 4096 + ks * 1024) : "memory");
            asm volatile("ds_read_b64_tr_b16 %0, %1 offset:%c2" : "=&v"(hi[ks]) : "v"(vb), "i"(d0 * 4096 + ks * 1024 + 512) : "memory"); }
        asm volatile("s_waitcnt lgkmcnt(0)" ::: "memory"); __builtin_amdgcn_sched_barrier(0);
#define ATT_PK(k) (bf16x8){lo[k][0], lo[k][1], lo[k][2], lo[k][3], hi[k][0], hi[k][1], hi[k][2], hi[k][3]}
        o[d0] = __builtin_amdgcn_mfma_f32_32x32x16_bf16(pa0, ATT_PK(0), o[d0], 0, 0, 0);
        o[d0] = __builtin_amdgcn_mfma_f32_32x32x16_bf16(pa1, ATT_PK(1), o[d0], 0, 0, 0);
        o[d0] = __builtin_amdgcn_mfma_f32_32x32x16_bf16(pa2, ATT_PK(2), o[d0], 0, 0, 0);
        o[d0] = __builtin_amdgcn_mfma_f32_32x32x16_bf16(pa3, ATT_PK(3), o[d0], 0, 0, 0);
#undef ATT_PK
    }
}
__device__ __forceinline__ void glds16(const void* gsrc, unsigned lds_dst) { unsigned keep;
    asm volatile("s_mov_b32 %0, m0\n\ts_mov_b32 m0, %2\n\ts_nop 0\n\tglobal_load_lds_dwordx4 %1, off\n\ts_mov_b32 m0, %0" : "=&s"(keep) : "v"(gsrc), "s"(lds_dst) : "memory"); }
#define ATT_WAITBAR() do { asm volatile("s_waitcnt vmcnt(0) lgkmcnt(0)" ::: "memory"); __builtin_amdgcn_s_barrier(); asm volatile("" ::: "memory"); } while (0)
constexpr float NEG = -1.0e30f;

constexpr int ATT_NS = 4, ATT_KSLOT = 10240, ATT_VOFF = ATT_NS * ATT_KSLOT, ATT_OST = ATT_VOFF + ATT_NS * 8192;
template <int MODE>
__device__ __forceinline__ void attn64_unit(LAS unsigned char* lds, LAS float* wsf_all, const bf16_t* Qp, const bf16_t* Kp, const bf16_t* Vp, const long rs,
                                            const int i0, const int t_lo, const int t_hi, const bf16_t* kbias, bf16_t* Op, const long os, float* lsep, const long ls) {
    int tid = threadIdx.x; asm volatile("" : "+v"(tid));
    const int lane = tid & 63, r32 = lane & 31, hi = lane >> 5, wid = __builtin_amdgcn_readfirstlane(tid >> 6);
    LAS float* wsf = wsf_all + wid * 64;
    const int qw0 = i0 + wid * 32, qi = qw0 + r32;
    constexpr float THR = 30.0f;
    int w_lo = t_lo; const int w_hi = ((qw0 + 31) >> 6) + 1;
    if (MODE == 1) { const int lo = (qw0 - 128) >> 6; w_lo = lo > t_lo ? lo : t_lo; }
    float mhat = 0.f, lrun = 0.f; bool started = false; f32x16 o[2]; o[0] = f32x16{}; o[1] = f32x16{};
    f32x16 negm = f32x16{};
    const bf16_t* ksrc = Kp + (long)lane * rs + wid * 8;
    const bf16_t* vsrc = Vp + (long)(16 * (wid & 3) + (lane >> 2)) * rs + (wid >> 2) * 32 + (lane & 3) * 8;
    const unsigned vb0 = (unsigned)(uintptr_t)(lds + ATT_VOFF) + ((lane >> 4) & 1) * 32 + (lane & 3) * 8 + (4 * hi + ((lane & 15) >> 2)) * 64;
#define ATT_ISSUE(tt) do { const int t_ = (tt) < t_hi ? (tt) : t_hi - 1; const int s_ = (tt) & (ATT_NS - 1); const unsigned l0_ = (unsigned)(uintptr_t)lds; \
        glds16(ksrc + (long)t_ * 64 * rs, (unsigned)__builtin_amdgcn_readfirstlane((int)(l0_ + s_ * ATT_KSLOT + wid * 1024))); \
        glds16(vsrc + (long)t_ * 64 * rs, (unsigned)__builtin_amdgcn_readfirstlane((int)(l0_ + ATT_VOFF + s_ * 8192 + wid * 1024))); \
        if (MODE == 0 && wid == 0) glds16(kbias + (long)(t_ * 64 + lane) * 64, (unsigned)__builtin_amdgcn_readfirstlane((int)(l0_ + s_ * ATT_KSLOT + 8192))); } while (0)
#define ATT_QK(tt) do { const LAS unsigned char* Ks_ = lds + ((tt) & (ATT_NS - 1)) * ATT_KSLOT; const LAS unsigned char* kb_ = Ks_ + hi * 1024 + r32 * 16; bf16x8 kf[10]; \
        _Pragma("unroll") for (int d0_ = 0; d0_ < 4; ++d0_) { kf[2 * d0_] = *(const LAS bf16x8*)(kb_ + d0_ * 2048); kf[2 * d0_ + 1] = *(const LAS bf16x8*)(kb_ + d0_ * 2048 + 512); } \
        if (MODE == 0) { const LAS unsigned char* kx_ = Ks_ + 8192 + r32 * 16; kf[8] = *(const LAS bf16x8*)(kx_); kf[9] = *(const LAS bf16x8*)(kx_ + 512); \
            asm volatile("s_waitcnt lgkmcnt(0)" : "+v"(kf[0]), "+v"(kf[1]), "+v"(kf[2]), "+v"(kf[3]), "+v"(kf[4]), "+v"(kf[5]), "+v"(kf[6]), "+v"(kf[7]), "+v"(kf[8]), "+v"(kf[9]) :: "memory"); } \
        else asm volatile("s_waitcnt lgkmcnt(0)" : "+v"(kf[0]), "+v"(kf[1]), "+v"(kf[2]), "+v"(kf[3]), "+v"(kf[4]), "+v"(kf[5]), "+v"(kf[6]), "+v"(kf[7]) :: "memory"); \
        p0 = __builtin_amdgcn_mfma_f32_32x32x16_bf16(kf[0], qr[0], negm, 0, 0, 0); \
        p1 = __builtin_amdgcn_mfma_f32_32x32x16_bf16(kf[1], qr[0], negm, 0, 0, 0); \
        _Pragma("unroll") for (int d0_ = 1; d0_ < 4; ++d0_) { \
            p0 = __builtin_amdgcn_mfma_f32_32x32x16_bf16(kf[2 * d0_], qr[d0_], p0, 0, 0, 0); \
            p1 = __builtin_amdgcn_mfma_f32_32x32x16_bf16(kf[2 * d0_ + 1], qr[d0_], p1, 0, 0, 0); } \
        if (MODE == 0) { p0 = __builtin_amdgcn_mfma_f32_32x32x16_bf16(kf[8], qr[4], p0, 0, 0, 0); p1 = __builtin_amdgcn_mfma_f32_32x32x16_bf16(kf[9], qr[4], p1, 0, 0, 0); } \
        asm volatile("s_nop 15\n\ts_nop 7" : "+v"(p0), "+v"(p1)); } while (0)
#define ATT_WAIT_TILES(n2, n3) do { if (MODE == 0 && wid == 0) asm volatile("s_waitcnt vmcnt(" #n3 ") lgkmcnt(0)" ::: "memory"); else asm volatile("s_waitcnt vmcnt(" #n2 ") lgkmcnt(0)" ::: "memory"); \
        __builtin_amdgcn_s_barrier(); asm volatile("" ::: "memory"); } while (0)
    ATT_ISSUE(t_lo); ATT_ISSUE(t_lo + 1); ATT_ISSUE(t_lo + 2);
    bf16x8 qr[5];
#pragma unroll
    for (int d0 = 0; d0 < 4; ++d0) qr[d0] = *(const bf16x8*)(Qp + (long)qi * rs + d0 * 16 + hi * 8);
    { const short one = hi == 0 ? (short)0x3F80 : (short)0; qr[4] = (bf16x8){one, one, one, 0, 0, 0, 0, 0}; }
    asm volatile("s_waitcnt vmcnt(0)" : "+v"(qr[0]), "+v"(qr[1]), "+v"(qr[2]), "+v"(qr[3]) :: "memory");
    const bool stag = wid >= 4;
    f32x16 p0 = f32x16{}, p1 = f32x16{};
    ATT_WAIT_TILES(4, 6);
    if (stag && t_lo >= w_lo && t_lo < w_hi) ATT_QK(t_lo);
    for (int t = t_lo; t < t_hi; ++t) {
        ATT_WAIT_TILES(2, 3);
        ATT_ISSUE(t + 3);
        const bool a0 = (t >= w_lo && t < w_hi), a1 = (t + 1 >= w_lo && t + 1 < w_hi);
        if (!stag && a0) ATT_QK(t);
        if (a0) {
            const int kvb = 64 * t + 4 * hi;
            if (MODE == 0) {
                if (64 * t + 63 > qw0) {
#pragma unroll
                    for (int r = 0; r < 16; ++r) { const int kv = kvb + (r & 3) + 8 * (r >> 2); if (kv > qi) p0[r] = -INFINITY; if (kv + 32 > qi) p1[r] = -INFINITY; }
                }
            } else {
                if (64 * t + 63 > qw0 || 64 * t < qw0 + 31 - 128) {
#pragma unroll
                    for (int r = 0; r < 16; ++r) { const int dd = qi - (kvb + (r & 3) + 8 * (r >> 2)); if (dd < 0 || dd > 128) p0[r] = -INFINITY; if (dd - 32 < 0 || dd - 32 > 128) p1[r] = -INFINITY; }
                }
            }
            const float rm = rowmax_fast(p0, p1);
            const bool need = started ? (rm > THR) : (rm > -1.0e30f);
            bool resc = false;
            if (__any(need)) {
                const float dl = need ? rm : 0.f; mhat += dl;
#pragma unroll
                for (int r = 0; r < 16; ++r) { p0[r] -= dl; p1[r] -= dl; }
#pragma unroll
                for (int r = 0; r < 16; ++r) negm[r] = -mhat;
                const float f = (need && started) ? fexp2(-dl) : 1.0f; lrun *= f; started = started || need;
                if (hi == 0) wsf[r32] = f; resc = true;
            }
            float ps = 0.f;
#pragma unroll
            for (int r = 0; r < 16; ++r) { p0[r] = fexp2(p0[r]); p1[r] = fexp2(p1[r]); ps += p0[r] + p1[r]; }
            lrun += ps;
            if (resc) {
                asm volatile("s_waitcnt lgkmcnt(0)" ::: "memory");
#pragma unroll
                for (int g = 0; g < 4; ++g) { const f32x4 fv = *(const LAS f32x4*)(wsf + 8 * g + 4 * hi);
#pragma unroll
                    for (int k = 0; k < 4; ++k) { o[0][4 * g + k] *= fv[k]; o[1][4 * g + k] *= fv[k]; } }
            }
            u32x4 pw0, pw1, pw2, pw3;
            pw0 = (u32x4){cvt_pk_bf16(p0[0], p0[1]), cvt_pk_bf16(p0[2], p0[3]), cvt_pk_bf16(p0[4], p0[5]), cvt_pk_bf16(p0[6], p0[7])};
            pw1 = (u32x4){cvt_pk_bf16(p0[8], p0[9]), cvt_pk_bf16(p0[10], p0[11]), cvt_pk_bf16(p0[12], p0[13]), cvt_pk_bf16(p0[14], p0[15])};
            pw2 = (u32x4){cvt_pk_bf16(p1[0], p1[1]), cvt_pk_bf16(p1[2], p1[3]), cvt_pk_bf16(p1[4], p1[5]), cvt_pk_bf16(p1[6], p1[7])};
            pw3 = (u32x4){cvt_pk_bf16(p1[8], p1[9]), cvt_pk_bf16(p1[10], p1[11]), cvt_pk_bf16(p1[12], p1[13]), cvt_pk_bf16(p1[14], p1[15])};
            pv<2>(o, vb0 + (t & (ATT_NS - 1)) * 8192, __builtin_bit_cast(bf16x8, pw0), __builtin_bit_cast(bf16x8, pw1), __builtin_bit_cast(bf16x8, pw2), __builtin_bit_cast(bf16x8, pw3));
        }
        if (stag && a1) ATT_QK(t + 1);
    }
#undef ATT_ISSUE
#undef ATT_QK
#undef ATT_WAIT_TILES
    const float ltot = swap_add(lrun);
    if (hi == 0) { wsf[32 + r32] = ltot; if (MODE == 1) lsep[(long)qi * ls] = mhat + __builtin_amdgcn_logf(ltot); }
    asm volatile("s_waitcnt lgkmcnt(0)" ::: "memory");
    LAS bf16_t* stg = (LAS bf16_t*)(lds + ATT_OST) + wid * 2048;
#pragma unroll
    for (int g = 0; g < 4; ++g) { const f32x4 lv = *(const LAS f32x4*)(wsf + 32 + 8 * g + 4 * hi);
#pragma unroll
        for (int k = 0; k < 4; ++k) { const int r = 4 * g + k; const float rl = frcp(lv[k]); LAS bf16_t* srow = stg + crow(r, hi) * 64 + r32;
            srow[0] = (bf16_t)(cvt_pk_bf16(o[0][r] * rl, 0.f) & 0xffffu); srow[32] = (bf16_t)(cvt_pk_bf16(o[1][r] * rl, 0.f) & 0xffffu); } }
    asm volatile("s_waitcnt lgkmcnt(0)" ::: "memory");
#pragma unroll
    for (int i = 0; i < 4; ++i) { const int row = i * 8 + (lane >> 3), ch = lane & 7; const u32x4 v = *(const LAS u32x4*)(stg + row * 64 + ch * 8); *(u32x4*)(Op + (long)(qw0 + row) * os + ch * 8) = v; }
    ATT_WAITBAR();
}

__device__ __forceinline__ s16x4 vtr(const LAS unsigned char* p) { return __builtin_amdgcn_ds_read_tr16_b64_v4i16((LAS s16x4*)p); }
#define FX_MX3(a, b, c) __builtin_fmaxf(__builtin_fmaxf((a), (b)), (c))
__device__ __forceinline__ float rowmax_b(const f32x16& p0, const f32x16& p1) {
    float a = FX_MX3(p0[0], p0[1], p1[0]), b = FX_MX3(p0[2], p0[3], p1[1]); a = FX_MX3(a, p1[2], p1[3]);
#pragma unroll
    for (int r = 4; r < 16; r += 4) { a = FX_MX3(a, p0[r], p0[r + 1]); b = FX_MX3(b, p0[r + 2], p0[r + 3]); a = FX_MX3(a, p1[r], p1[r + 1]); b = FX_MX3(b, p1[r + 2], p1[r + 3]); }
    const float m = __builtin_fmaxf(a, b); auto rr = __builtin_amdgcn_permlane32_swap(__float_as_uint(m), __float_as_uint(m), false, false);
    return __builtin_fmaxf(__uint_as_float(rr[0]), __uint_as_float(rr[1])); }
__device__ __forceinline__ void fox_unit(LAS unsigned char* lds, LAS float* wsf_all, const bf16_t* Qp, const bf16_t* Kp, const bf16_t* Vp, const long rs,
                                         const int i0, const int t_lo, const int t_hi, const bf16_t* kbias, bf16_t* Op, const long os) {
    int tid = threadIdx.x; asm volatile("" : "+v"(tid));
    const int lane = tid & 63, r32 = lane & 31, hi = lane >> 5, wid = __builtin_amdgcn_readfirstlane(tid >> 6);
    LAS float* wsf = wsf_all + wid * 64;
    const int qw0 = i0 + wid * 32, qi = qw0 + r32;
    constexpr float THR = 30.0f;
#define FX_SBAR() __builtin_amdgcn_sched_barrier(0)
#define FX_PIN(x) asm volatile("" : "+v"(x))
#define FX_MF(a, b, c) __builtin_amdgcn_mfma_f32_32x32x16_bf16(a, b, c, 0, 0, 0)
    float mhat = 0.f, lrun = 0.f; f32x16 o[2]; o[0] = f32x16{}; o[1] = f32x16{};
    const bf16_t* ksrc = Kp + (long)lane * rs + wid * 8;
    const bf16_t* vsrc = Vp + (long)(16 * (wid & 3) + (lane >> 2)) * rs + (wid >> 2) * 32 + (lane & 3) * 8;
    const LAS unsigned char* vp0 = lds + ATT_VOFF + ((lane >> 4) & 1) * 32 + (lane & 3) * 8 + (4 * hi + ((lane & 15) >> 2)) * 64;
    const LAS unsigned char* kp0 = lds + hi * 1024 + r32 * 16;
    const LAS unsigned char* kx0 = lds + 8192 + r32 * 16;
#define FX_DMA_K(tt) do { const int t_ = (tt) < t_hi ? (tt) : t_hi - 1; const int s_ = (tt) & (ATT_NS - 1); const unsigned l0_ = (unsigned)(uintptr_t)lds; \
        glds16(ksrc + (long)t_ * 64 * rs, (unsigned)__builtin_amdgcn_readfirstlane((int)(l0_ + s_ * ATT_KSLOT + wid * 1024))); \
        if (wid == 0) glds16(kbias + (long)(t_ * 64 + lane) * 64, (unsigned)__builtin_amdgcn_readfirstlane((int)(l0_ + s_ * ATT_KSLOT + 8192))); } while (0)
#define FX_DMA_V(tt) do { const int t_ = (tt) < t_hi ? (tt) : t_hi - 1; const int s_ = (tt) & (ATT_NS - 1); const unsigned l0_ = (unsigned)(uintptr_t)lds; \
        glds16(vsrc + (long)t_ * 64 * rs, (unsigned)__builtin_amdgcn_readfirstlane((int)(l0_ + ATT_VOFF + s_ * 8192 + wid * 1024))); } while (0)
#define FX_WAIT_BAR() do { if (wid == 0) asm volatile("s_waitcnt vmcnt(4) lgkmcnt(0)\n\ts_barrier" ::: "memory"); else asm volatile("s_waitcnt vmcnt(3) lgkmcnt(0)\n\ts_barrier" ::: "memory"); } while (0)
#define FX_KLOAD2(kp_, d0) do { kf[2 * (d0)] = *(const LAS bf16x8*)((kp_) + (d0) * 2048); kf[2 * (d0) + 1] = *(const LAS bf16x8*)((kp_) + (d0) * 2048 + 512); } while (0)
#define FX_KLOADX(kx_) do { kf[8] = *(const LAS bf16x8*)(kx_); kf[9] = *(const LAS bf16x8*)((kx_) + 512); } while (0)
#define FX_MASK(C0, C1, tt) do { if (64 * (tt) + 63 > qw0) { const int kvb_ = 64 * (tt) + 4 * hi; \
        _Pragma("unroll") for (int r = 0; r < 16; ++r) { const int kv = kvb_ + (r & 3) + 8 * (r >> 2); if (kv > qi) C0[r] = -INFINITY; if (kv + 32 > qi) C1[r] = -INFINITY; } } } while (0)
#define FX_SETREF() do { const float nm_ = -mhat; const unsigned h1_ = cvt_pk_bf16(nm_, 0.f) & 0xffffu; const float r1_ = nm_ - bf_lo(h1_); const unsigned h2_ = cvt_pk_bf16(r1_, 0.f) & 0xffffu; \
        const float r2_ = r1_ - bf_lo(h2_); const unsigned h3_ = cvt_pk_bf16(r2_, 0.f) & 0xffffu; \
        u32x4 q4_; q4_.x = q4d0; q4_.y = hi == 0 ? (0x3F80u | (h1_ << 16)) : 0u; q4_.z = hi == 0 ? (h2_ | (h3_ << 16)) : 0u; q4_.w = 0u; qr[4] = __builtin_bit_cast(bf16x8, q4_); } while (0)
    FX_DMA_K(t_lo); FX_DMA_K(t_lo + 1); FX_DMA_V(t_lo); FX_DMA_K(t_lo + 2); FX_DMA_V(t_lo + 1); FX_DMA_K(t_lo + 3); FX_DMA_V(t_lo + 2);
    bf16x8 qr[5];
#pragma unroll
    for (int d0 = 0; d0 < 4; ++d0) qr[d0] = *(const bf16x8*)(Qp + (long)qi * rs + d0 * 16 + hi * 8);
    unsigned q4d0 = hi == 0 ? 0x3F803F80u : 0u; asm volatile("" : "+v"(q4d0));
    { u32x4 q4_; q4_.x = q4d0; q4_.y = hi == 0 ? 0x3F80u : 0u; q4_.z = 0u; q4_.w = 0u; qr[4] = __builtin_bit_cast(bf16x8, q4_); }
    asm volatile("s_waitcnt vmcnt(0)" : "+v"(qr[0]), "+v"(qr[1]), "+v"(qr[2]), "+v"(qr[3]) :: "memory");
    asm volatile("s_barrier" ::: "memory");
    f32x16 pA0, pA1, pB0, pB1; bf16x8 kf[10]; s16x4 vlo[8], vhi[8]; u32x4 pw0, pw1, pw2, pw3; bool resc = false;
    { const LAS unsigned char* kp_ = kp0 + (t_lo & (ATT_NS - 1)) * ATT_KSLOT;
      FX_KLOAD2(kp_, 0); FX_KLOAD2(kp_, 1); FX_KLOAD2(kp_, 2); FX_KLOAD2(kp_, 3); FX_KLOADX(kx0 + (t_lo & (ATT_NS - 1)) * ATT_KSLOT); }
    pA0 = FX_MF(kf[8], qr[4], (f32x16){}); pA1 = FX_MF(kf[9], qr[4], (f32x16){});
#pragma unroll
    for (int d0 = 0; d0 < 4; ++d0) { pA0 = FX_MF(kf[2 * d0], qr[d0], pA0); pA1 = FX_MF(kf[2 * d0 + 1], qr[d0], pA1); }
    FX_MASK(pA0, pA1, t_lo);
    { const float rm = rowmax_b(pA0, pA1); mhat = rm;
#pragma unroll
      for (int r = 0; r < 16; ++r) { pA0[r] = fexp2(pA0[r] - rm); pA1[r] = fexp2(pA1[r] - rm); }
      FX_SETREF(); }
    { const LAS unsigned char* kp_ = kp0 + ((t_lo + 1) & (ATT_NS - 1)) * ATT_KSLOT;
      FX_KLOAD2(kp_, 0); FX_KLOAD2(kp_, 1); FX_KLOAD2(kp_, 2); FX_KLOAD2(kp_, 3); FX_KLOADX(kx0 + ((t_lo + 1) & (ATT_NS - 1)) * ATT_KSLOT); }
    asm volatile("s_waitcnt lgkmcnt(0)\n\ts_barrier" ::: "memory");
#define FX_PKW(P, i) cvt_pk_bf16(P[i], P[(i) + 1])
#define FX_PAF(k) __builtin_bit_cast(bf16x8, pw##k)
#define FX_VFR(i) (bf16x8){vlo[i][0], vlo[i][1], vlo[i][2], vlo[i][3], vhi[i][0], vhi[i][1], vhi[i][2], vhi[i][3]}
#define FX_VRD(i) do { vlo[i] = vtr(vp_ + (((i) >> 2) * 4096 + ((i) & 3) * 1024)); vhi[i] = vtr(vp_ + (((i) >> 2) * 4096 + ((i) & 3) * 1024 + 512)); } while (0)
#define FX_GAPA(MF, a0, a1, a2, W0, W1, PW) do { MF; sacc += a0; sacc += a1; sacc += a2; W0; W1; FX_PIN(PW); FX_PIN(sacc); FX_SBAR(); } while (0)
#define FX_GAPA3(MF, a0, a1, a2) do { MF; sacc += a0; sacc += a1; sacc += a2; FX_PIN(sacc); FX_SBAR(); } while (0)
#define FX_GAPB(MF, X, i) do { MF; X[i] = fexp2(X[i]); X[(i) + 1] = fexp2(X[(i) + 1]); X[(i) + 2] = fexp2(X[(i) + 2]); X[(i) + 3] = fexp2(X[(i) + 3]); FX_PIN(X); FX_SBAR(); } while (0)
#define FX_STEP(C0, C1, P0, P1, t, MASK) do { FX_SBAR(); \
    const LAS unsigned char* vp_ = vp0 + (((t) - 1) & (ATT_NS - 1)) * 8192; \
    FX_VRD(0); FX_SBAR(); float sacc = P0[0] + P0[1]; \
                       FX_GAPA(C0 = FX_MF(kf[8], qr[4], (f32x16){}), P0[2], P0[3], P0[4],    pw0[0] = FX_PKW(P0, 0),  pw0[1] = FX_PKW(P0, 2),  pw0); \
    FX_VRD(4); FX_SBAR(); FX_GAPA(C1 = FX_MF(kf[9], qr[4], (f32x16){}), P0[5], P0[6], P0[7],    pw0[2] = FX_PKW(P0, 4),  pw0[3] = FX_PKW(P0, 6),  pw0); \
    FX_VRD(1); FX_SBAR(); FX_GAPA(C0 = FX_MF(kf[0], qr[0], C0),   P0[8], P0[9], P0[10],   pw1[0] = FX_PKW(P0, 8),  pw1[1] = FX_PKW(P0, 10), pw1); \
    FX_VRD(5); FX_SBAR(); FX_GAPA(C1 = FX_MF(kf[1], qr[0], C1),   P0[11], P0[12], P0[13], pw1[2] = FX_PKW(P0, 12), pw1[3] = FX_PKW(P0, 14), pw1); \
    FX_VRD(2); FX_SBAR(); FX_GAPA(C0 = FX_MF(kf[2], qr[1], C0),   P0[14], P0[15], P1[0],  pw2[0] = FX_PKW(P1, 0),  pw2[1] = FX_PKW(P1, 2),  pw2); \
    FX_VRD(6); FX_SBAR(); FX_GAPA(C1 = FX_MF(kf[3], qr[1], C1),   P1[1], P1[2], P1[3],    pw2[2] = FX_PKW(P1, 4),  pw2[3] = FX_PKW(P1, 6),  pw2); \
    FX_VRD(3); FX_SBAR(); FX_GAPA(C0 = FX_MF(kf[4], qr[2], C0),   P1[4], P1[5], P1[6],    pw3[0] = FX_PKW(P1, 8),  pw3[1] = FX_PKW(P1, 10), pw3); \
    FX_VRD(7); FX_SBAR(); FX_GAPA(C1 = FX_MF(kf[5], qr[2], C1),   P1[7], P1[8], P1[9],    pw3[2] = FX_PKW(P1, 12), pw3[3] = FX_PKW(P1, 14), pw3); \
    FX_GAPA3(C0 = FX_MF(kf[6], qr[3], C0), P1[10], P1[11], P1[12]); \
    FX_GAPA3(C1 = FX_MF(kf[7], qr[3], C1), P1[13], P1[14], P1[15]); \
    lrun += sacc; \
    FX_DMA_K((t) + 3); FX_DMA_V((t) + 2);                                  \
    if (MASK) FX_MASK(C0, C1, t); \
    { const float rm = rowmax_b(C0, C1); resc = false;                     \
      if (__builtin_expect(__any(rm > THR), 0)) { const float dl = __builtin_fmaxf(rm, 0.f); mhat += dl;        \
          _Pragma("unroll") for (int r = 0; r < 16; ++r) { C0[r] -= dl; C1[r] -= dl; } \
          FX_SETREF(); \
          const float f = fexp2(-dl); lrun *= f; if (hi == 0) wsf[r32] = f; resc = true; } } \
    FX_SBAR(); \
    const LAS unsigned char* kp_ = kp0 + (((t) + 1) & (ATT_NS - 1)) * ATT_KSLOT; \
    FX_GAPB(o[0] = FX_MF(FX_PAF(0), FX_VFR(0), o[0]), C0, 0);                              FX_GAPB(o[1] = FX_MF(FX_PAF(0), FX_VFR(4), o[1]), C0, 4); \
    FX_KLOAD2(kp_, 0); FX_SBAR(); FX_GAPB(o[0] = FX_MF(FX_PAF(1), FX_VFR(1), o[0]), C0, 8);   FX_KLOAD2(kp_, 1); FX_SBAR(); FX_GAPB(o[1] = FX_MF(FX_PAF(1), FX_VFR(5), o[1]), C0, 12); \
    FX_KLOAD2(kp_, 2); FX_SBAR(); FX_GAPB(o[0] = FX_MF(FX_PAF(2), FX_VFR(2), o[0]), C1, 0);   FX_KLOAD2(kp_, 3); FX_SBAR(); FX_GAPB(o[1] = FX_MF(FX_PAF(2), FX_VFR(6), o[1]), C1, 4); \
    FX_KLOADX(kx0 + (((t) + 1) & (ATT_NS - 1)) * ATT_KSLOT); FX_SBAR(); FX_GAPB(o[0] = FX_MF(FX_PAF(3), FX_VFR(3), o[0]), C1, 8);   FX_GAPB(o[1] = FX_MF(FX_PAF(3), FX_VFR(7), o[1]), C1, 12); \
    FX_WAIT_BAR(); \
    if (resc) { _Pragma("unroll") for (int g = 0; g < 4; ++g) { const f32x4 fv = *(const LAS f32x4*)(wsf + 8 * g + 4 * hi); \
        _Pragma("unroll") for (int k = 0; k < 4; ++k) { o[0][4 * g + k] *= fv[k]; o[1][4 * g + k] *= fv[k]; } } } \
    } while (0)
#define FX_DRAIN(P0, P1) do { float sacc = P0[0] + P0[1]; \
      _Pragma("unroll") for (int r = 2; r < 16; ++r) sacc += P0[r]; \
      _Pragma("unroll") for (int r = 0; r < 16; ++r) sacc += P1[r]; \
      lrun += sacc; \
      pw0 = (u32x4){FX_PKW(P0, 0), FX_PKW(P0, 2), FX_PKW(P0, 4), FX_PKW(P0, 6)}; pw1 = (u32x4){FX_PKW(P0, 8), FX_PKW(P0, 10), FX_PKW(P0, 12), FX_PKW(P0, 14)}; \
      pw2 = (u32x4){FX_PKW(P1, 0), FX_PKW(P1, 2), FX_PKW(P1, 4), FX_PKW(P1, 6)}; pw3 = (u32x4){FX_PKW(P1, 8), FX_PKW(P1, 10), FX_PKW(P1, 12), FX_PKW(P1, 14)}; \
      const LAS unsigned char* vp_ = vp0 + ((t_hi - 1) & (ATT_NS - 1)) * 8192; _Pragma("unroll") for (int i = 0; i < 8; ++i) FX_VRD(i); \
      o[0] = FX_MF(FX_PAF(0), FX_VFR(0), o[0]); o[1] = FX_MF(FX_PAF(0), FX_VFR(4), o[1]); o[0] = FX_MF(FX_PAF(1), FX_VFR(1), o[0]); o[1] = FX_MF(FX_PAF(1), FX_VFR(5), o[1]); \
      o[0] = FX_MF(FX_PAF(2), FX_VFR(2), o[0]); o[1] = FX_MF(FX_PAF(2), FX_VFR(6), o[1]); o[0] = FX_MF(FX_PAF(3), FX_VFR(3), o[0]); o[1] = FX_MF(FX_PAF(3), FX_VFR(7), o[1]); } while (0)
    int t = t_lo + 1; const int t_band = t_hi - 4;
    for (; t + 1 < t_band; t += 2) {
        FX_STEP(pB0, pB1, pA0, pA1, t, false);
        FX_STEP(pA0, pA1, pB0, pB1, t + 1, false);
    }
    for (; t + 1 < t_hi; t += 2) {
        FX_STEP(pB0, pB1, pA0, pA1, t, true);
        FX_STEP(pA0, pA1, pB0, pB1, t + 1, true);
    }
    if (t < t_hi) { FX_STEP(pB0, pB1, pA0, pA1, t, true); FX_DRAIN(pB0, pB1); } else FX_DRAIN(pA0, pA1);
    const float ltot = swap_add(lrun);
    if (hi == 0) wsf[32 + r32] = ltot;
    asm volatile("s_waitcnt lgkmcnt(0)" ::: "memory");
    LAS bf16_t* stg = (LAS bf16_t*)(lds + ATT_OST) + wid * 2048;
#pragma unroll
    for (int g = 0; g < 4; ++g) { const f32x4 lv = *(const LAS f32x4*)(wsf + 32 + 8 * g + 4 * hi);
#pragma unroll
        for (int k = 0; k < 4; ++k) { const int r = 4 * g + k; const float rl = frcp(lv[k]); LAS bf16_t* srow = stg + crow(r, hi) * 64 + r32;
            srow[0] = (bf16_t)(cvt_pk_bf16(o[0][r] * rl, 0.f) & 0xffffu); srow[32] = (bf16_t)(cvt_pk_bf16(o[1][r] * rl, 0.f) & 0xffffu); } }
    asm volatile("s_waitcnt lgkmcnt(0)" ::: "memory");
#pragma unroll
    for (int i = 0; i < 4; ++i) { const int row = i * 8 + (lane >> 3), ch = lane & 7; const u32x4 v = *(const LAS u32x4*)(stg + row * 64 + ch * 8); *(u32x4*)(Op + (long)(qw0 + row) * os + ch * 8) = v; }
    ATT_WAITBAR();
#undef FX_SBAR
#undef FX_SETREF
#undef FX_PIN
#undef FX_MF
#undef FX_DMA_K
#undef FX_DMA_V
#undef FX_WAIT_BAR
#undef FX_KLOAD2
#undef FX_KLOADX
#undef FX_MASK
#undef FX_PKW
#undef FX_PAF
#undef FX_VFR
#undef FX_VRD
#undef FX_GAPA
#undef FX_GAPA3
#undef FX_GAPB
#undef FX_STEP
#undef FX_DRAIN
}

template <bool ISO>
__device__ __forceinline__ void dil_sweep(LAS unsigned char* lds, LAS float* wsf_all, const bf16_t* Qp, const bf16_t* Kp, const bf16_t* Vp, const long rs, const int B0, const int NB,
                                          bf16_t* Op, const long os, float* lsep, const long ls, const long bst, const long obst, const long lbst) {
    int tid = threadIdx.x; asm volatile("" : "+v"(tid));
    const int lane = tid & 63, r32 = lane & 31, hi = lane >> 5, wid = __builtin_amdgcn_readfirstlane(tid >> 6);
    LAS float* wsf = wsf_all + wid * 64;
    const int NT = 4 * (B0 + NB), T0 = ISO ? 4 * B0 : (B0 > 0 ? 4 * B0 - 2 : 0), wh = wid >> 1;
    constexpr float THR = 30.0f;
    float mhat = 0.f, lrun = 0.f; bool started = false; f32x16 o[2]; o[0] = f32x16{}; o[1] = f32x16{};
    f32x16 negm = f32x16{};
    const bf16_t* ksrc = Kp + (long)lane * rs + wid * 8;
    const bf16_t* vsrc = Vp + (long)(16 * (wid & 3) + (lane >> 2)) * rs + (wid >> 2) * 32 + (lane & 3) * 8;
    const LAS unsigned char* vp0 = lds + ATT_VOFF + ((lane >> 4) & 1) * 32 + (lane & 3) * 8 + (4 * hi + ((lane & 15) >> 2)) * 64;
    LAS bf16_t* stg = (LAS bf16_t*)(lds + ATT_OST) + wid * 2048;
#define DS_ISSUE(tt) do { const int t_ = (tt) < NT ? (tt) : NT - 1; const int s_ = (tt) & (ATT_NS - 1); const unsigned l0_ = (unsigned)(uintptr_t)lds; \
        const long to_ = ISO ? (long)(t_ >> 2) * bst + (long)(t_ & 3) * 64 * rs : (long)t_ * 64 * rs; \
        glds16(ksrc + to_, (unsigned)__builtin_amdgcn_readfirstlane((int)(l0_ + s_ * ATT_KSLOT + wid * 1024))); \
        glds16(vsrc + to_, (unsigned)__builtin_amdgcn_readfirstlane((int)(l0_ + ATT_VOFF + s_ * 8192 + wid * 1024))); } while (0)
#define DS_QDMA(bq) do { const unsigned sb_ = (unsigned)(uintptr_t)stg; \
        _Pragma("unroll") for (int i_ = 0; i_ < 4; ++i_) glds16(Qp + (ISO ? (long)(bq) * bst : (long)256 * (bq) * rs) + (long)(32 * wid + 8 * i_ + (lane >> 3)) * rs + (lane & 7) * 8, (unsigned)__builtin_amdgcn_readfirstlane((int)(sb_ + i_ * 1024))); } while (0)
#define DS_WAITBAR(n) do { asm volatile("s_waitcnt vmcnt(" #n ") lgkmcnt(0)" ::: "memory"); __builtin_amdgcn_s_barrier(); asm volatile("" ::: "memory"); } while (0)
    DS_ISSUE(T0); DS_ISSUE(T0 + 1); DS_ISSUE(T0 + 2); DS_QDMA(B0);
    DS_WAITBAR(0);
    bf16x8 qr[4]; f32x16 p0 = f32x16{}, p1 = f32x16{};
#pragma unroll
    for (int d0 = 0; d0 < 4; ++d0) qr[d0] = bf16x8{};
    for (int t = T0; t <= NT; ++t) {
        const int u = t - 4 * B0 - wh + 2, rel = u & 3, blk = B0 + (u >> 2);
        const bool act = (u >= 0) && (rel != 3) && (blk < B0 + NB) && (!ISO || t >= 4 * blk);
        if (rel == 0) DS_WAITBAR(2); else DS_WAITBAR(4);
        if (rel == 3 && u > 0 && blk < B0 + NB) {
            const int qw0 = (ISO ? 0 : 256 * blk) + 32 * wid, qi = qw0 + r32;
            bf16_t* Ob_ = Op + (ISO ? (long)blk * obst : 0L); float* lb_ = lsep + (ISO ? (long)blk * lbst : 0L);
            const float ltot = swap_add(lrun);
            if (hi == 0) { wsf[32 + r32] = ltot; lb_[(long)qi * ls] = mhat + __builtin_amdgcn_logf(ltot); }
            asm volatile("s_waitcnt lgkmcnt(0)" ::: "memory");
#pragma unroll
            for (int g = 0; g < 4; ++g) { const f32x4 lv = *(const LAS f32x4*)(wsf + 32 + 8 * g + 4 * hi);
#pragma unroll
                for (int k = 0; k < 4; ++k) { const int r = 4 * g + k; const float rl = frcp(lv[k]); LAS bf16_t* srow = stg + crow(r, hi) * 64 + r32;
                    srow[0] = (bf16_t)(cvt_pk_bf16(o[0][r] * rl, 0.f) & 0xffffu); srow[32] = (bf16_t)(cvt_pk_bf16(o[1][r] * rl, 0.f) & 0xffffu); } }
            asm volatile("s_waitcnt lgkmcnt(0)" ::: "memory");
#pragma unroll
            for (int i = 0; i < 4; ++i) { const int row = i * 8 + (lane >> 3), ch = lane & 7; const u32x4 v = *(const LAS u32x4*)(stg + row * 64 + ch * 8); *(u32x4*)(Ob_ + (long)(qw0 + row) * os + ch * 8) = v; }
            if (blk + 1 < B0 + NB) DS_QDMA(blk + 1);
        }
        DS_ISSUE(t + 3);
        if (act) {
            const int qw0 = (ISO ? 0 : 256 * blk) + 32 * wid, qi = qw0 + r32, tk = ISO ? t - 4 * blk : t;
            if (ISO ? (t == 4 * blk + (wh > 2 ? wh - 2 : 0)) : (rel == 0 || t == 0)) {
#pragma unroll
                for (int d0 = 0; d0 < 4; ++d0) qr[d0] = *(const LAS bf16x8*)((const LAS unsigned char*)stg + r32 * 128 + d0 * 32 + hi * 16);
                asm volatile("s_waitcnt lgkmcnt(0)" : "+v"(qr[0]), "+v"(qr[1]), "+v"(qr[2]), "+v"(qr[3]) :: "memory");
                o[0] = f32x16{}; o[1] = f32x16{}; negm = f32x16{}; mhat = 0.f; lrun = 0.f; started = false;
            }
            { const LAS unsigned char* Ks_ = lds + (t & (ATT_NS - 1)) * ATT_KSLOT; const LAS unsigned char* kb_ = Ks_ + hi * 1024 + r32 * 16; bf16x8 kf[8];
#pragma unroll
              for (int d0_ = 0; d0_ < 4; ++d0_) { kf[2 * d0_] = *(const LAS bf16x8*)(kb_ + d0_ * 2048); kf[2 * d0_ + 1] = *(const LAS bf16x8*)(kb_ + d0_ * 2048 + 512); }
              asm volatile("s_waitcnt lgkmcnt(0)" : "+v"(kf[0]), "+v"(kf[1]), "+v"(kf[2]), "+v"(kf[3]), "+v"(kf[4]), "+v"(kf[5]), "+v"(kf[6]), "+v"(kf[7]) :: "memory");
              p0 = __builtin_amdgcn_mfma_f32_32x32x16_bf16(kf[0], qr[0], negm, 0, 0, 0);
              p1 = __builtin_amdgcn_mfma_f32_32x32x16_bf16(kf[1], qr[0], negm, 0, 0, 0);
#pragma unroll
              for (int d0_ = 1; d0_ < 4; ++d0_) {
                  p0 = __builtin_amdgcn_mfma_f32_32x32x16_bf16(kf[2 * d0_], qr[d0_], p0, 0, 0, 0);
                  p1 = __builtin_amdgcn_mfma_f32_32x32x16_bf16(kf[2 * d0_ + 1], qr[d0_], p1, 0, 0, 0); }
              asm volatile("s_nop 15\n\ts_nop 7" : "+v"(p0), "+v"(p1)); }
            s16x4 vlo[8], vhi[8];
            { const LAS unsigned char* vp_ = vp0 + (t & (ATT_NS - 1)) * 8192;
#pragma unroll
              for (int i = 0; i < 8; ++i) { vlo[i] = vtr(vp_ + ((i >> 2) * 4096 + (i & 3) * 1024)); vhi[i] = vtr(vp_ + ((i >> 2) * 4096 + (i & 3) * 1024 + 512)); } }
            __builtin_amdgcn_sched_barrier(0);
            if (64 * tk + 63 > qw0 || 64 * tk < qw0 + 31 - 128) { const int kvb = 64 * tk + 4 * hi;
#pragma unroll
                for (int r = 0; r < 16; ++r) { const int dd = qi - (kvb + (r & 3) + 8 * (r >> 2)); if (dd < 0 || dd > 128) p0[r] = -INFINITY; if (dd - 32 < 0 || dd - 32 > 128) p1[r] = -INFINITY; }
            }
            const float rm = rowmax_fast(p0, p1);
            const bool need = started ? (rm > THR) : (rm > -1.0e30f);
            bool resc = false;
            if (__any(need)) {
                const float dl = need ? rm : 0.f; mhat += dl;
#pragma unroll
                for (int r = 0; r < 16; ++r) { p0[r] -= dl; p1[r] -= dl; }
#pragma unroll
                for (int r = 0; r < 16; ++r) negm[r] = -mhat;
                const float f = (need && started) ? fexp2(-dl) : 1.0f; lrun *= f; started = started || need;
                if (hi == 0) wsf[r32] = f; resc = true;
            }
#pragma unroll
            for (int r = 0; r < 16; ++r) { p0[r] = fexp2(p0[r]); p1[r] = fexp2(p1[r]); }
            if (resc) {
                asm volatile("s_waitcnt lgkmcnt(0)" ::: "memory");
#pragma unroll
                for (int g = 0; g < 4; ++g) { const f32x4 fv = *(const LAS f32x4*)(wsf + 8 * g + 4 * hi);
#pragma unroll
                    for (int k = 0; k < 4; ++k) { o[0][4 * g + k] *= fv[k]; o[1][4 * g + k] *= fv[k]; } }
            }
            u32x4 pw0, pw1, pw2, pw3;
            pw0 = (u32x4){cvt_pk_bf16(p0[0], p0[1]), cvt_pk_bf16(p0[2], p0[3]), cvt_pk_bf16(p0[4], p0[5]), cvt_pk_bf16(p0[6], p0[7])};
            pw1 = (u32x4){cvt_pk_bf16(p0[8], p0[9]), cvt_pk_bf16(p0[10], p0[11]), cvt_pk_bf16(p0[12], p0[13]), cvt_pk_bf16(p0[14], p0[15])};
            pw2 = (u32x4){cvt_pk_bf16(p1[0], p1[1]), cvt_pk_bf16(p1[2], p1[3]), cvt_pk_bf16(p1[4], p1[5]), cvt_pk_bf16(p1[6], p1[7])};
            pw3 = (u32x4){cvt_pk_bf16(p1[8], p1[9]), cvt_pk_bf16(p1[10], p1[11]), cvt_pk_bf16(p1[12], p1[13]), cvt_pk_bf16(p1[14], p1[15])};
#define DS_VF(i) (bf16x8){vlo[i][0], vlo[i][1], vlo[i][2], vlo[i][3], vhi[i][0], vhi[i][1], vhi[i][2], vhi[i][3]}
#define DS_GP(d, PW, i, P, r0) do { o[d] = __builtin_amdgcn_mfma_f32_32x32x16_bf16(__builtin_bit_cast(bf16x8, PW), DS_VF(i), o[d], 0, 0, 0); \
        ps += P[r0]; ps += P[(r0) + 1]; ps += P[(r0) + 2]; ps += P[(r0) + 3]; asm volatile("" : "+v"(ps)); __builtin_amdgcn_sched_barrier(0); } while (0)
            { float ps = 0.f; __builtin_amdgcn_sched_barrier(0);
              DS_GP(0, pw0, 0, p0, 0); DS_GP(1, pw0, 4, p0, 4); DS_GP(0, pw1, 1, p0, 8); DS_GP(1, pw1, 5, p0, 12);
              DS_GP(0, pw2, 2, p1, 0); DS_GP(1, pw2, 6, p1, 4); DS_GP(0, pw3, 3, p1, 8); DS_GP(1, pw3, 7, p1, 12);
              lrun += ps; }
#undef DS_VF
#undef DS_GP
        }
    }
    ATT_WAITBAR();
#undef DS_ISSUE
#undef DS_QDMA
#undef DS_WAITBAR
}

__device__ __forceinline__ void xattn_unit(LAS unsigned char* lds, LAS float* wsf_all, const bf16_t* Qp, const bf16_t* Kp, const bf16_t* Vp, bf16_t* Op) {
    int tid = threadIdx.x; asm volatile("" : "+v"(tid));
    const int lane = tid & 63, r32 = lane & 31, hi = lane >> 5, wid = __builtin_amdgcn_readfirstlane(tid >> 6);
    LAS float* wsf = wsf_all + wid * 64;
    const int qi = wid * 32 + r32;
#define XA_ISSUE(s_) do { const unsigned sl_ = (unsigned)(uintptr_t)lds + ((s_) & 3) * 32768; \
        if ((s_) < 4) { _Pragma("unroll") for (int i_ = 0; i_ < 4; ++i_) { const int c_ = wid + 8 * i_; \
            glds16(Kp + (long)((s_) * 64 + lane) * D + c_ * 8, (unsigned)__builtin_amdgcn_readfirstlane((int)(sl_ + c_ * 1024))); } } \
        else { _Pragma("unroll") for (int i_ = 0; i_ < 4; ++i_) { const int pi_ = wid + 8 * i_, db_ = pi_ >> 2, kg_ = pi_ & 3; \
            glds16(Vp + (long)(((s_) - 4) * 64 + 16 * kg_ + (lane >> 2)) * D + db_ * 32 + (lane & 3) * 8, (unsigned)__builtin_amdgcn_readfirstlane((int)(sl_ + pi_ * 1024))); } } } while (0)
#define XA_WAITBAR(n) do { asm volatile("s_waitcnt vmcnt(" #n ") lgkmcnt(0)" ::: "memory"); __builtin_amdgcn_s_barrier(); asm volatile("" ::: "memory"); } while (0)
    XA_ISSUE(0);
    bf16x8 qr[16];
#pragma unroll
    for (int d0 = 0; d0 < 16; ++d0) qr[d0] = *(const bf16x8*)(Qp + (long)qi * D + d0 * 16 + hi * 8);
    asm volatile("s_waitcnt vmcnt(0)" : "+v"(qr[0]), "+v"(qr[1]), "+v"(qr[2]), "+v"(qr[3]), "+v"(qr[4]), "+v"(qr[5]), "+v"(qr[6]), "+v"(qr[7]),
                 "+v"(qr[8]), "+v"(qr[9]), "+v"(qr[10]), "+v"(qr[11]), "+v"(qr[12]), "+v"(qr[13]), "+v"(qr[14]), "+v"(qr[15]) :: "memory");
    XA_ISSUE(1); XA_ISSUE(2); XA_ISSUE(3);
    __builtin_amdgcn_s_barrier(); asm volatile("" ::: "memory");
    f32x16 p[4][2];
#pragma unroll
    for (int s = 0; s < 4; ++s) {
        if (s > 0) { XA_WAITBAR(8);
                     XA_ISSUE(s + 3); }
        p[s][0] = f32x16{}; p[s][1] = f32x16{};
        qkt<16>(p[s][0], p[s][1], lds + (s & 3) * 32768, qr, r32, hi);
    }
    float a = NEG;
#pragma unroll
    for (int s = 0; s < 4; ++s)
#pragma unroll
        for (int r = 0; r < 16; ++r) a = fmaxf(a, fmaxf(p[s][0][r], p[s][1][r]));
    const float mx = swap_max(a);
    float ps = 0.f; u32x4 pw[4][4];
#pragma unroll
    for (int s = 0; s < 4; ++s) {
#pragma unroll
        for (int r = 0; r < 16; ++r) { p[s][0][r] = fexp2(p[s][0][r] - mx); p[s][1][r] = fexp2(p[s][1][r] - mx); ps += p[s][0][r] + p[s][1][r]; }
#pragma unroll
        for (int h2 = 0; h2 < 2; ++h2) {
            pw[s][2 * h2] = (u32x4){cvt_pk_bf16(p[s][h2][0], p[s][h2][1]), cvt_pk_bf16(p[s][h2][2], p[s][h2][3]), cvt_pk_bf16(p[s][h2][4], p[s][h2][5]), cvt_pk_bf16(p[s][h2][6], p[s][h2][7])};
            pw[s][2 * h2 + 1] = (u32x4){cvt_pk_bf16(p[s][h2][8], p[s][h2][9]), cvt_pk_bf16(p[s][h2][10], p[s][h2][11]), cvt_pk_bf16(p[s][h2][12], p[s][h2][13]), cvt_pk_bf16(p[s][h2][14], p[s][h2][15])}; }
    }
    const float ltot = swap_add(ps);
    f32x16 o[8];
#pragma unroll
    for (int d0 = 0; d0 < 8; ++d0) o[d0] = f32x16{};
    const unsigned vb0 = (unsigned)(uintptr_t)lds + ((lane >> 4) & 1) * 32 + (lane & 3) * 8 + (4 * hi + ((lane & 15) >> 2)) * 64;
#pragma unroll
    for (int s = 4; s < 8; ++s) {
        if (s < 6) XA_WAITBAR(8); else if (s == 6) XA_WAITBAR(4); else XA_WAITBAR(0);
        if (s == 4) XA_ISSUE(7);
        pv<8>(o, vb0 + (s & 3) * 32768, __builtin_bit_cast(bf16x8, pw[s - 4][0]), __builtin_bit_cast(bf16x8, pw[s - 4][1]), __builtin_bit_cast(bf16x8, pw[s - 4][2]), __builtin_bit_cast(bf16x8, pw[s - 4][3]));
    }
#undef XA_ISSUE
    if (hi == 0) wsf[32 + r32] = ltot;
    XA_WAITBAR(0);
#undef XA_WAITBAR
    LAS bf16_t* stg = (LAS bf16_t*)(lds + wid * 16384);
#pragma unroll
    for (int g = 0; g < 4; ++g) { const f32x4 lv = *(const LAS f32x4*)(wsf + 32 + 8 * g + 4 * hi);
#pragma unroll
        for (int k = 0; k < 4; ++k) { const int r = 4 * g + k; const float rl = frcp(lv[k]); LAS bf16_t* srow = stg + crow(r, hi) * 256 + r32;
#pragma unroll
            for (int d0 = 0; d0 < 8; ++d0) srow[d0 * 32] = (bf16_t)(cvt_pk_bf16(o[d0][r] * rl, 0.f) & 0xffffu); } }
    asm volatile("s_waitcnt lgkmcnt(0)" ::: "memory");
#pragma unroll
    for (int i = 0; i < 16; ++i) { const int row = i * 2 + (lane >> 5), ch = lane & 31; const u32x4 v = *(const LAS u32x4*)(stg + row * 256 + ch * 8); *(u32x4*)(Op + (long)(wid * 32 + row) * D + ch * 8) = v; }
    ATT_WAITBAR();
}
}

constexpr size_t MiB = 1u << 20;
constexpr size_t WS_CTL = 0, CTL_ZERO_BYTES = 1 * MiB;
constexpr size_t WS_ROPE = 1 * MiB;
constexpr size_t WS_FLOG = 3 * MiB;
constexpr size_t WS_CL = 4 * MiB;
constexpr size_t WS_LSE = 5 * MiB;
constexpr size_t WS_TOKE = 8 * MiB;
constexpr size_t WS_TOKW = WS_TOKE + 256 * 1024;
constexpr size_t WS_TOKP = WS_TOKW + 256 * 1024;
constexpr size_t WS_SLOC = 9 * MiB;
constexpr size_t WS_POW = 25 * MiB;
constexpr size_t WS_BBAR = 28 * MiB;
constexpr size_t WS_KMAT = 29 * MiB;
constexpr size_t WS_ONES = 33 * MiB, WS_ZEROS = 33 * MiB + 4096, WS_STATS = 33 * MiB + 65536;
constexpr size_t WS_XB = 34 * MiB;
constexpr size_t WS_WL = 98 * MiB;
constexpr size_t WL_WIN = 0, WL_WGLU = 13 * MiB, WL_WB = WL_WGLU + MiB / 2, WL_WOUT = WL_WB + 3 * MiB, WL_XQ = WL_WOUT + 2 * MiB, WL_XO = WL_XQ + 2 * MiB, WL_TF = WL_XO + 2 * MiB, WL_E = WL_TF + 20 * MiB;
constexpr size_t WS_FFNW = 148 * MiB;
constexpr size_t WS_UG = 214 * MiB;
constexpr size_t WS_QKV = 254 * MiB;
constexpr size_t WS_YS = 446 * MiB;
constexpr size_t WS_KBIAS = 606 * MiB;
constexpr size_t WS_ZH = 610 * MiB;
constexpr size_t WS_END = 674 * MiB;
static_assert(WL_E + 4 * MiB + MiB / 4 <= 50 * MiB, "WL map");
constexpr int CW_TMO = 0, CW_BAR = 4096, CW_CNT = 16384, CW_FILL = 16384 + 2048, CW_QUEUE = 16384 + 4096, CW_NORM = 32768;
constexpr int RING_BYTES = 131072, MISC_OFF = RING_BYTES, WSF_OFF = RING_BYTES + 512, LDS_BYTES = 147456;
constexpr int NWAVES = 8, PTR_OFF = RING_BYTES + 3072;
__device__ __forceinline__ const void* inptr(LAS unsigned char* lds, int k) { const unsigned long long v = ((volatile LAS unsigned long long*)(lds + PTR_OFF))[k];
    const unsigned lo = (unsigned)__builtin_amdgcn_readfirstlane((int)(unsigned)v), hi = (unsigned)__builtin_amdgcn_readfirstlane((int)(unsigned)(v >> 32)); return (const void*)(GAS const void*)(((unsigned long long)hi << 32) | lo); }

typedef GAS unsigned gu32;
#define RLX_AGENT __ATOMIC_RELAXED, __HIP_MEMORY_SCOPE_AGENT

#define XB_TMO      128
#define XB_XCNT(j)  (256  + 64 * (j))
#define XB_XSUB(j)  (1280 + 64 * (j))
#define XB_XGEN(j)  (2304 + 64 * (j))
#define XB_TOP      3328
#define XB_TOPGEN   3392
#define XCD_BAR_WORDS 3456
#define XB_SPIN_CAP (1u << 22)
__device__ __forceinline__ unsigned xb_ld(unsigned* p)              { return __hip_atomic_load(p, __ATOMIC_RELAXED, __HIP_MEMORY_SCOPE_AGENT); }
__device__ __forceinline__ unsigned xb_add(unsigned* p, unsigned v) { return __hip_atomic_fetch_add(p, v, __ATOMIC_RELAXED, __HIP_MEMORY_SCOPE_AGENT); }
__device__ __forceinline__ unsigned xb_xcc_id() { return (unsigned)__builtin_amdgcn_s_getreg((3 << 11) | 20) & 0xFu; }
#define XB_SPIN(cond, bar) do { unsigned _sp = 0; while (cond) { __builtin_amdgcn_s_sleep(1); \
    if ((++_sp & 255u) == 0u) { if (xb_ld(&(bar)[XB_TMO])) break; if (_sp > XB_SPIN_CAP) { atomicAdd(&(bar)[XB_TMO], 1u); break; } } } } while (0)
struct XcdBarrier { unsigned* bar; unsigned x; volatile LAS unsigned* st; };
__device__ __forceinline__ XcdBarrier xcd_barrier_post(unsigned* bar, volatile LAS unsigned* st) {
    XcdBarrier b; b.bar = bar; b.x = xb_xcc_id(); b.st = st;
    if (threadIdx.x == 0) (void)xb_add(&bar[XB_XCNT(b.x)], 1u);
    return b;
}
__device__ __forceinline__ void xcd_barrier_complete(unsigned* bar, unsigned x, unsigned& nloc, unsigned& nx) {
    const unsigned G = gridDim.x * gridDim.y * gridDim.z;
    unsigned sum, cnt, mine, sp = 0u;
    for (;;) {
        sum = 0u; cnt = 0u; mine = 0u;
#pragma unroll
        for (unsigned j = 0; j < 16; ++j) { const unsigned c = xb_ld(&bar[XB_XCNT(j)]); sum += c; cnt += (c > 0u) ? 1u : 0u; mine = (j == x) ? c : mine; }
        if (sum == G) break;
        __builtin_amdgcn_s_sleep(1);
        if ((++sp & 255u) == 0u) { if (xb_ld(&bar[XB_TMO])) break; if (sp > XB_SPIN_CAP) { atomicAdd(&bar[XB_TMO], 1u); break; } }
    }
    nloc = mine > 0u ? mine : 1u; nx = cnt > 0u ? cnt : 1u;
}
__device__ __forceinline__ void xcd_barrier(const XcdBarrier& b) {
    asm volatile("s_waitcnt vmcnt(0)" ::: "memory");
    __syncthreads();
    if (threadIdx.x == 0) {
        unsigned* bar = b.bar;
        __builtin_amdgcn_s_waitcnt(0);
        unsigned nloc = b.st[0], nx = b.st[1];
        if (nloc == 0u) { xcd_barrier_complete(bar, b.x, nloc, nx); b.st[0] = nloc; b.st[1] = nx; }
        const unsigned old = xb_add(&bar[XB_XSUB(b.x)], 1u);
        const unsigned gen = old / nloc;
        if (old + 1u == (gen + 1u) * nloc) {
            __builtin_amdgcn_fence(__ATOMIC_RELEASE, "agent");
            asm volatile("s_waitcnt vmcnt(0)" ::: "memory");
            const unsigned og = xb_add(&bar[XB_TOP], 1u);
            const unsigned tg = og / nx;
            if (og + 1u == (tg + 1u) * nx) xb_add(&bar[XB_TOPGEN], 1u);
            else XB_SPIN(xb_ld(&bar[XB_TOPGEN]) == tg, bar);
            __builtin_amdgcn_fence(__ATOMIC_ACQUIRE, "agent");
            xb_add(&bar[XB_XGEN(b.x)], 1u);
            asm volatile("s_waitcnt vmcnt(0)" ::: "memory");
        } else {
            XB_SPIN(xb_ld(&bar[XB_XGEN(b.x)]) == gen, bar);
            __builtin_amdgcn_fence(__ATOMIC_ACQUIRE, "agent");
            asm volatile("s_waitcnt vmcnt(0)" ::: "memory");
        }
    }
    __syncthreads();
}

__device__ __forceinline__ void conv_mat(int& rot, int gw, int NGW, LAS float* scr, int lane, const float* W, int K, int ldn, int nblk, int mode, bf16_t* WT, int dstrow0) {
    asm volatile("" : "+v"(lane));
    const int nitems = (K / 64) * nblk;
    int it = gw - rot; if (it < 0) it += NGW;
    rot += nitems % NGW; if (rot >= NGW) rot -= NGW;
    const int kr = lane >> 3, n4 = (lane & 7) * 4;
    f32x4 v[8];
#define CM_COL(it_) ((mode == 1 && 32 * ((it_) % nblk) >= 3584) ? 32 * ((it_) % nblk) + 8 : 32 * ((it_) % nblk))
    if (it < nitems) { const float* sp = W + (size_t)(64 * (it / nblk) + kr) * ldn + CM_COL(it) + n4;
#pragma unroll
        for (int i = 0; i < 8; ++i) v[i] = *(const f32x4*)(sp + (size_t)(8 * i) * ldn); }
    while (it < nitems) {
        const int kb = it / nblk, n0 = 32 * (it % nblk), k0 = 64 * kb;
        const int drow = (mode == 2) ? dstrow0 + 256 * (n0 >> 7) + (n0 & 127) : dstrow0 + n0;
#pragma unroll
        for (int i = 0; i < 8; ++i)
#pragma unroll
            for (int q = 0; q < 4; ++q) scr[(8 * i + kr) * 33 + n4 + q] = v[i][q];
        const int nx = it + NGW;
        if (nx < nitems) { const float* sp = W + (size_t)(64 * (nx / nblk) + kr) * ldn + CM_COL(nx) + n4;
#pragma unroll
            for (int i = 0; i < 8; ++i) v[i] = *(const f32x4*)(sp + (size_t)(8 * i) * ldn); }
        asm volatile("" ::: "memory");
        const int c = lane & 7;
#pragma unroll
        for (int j = 0; j < 4; ++j) { const int n = (lane >> 3) + 8 * j; const LAS float* sl = scr + (8 * c) * 33 + n;
            u32x4 o; o.x = cvt_pk_bf16(sl[0 * 33], sl[1 * 33]); o.y = cvt_pk_bf16(sl[2 * 33], sl[3 * 33]); o.z = cvt_pk_bf16(sl[4 * 33], sl[5 * 33]); o.w = cvt_pk_bf16(sl[6 * 33], sl[7 * 33]);
            *(u32x4*)(WT + (size_t)(drow + n) * K + k0 + 8 * c) = o; }
        asm volatile("s_waitcnt lgkmcnt(0)" ::: "memory");
        it = nx;
    }
#undef CM_COL
}
__device__ __forceinline__ void dsincos(double x, double& s, double& c) {
    const double q = __builtin_rint(x * 0.63661977236758134308);
    const double r = (x - q * 1.57079632679489655800) - q * 6.12323399573676603587e-17;
    const double r2 = r * r;
    double sp = 1.0 / 6227020800.0; sp = sp * r2 - 1.0 / 39916800.0; sp = sp * r2 + 1.0 / 362880.0; sp = sp * r2 - 1.0 / 5040.0; sp = sp * r2 + 1.0 / 120.0; sp = sp * r2 - 1.0 / 6.0; sp = sp * r2 + 1.0; sp = sp * r;
    double cp = -1.0 / 87178291200.0; cp = cp * r2 + 1.0 / 479001600.0; cp = cp * r2 - 1.0 / 3628800.0; cp = cp * r2 + 1.0 / 40320.0; cp = cp * r2 - 1.0 / 720.0; cp = cp * r2 + 1.0 / 24.0; cp = cp * r2 - 0.5; cp = cp * r2 + 1.0;
    const int qi = (int)((long long)q & 3);
    s = (qi == 0) ? sp : (qi == 1) ? cp : (qi == 2) ? -sp : -cp;
    c = (qi == 0) ? cp : (qi == 1) ? -sp : (qi == 2) ? -cp : sp;
}

template <int SRC, bool ROUTER, bool FLOG, bool WF32>
__device__ __forceinline__ void ln_pass(int gw, int NGW, int lane, unsigned short* ZH, float* OUT32, const float* xin, bf16_t* XB, float* ST, const float* gam, const float* bet, const float* gp, const float* bp,
                                        const bf16_t* Y2, const int* TOKP, const float* TOKW_in,
                                        const float* wrt, int wrt_ld, const float* brt, int* TOKE, float* TOKW, LAS unsigned* hist, float* FLOGo) {
    f32x4 g4[4], b4[4];
    if (SRC != 2) {
#pragma unroll
        for (int j = 0; j < 4; ++j) { g4[j] = *(const f32x4*)(gam + 4 * lane + 256 * j); b4[j] = *(const f32x4*)(bet + 4 * lane + 256 * j); }
    }
    f32x4 wq[16][2];
    if (ROUTER || FLOG) {
#pragma unroll
        for (int j = 0; j < 4; ++j)
#pragma unroll
            for (int k = 0; k < 4; ++k) { const float* wp = wrt + (size_t)(4 * lane + 256 * j + k) * wrt_ld; wq[4 * j + k][0] = *(const f32x4*)wp; wq[4 * j + k][1] = *(const f32x4*)(wp + 4); }
    }
    f32x4 xN[4]; u32x2 hN[4]; f32x2 stN; int p0N, p1N; float w0N, w1N; u32x2 yaC[4], ybC[4];
#define LN_LOAD1(r_) do { if (SRC == 2) { _Pragma("unroll") for (int j = 0; j < 4; ++j) xN[j] = *(const f32x4*)(xin + (size_t)(r_) * D + 4 * lane + 256 * j); } \
        else { _Pragma("unroll") for (int j = 0; j < 4; ++j) hN[j] = *(const u32x2*)(ZH + (size_t)(r_) * D + 4 * lane + 256 * j); \
            if (SRC == 1) { stN = *(const f32x2*)(ST + (size_t)(r_) * 2); p0N = TOKP[2 * (r_)]; p1N = TOKP[2 * (r_) + 1]; w0N = TOKW_in[2 * (r_)]; w1N = TOKW_in[2 * (r_) + 1]; } } } while (0)
#define LN_LOAD2() do { if (SRC == 1) { _Pragma("unroll") for (int j = 0; j < 4; ++j) { yaC[j] = *(const u32x2*)(Y2 + (size_t)p0N * D + 4 * lane + 256 * j); ybC[j] = *(const u32x2*)(Y2 + (size_t)p1N * D + 4 * lane + 256 * j); } } } while (0)
    LN_LOAD1(gw); LN_LOAD2();
    for (int row = gw; row < T; row += NGW) {
        f32x4 v[4]; u32x2 hC[4]; f32x2 stp; float w0, w1; u32x2 ya[4], yb[4];
        if (SRC == 1) { stp = stN; w0 = w0N; w1 = w1N; }
#pragma unroll
        for (int j = 0; j < 4; ++j) { if (SRC == 2) v[j] = xN[j]; else hC[j] = hN[j]; if (SRC == 1) { ya[j] = yaC[j]; yb[j] = ybC[j]; } }
        const int nrow = row + NGW < T ? row + NGW : row;
        LN_LOAD1(nrow);
        if (SRC == 2) {
            if (lane == 0) *(f32x2*)(ST + (size_t)row * 2) = (f32x2){0.f, 1.f};
        } else {
#pragma unroll
            for (int j = 0; j < 4; ++j) { const u32x2 hz = hC[j]; const f32x2 h0 = unpk_f16(hz.x), h1 = unpk_f16(hz.y); v[j] = (f32x4){h0.x, h0.y, h1.x, h1.y}; }
            if (SRC == 1) {
#pragma unroll
                for (int j = 0; j < 4; ++j) { const u32x2 a = ya[j], b = yb[j];
                    const f32x4 gq = *(const f32x4*)(gp + 4 * lane + 256 * j), bq = *(const f32x4*)(bp + 4 * lane + 256 * j);
                    const f32x4 xp = ((v[j] - stp.x) * stp.y) * gq + bq;
                    v[j] = xp * ALPHA + (f32x4){bf_lo(a.x), bf_hi(a.x), bf_lo(a.y), bf_hi(a.y)} * w0 + (f32x4){bf_lo(b.x), bf_hi(b.x), bf_lo(b.y), bf_hi(b.y)} * w1;
                    if (!WF32) { u32x2 hz; hz.x = cvt_pk_f16(v[j][0], v[j][1]); hz.y = cvt_pk_f16(v[j][2], v[j][3]); *(u32x2*)(ZH + (size_t)row * D + 4 * lane + 256 * j) = hz;
                        const f32x2 h0 = unpk_f16(hz.x), h1 = unpk_f16(hz.y); v[j] = (f32x4){h0.x, h0.y, h1.x, h1.y}; } }
            }
            float s = 0.f;
#pragma unroll
            for (int j = 0; j < 4; ++j) s += (v[j][0] + v[j][1]) + (v[j][2] + v[j][3]);
            const float mean = wave_sum(s) * (1.f / D); float s2 = 0.f;
#pragma unroll
            for (int j = 0; j < 4; ++j) { v[j] = v[j] - mean; s2 += (v[j][0] * v[j][0] + v[j][1] * v[j][1]) + (v[j][2] * v[j][2] + v[j][3] * v[j][3]); }
            const float rstd = __builtin_amdgcn_rsqf(wave_sum(s2) * (1.f / D) + LN_EPS);
            if (!WF32 && lane == 0) *(f32x2*)(ST + (size_t)row * 2) = (f32x2){mean, rstd};
#pragma unroll
            for (int j = 0; j < 4; ++j) v[j] = v[j] * rstd * g4[j] + b4[j];
        }
        LN_LOAD2();
#pragma unroll
        for (int j = 0; j < 4; ++j) { if (WF32) *(f32x4*)(OUT32 + (size_t)row * D + 4 * lane + 256 * j) = v[j];
            u32x2 o; o.x = cvt_pk_bf16(v[j][0], v[j][1]); o.y = cvt_pk_bf16(v[j][2], v[j][3]); *(u32x2*)(XB + (size_t)row * D + 4 * lane + 256 * j) = o; }
        if (ROUTER || FLOG) {
            f32x4 a0 = (f32x4){0.f, 0.f, 0.f, 0.f}, a1 = a0;
#pragma unroll
            for (int j = 0; j < 4; ++j)
#pragma unroll
                for (int k = 0; k < 4; ++k) { a0 += wq[4 * j + k][0] * v[j][k]; a1 += wq[4 * j + k][1] * v[j][k]; }
            float lg[8];
#pragma unroll
            for (int k = 0; k < 4; ++k) { lg[k] = wave_sum(a0[k]); lg[4 + k] = wave_sum(a1[k]); }
            if (FLOG) { if (lane == 0) { *(f32x4*)(FLOGo + (size_t)row * 8) = (f32x4){lg[0], lg[1], lg[2], lg[3]}; *(f32x4*)(FLOGo + (size_t)row * 8 + 4) = (f32x4){lg[4], lg[5], lg[6], lg[7]}; } }
            if (ROUTER) {
#pragma unroll
                for (int k = 0; k < 8; ++k) lg[k] += brt[k];
                int i1 = 0; float v1 = lg[0];
#pragma unroll
                for (int k = 1; k < 8; ++k) if (lg[k] > v1) { v1 = lg[k]; i1 = k; }
                int i2 = -1; float v2 = -3.0e38f;
#pragma unroll
                for (int k = 0; k < 8; ++k) if (k != i1 && lg[k] > v2) { v2 = lg[k]; i2 = k; }
                const float w2 = 1.0f / (1.0f + fexp2((v1 - v2) * LOG2E)), w1 = 1.0f - w2;
                if (lane == 0) { TOKE[2 * row] = i1; TOKE[2 * row + 1] = i2; TOKW[2 * row] = w1; TOKW[2 * row + 1] = w2;
                    __hip_atomic_fetch_add(hist + i1, 1u, __ATOMIC_RELAXED, __HIP_MEMORY_SCOPE_WORKGROUP); __hip_atomic_fetch_add(hist + i2, 1u, __ATOMIC_RELAXED, __HIP_MEMORY_SCOPE_WORKGROUP); }
            }
        }
    }
#undef LN_LOAD1
#undef LN_LOAD2
}

struct Args { const void* in[34]; float* out; unsigned char* ws; int ph_lo, ph_hi; };
constexpr int NPH_TOTAL = 2 + 2 * 13 + 2 * 14;

__global__ void __launch_bounds__(NWAVES * 64, 2) hybrid_fwd(Args args) {
    extern __shared__ __attribute__((aligned(16))) unsigned char lds_raw[];
    LAS unsigned char* lds = (LAS unsigned char*)lds_raw;
    volatile LAS unsigned* MISC = (volatile LAS unsigned*)(lds + MISC_OFF);
    LAS unsigned* hist = (LAS unsigned*)(lds + MISC_OFF + 64);
    LAS float* wsf_all = (LAS float*)(lds + WSF_OFF);
    const int G = gridDim.x; const int bx = blockIdx.x; const int vcu = (G % 8 == 0) ? (bx % 8) * (G / 8) + bx / 8 : bx;
    const int NGW = G * NWAVES, NGT = G * NWAVES * 64;
    unsigned char* ws = args.ws;
    unsigned* ctl = (unsigned*)(ws + WS_CTL);
    for (int u = threadIdx.x; u < (LDS_BYTES - MISC_OFF) / 4; u += NWAVES * 64) ((LAS unsigned*)(lds + MISC_OFF))[u] = 0u;
    __syncthreads();
    const int lo = args.ph_lo, hi = args.ph_hi;
    XcdBarrier bar; bar.bar = ctl + CW_BAR; bar.x = 0; bar.st = nullptr;
    if (hi - lo > 1) bar = xcd_barrier_post(ctl + CW_BAR, MISC + 8);
    int pid = 0;
#define PH_BEGIN if (pid >= lo && pid < hi) { int tid = threadIdx.x; asm volatile("" : "+v"(tid)); const int lane = tid & 63, wave = __builtin_amdgcn_readfirstlane(tid >> 6); \
        const int gw = vcu * NWAVES + wave, gt = vcu * (NWAVES * 64) + tid; LAS float* scr = (LAS float*)(lds + wave * 16384); int rot = 0; (void)rot; unsigned long long wsl_ = (unsigned long long)(uintptr_t)ws; asm volatile("" : "+s"(wsl_)); unsigned char* wsl = (unsigned char*)(GAS unsigned char*)wsl_; (void)lane; (void)gw; (void)gt; (void)scr;
#define PH_END } if (pid >= lo && pid + 1 < hi) xcd_barrier(bar); ++pid;
#define LOAD_TOFF() int toff[9]; { int acc_t = 0; _Pragma("unroll") for (int e = 0; e < 8; ++e) { toff[e] = acc_t; \
        const unsigned c = (unsigned)__builtin_amdgcn_readfirstlane((int)__hip_atomic_load(ctl + CW_CNT + (li2 * 8 + e) * 64, RLX_AGENT)); acc_t += (int)((c + 255u) >> 8); } toff[8] = acc_t; }
#define CONVERT_MIXER(LL) do { const int LL_ = (LL); \
            conv_mat(rot, gw, NGW, scr, lane, w_in + (size_t)LL_ * D * NIN, D, NIN, 208, 1, WIN_T, 0); \
            conv_mat(rot, gw, NGW, scr, lane, w_glu + (size_t)LL_ * 512 * 512, 512, 512, 16, 0, WGLU_T, 0); \
            for (int n = 0; n < 3; ++n) conv_mat(rot, gw, NGW, scr, lane, w_branch + ((size_t)LL_ * 3 + n) * 512 * D, 512, D, 32, 0, WB_T + (size_t)n * D * 512, 0); \
            conv_mat(rot, gw, NGW, scr, lane, w_mix_out + (size_t)LL_ * D * D, D, D, 32, 0, WOUT_T, 0); \
            conv_mat(rot, gw, NGW, scr, lane, w_xq + (size_t)LL_ * D * D, D, D, 32, 0, XQ_T, 0); \
            conv_mat(rot, gw, NGW, scr, lane, w_xo + (size_t)LL_ * D * D, D, D, 32, 0, XO_T, 0); \
    } while (0)
#define CONVERT_FFN(LL) do { const int LL_ = (LL); \
            if (!(LL_ & 1)) { \
                conv_mat(rot, gw, NGW, scr, lane, ffn_wg + (size_t)(LL_ >> 1) * D * DFF, D, DFF, 88, 2, FFN_GU, 0); \
                conv_mat(rot, gw, NGW, scr, lane, ffn_wu + (size_t)(LL_ >> 1) * D * DFF, D, DFF, 88, 2, FFN_GU, 128); \
                conv_mat(rot, gw, NGW, scr, lane, ffn_wd + (size_t)(LL_ >> 1) * DFF * D, DFF, D, 32, 0, FFN_D_DENSE, 0); \
            } else { \
                for (int e = 0; e < NEXP; ++e) { \
                    conv_mat(rot, gw, NGW, scr, lane, moe_wg + ((size_t)(LL_ >> 1) * NEXP + e) * D * DFFE, D, DFFE, 44, 2, FFN_GU + (size_t)e * 2 * DFFE * D, 0); \
                    conv_mat(rot, gw, NGW, scr, lane, moe_wu + ((size_t)(LL_ >> 1) * NEXP + e) * D * DFFE, D, DFFE, 44, 2, FFN_GU + (size_t)e * 2 * DFFE * D, 128); \
                    conv_mat(rot, gw, NGW, scr, lane, moe_wd + ((size_t)(LL_ >> 1) * NEXP + e) * DFFE * D, DFFE, D, 32, 0, FFN_D_MOE + (size_t)e * D * DFFE, 0); \
                } \
            } \
    } while (0)
#define SUBSYNC() do { asm volatile("s_waitcnt vmcnt(0) lgkmcnt(0)" ::: "memory"); __syncthreads(); } while (0)

    if (threadIdx.x < 34) ((LAS unsigned long long*)(lds + PTR_OFF))[threadIdx.x] = (unsigned long long)(uintptr_t)args.in[threadIdx.x];
    __syncthreads();
#define INP(k) ((const float*)inptr(lds, (k)))
#define x_in INP(0)
#define mem_in INP(1)
#define pos_in ((const int*)inptr(lds, 2))
#define w_in INP(3)
#define b_forget INP(4)
#define lam_re INP(5)
#define lam_im INP(6)
#define log_dt INP(7)
#define ssm_bre INP(8)
#define ssm_bim INP(9)
#define ssm_cre INP(10)
#define ssm_cim INP(11)
#define ssm_d INP(12)
#define w_glu INP(13)
#define w_branch INP(14)
#define w_mix_out INP(15)
#define ln_mix_g INP(16)
#define ln_mix_b INP(17)
#define w_xq INP(18)
#define w_xk INP(19)
#define w_xv INP(20)
#define w_xo INP(21)
#define ln_x_g INP(22)
#define ln_x_b INP(23)
#define ffn_wg INP(24)
#define ffn_wu INP(25)
#define ffn_wd INP(26)
#define moe_wr INP(27)
#define moe_br INP(28)
#define moe_wg INP(29)
#define moe_wu INP(30)
#define moe_wd INP(31)
#define ln_ffn_g INP(32)
#define ln_ffn_b INP(33)
    float* OUTF = args.out;
#define ZHP ((unsigned short*)(wsl + WS_ZH))
#define ROPE ((float*)(wsl + WS_ROPE))
#define FLOG ((float*)(wsl + WS_FLOG))
#define KBIAS ((bf16_t*)(wsl + WS_KBIAS))
#define LSE ((float*)(wsl + WS_LSE))
#define TOKE ((int*)(wsl + WS_TOKE))
#define TOKW ((float*)(wsl + WS_TOKW))
#define TOKP ((int*)(wsl + WS_TOKP))
#define INV16 ((unsigned short*)(wsl + WS_TOKP + 256 * 1024))
#define SLOC ((float*)(wsl + WS_SLOC))
#define POW ((f32x2*)(wsl + WS_POW))
#define BBAR ((f32x2*)(wsl + WS_BBAR))
#define KMAT ((float*)(wsl + WS_KMAT))
#define XB ((bf16_t*)(wsl + WS_XB))
#define STATS ((float*)(wsl + WS_STATS))
#define ONESV ((const float*)(wsl + WS_ONES))
#define ZEROSV ((const float*)(wsl + WS_ZEROS))
#define XKV ((bf16_t*)OUTF)
#define WIN_T ((bf16_t*)(wsl + WS_WL + WL_WIN))
#define WGLU_T ((bf16_t*)(wsl + WS_WL + WL_WGLU))
#define WB_T ((bf16_t*)(wsl + WS_WL + WL_WB))
#define WOUT_T ((bf16_t*)(wsl + WS_WL + WL_WOUT))
#define XQ_T ((bf16_t*)(wsl + WS_WL + WL_XQ))
#define XO_T ((bf16_t*)(wsl + WS_WL + WL_XO))
#define TF ((bf16_t*)(wsl + WS_WL + WL_TF))
#define ETAB ((bf16_t*)(wsl + WS_WL + WL_E))
#define FFN_GU ((bf16_t*)(wsl + WS_FFNW))
#define FFN_D_DENSE ((bf16_t*)(wsl + WS_FFNW + 11 * MiB))
#define FFN_D_MOE ((bf16_t*)(wsl + WS_FFNW + 44 * MiB))
#define UG ((bf16_t*)(wsl + WS_UG))
#define YSSM2 ((bf16_t*)(wsl + WS_UG))
#define QKV ((bf16_t*)(wsl + WS_QKV))
#define GATES ((bf16_t*)(wsl + WS_QKV))
#define XQ ((bf16_t*)(wsl + WS_QKV))
#define HBUF ((bf16_t*)(wsl + WS_QKV))
#define WKV_T ((bf16_t*)(wsl + WS_QKV))
#define MEMB ((bf16_t*)(wsl + WS_QKV + 16 * MiB))
#define YSSM ((bf16_t*)(wsl + WS_YS))
#define O1 ((bf16_t*)(wsl + WS_YS + 32 * MiB))
#define O2 ((bf16_t*)(wsl + WS_YS + 64 * MiB))
#define O3 ((bf16_t*)(wsl + WS_YS + 96 * MiB))
#define YFOX ((bf16_t*)(wsl + WS_YS + 128 * MiB))
#define MERGED O2
#define XG ((bf16_t*)(wsl + WS_YS))
#define Y2 ((bf16_t*)(wsl + WS_YS))

    PH_BEGIN
        ln_pass<2, false, true, false>(gw, NGW, lane, ZHP, OUTF, x_in, XB, STATS, nullptr, nullptr, nullptr, nullptr, nullptr, nullptr, nullptr, w_in + 3584, NIN, nullptr, nullptr, nullptr, hist, FLOG);
        for (int it = gt; it < 1024; it += NGT) { ((float*)(wsl + WS_ONES))[it] = 1.0f; ((float*)(wsl + WS_ZEROS))[it] = 0.0f; }
        for (int it = gt; it < T * 8; it += NGT) { const int row = it >> 3, j = it & 7;
            const float inv = (float)exp(-(double)j * 0.125 * 13.122363377404328);
            const float ang = (float)pos_in[row] * inv; double s, c; dsincos((double)ang, s, c);
            ROPE[(size_t)row * 16 + j] = (float)c; ROPE[(size_t)row * 16 + 8 + j] = (float)s; }
        for (int i2 = gt; i2 < DEPTH * 32 * 64 * 33; i2 += NGT) { const int it = i2 / 33, k = i2 - it * 33, g = (it >> 6) & 31, l = it >> 11;
            const double lr = lam_re[it], li = lam_im[it], dt = exp((double)log_dt[l * 32 + g]);
            const double mg = exp(k * dt * lr); double s, c; dsincos(k * dt * li, s, c); POW[(size_t)it * 33 + k] = (f32x2){(float)(mg * c), (float)(mg * s)}; }
        for (int i2 = gt; i2 < DEPTH * 32 * 64 * 16; i2 += NGT) { const int it = i2 >> 4, cc = i2 & 15, g = (it >> 6) & 31, l = it >> 11;
            const double lr = lam_re[it], li = lam_im[it], dt = exp((double)log_dt[l * 32 + g]);
            const double mg = exp(dt * lr); double s, c; dsincos(dt * li, s, c);
            const double nr = mg * c - 1.0, ni = mg * s, den = lr * lr + li * li, qr = (nr * lr + ni * li) / den, qi = (ni * lr - nr * li) / den;
            const double br = ssm_bre[(size_t)it * 16 + cc], bi = ssm_bim[(size_t)it * 16 + cc];
            BBAR[(size_t)it * 16 + cc] = (f32x2){(float)(qr * br - qi * bi), (float)(qr * bi + qi * br)}; }
        for (int it = gt; it < NB * NMEM * D / 4; it += NGT) { const f32x4 v = *(const f32x4*)(mem_in + (size_t)it * 4); u32x2 o; o.x = cvt_pk_bf16(v[0], v[1]); o.y = cvt_pk_bf16(v[2], v[3]); *(u32x2*)(MEMB + (size_t)it * 4) = o; }
        for (int l = 0; l < DEPTH; ++l) { conv_mat(rot, gw, NGW, scr, lane, w_xk + (size_t)l * D * D, D, D, 32, 0, WKV_T + (size_t)(2 * l) * D * D, 0);
                                          conv_mat(rot, gw, NGW, scr, lane, w_xv + (size_t)l * D * D, D, D, 32, 0, WKV_T + (size_t)(2 * l + 1) * D * D, 0); }
        CONVERT_MIXER(0); CONVERT_FFN(0);
    PH_END
    PH_BEGIN
        { SchedBatched S{(const char*)MEMB, (const char*)WKV_T, 0, (size_t)D * D * 2, D, D, 8, 4, 8, G, bx};
          EpiScale E{XKV, D, 1.0f, (size_t)NB * NMEM * D};
          pg8::gemm_phase(lds, D, D, D / 64, S, E); }
        for (int i2 = gt; i2 < DEPTH * 32 * 32 * 16 * 2; i2 += NGT) { const int it = i2 >> 1, hf = i2 & 1, co = it & 15, lag = (it >> 4) & 31, lg = it >> 9;
            float acc[16];
#pragma unroll
            for (int c = 0; c < 16; ++c) acc[c] = 0.f;
            for (int p = 32 * hf; p < 32 * hf + 32; ++p) { const f32x2 pw = POW[((size_t)lg * 64 + p) * 33 + lag]; const float cr = ssm_cre[((size_t)lg * 16 + co) * 64 + p], ci = ssm_cim[((size_t)lg * 16 + co) * 64 + p];
                const float zr = cr * pw.x - ci * pw.y, zi = cr * pw.y + ci * pw.x; const f32x2* bb = BBAR + ((size_t)lg * 64 + p) * 16;
#pragma unroll
                for (int c = 0; c < 16; ++c) acc[c] += zr * bb[c].x - zi * bb[c].y; }
#pragma unroll
            for (int c = 0; c < 16; ++c) acc[c] += __shfl_xor(acc[c], 1);
            if (hf == 0) {
#pragma unroll
                for (int c = 0; c < 16; ++c) KMAT[(((size_t)lg * 32 + lag) * 16 + co) * 16 + c] = acc[c]; } }
    PH_END

    for (int l = 0; l < DEPTH; ++l) {
        const bool moe = (l & 1) != 0; const int li2 = l >> 1;
        PH_BEGIN
            for (int step = 0; step < 2; ++step) { if ((step == 0) != ((vcu & 1) != 0)) {
            { SchedBatched S{(const char*)XB, (const char*)WIN_T, 0, 0, D, D, 128, 14, 1, G, bx};
              EpiInProj E{UG, QKV, ROPE, ctl + CW_NORM + l * 256};
              pg8::gemm_phase(lds, D, D, D / 64, S, E); }
            } else {
            for (int it = gt; it < 32 * 512 * 80; it += NGT) { const int k8 = it % 80, n = (it / 80) & 511, g = it / (80 * 512); const int k0 = 8 * k8, to = n >> 4, co = n & 15; const int lg = l * 32 + g;
                f32x4 a = (f32x4){0.f, 0.f, 0.f, 0.f}, b = a;
                if (k0 < 512) { const int ti = k0 >> 4, ci0 = k0 & 15, lag = to - ti;
                    if (lag >= 0) { const float* kp = KMAT + (((size_t)lg * 32 + lag) * 16 + co) * 16 + ci0; a = *(const f32x4*)kp; b = *(const f32x4*)(kp + 4); } }
                else { const int j0 = k0 - 512, part = j0 >> 6, p0 = j0 & 63; float v[8];
#pragma unroll
                    for (int q = 0; q < 8; ++q) { const int p = p0 + q; const f32x2 pw = POW[((size_t)lg * 64 + p) * 33 + to + 1]; const float cr = ssm_cre[((size_t)lg * 16 + co) * 64 + p], ci = ssm_cim[((size_t)lg * 16 + co) * 64 + p];
                        v[q] = part == 0 ? (cr * pw.x - ci * pw.y) : -(cr * pw.y + ci * pw.x); }
                    a = (f32x4){v[0], v[1], v[2], v[3]}; b = (f32x4){v[4], v[5], v[6], v[7]}; }
                *(u32x4*)(TF + ((size_t)g * 512 + n) * 640 + k0) = pack8(a, b); }
            for (int it = gt; it < 32 * 128 * 64; it += NGT) { const int k8 = it & 63, rowi = (it >> 6) & 127, g = it >> 13; const int k0 = 8 * k8, ti = k0 >> 4, ci0 = k0 & 15, part = rowi >> 6, p = rowi & 63; const int lg = l * 32 + g;
                const f32x2 pw = POW[((size_t)lg * 64 + p) * 33 + 31 - ti]; const f32x2* bb = BBAR + ((size_t)lg * 64 + p) * 16 + ci0; float v[8];
#pragma unroll
                for (int q = 0; q < 8; ++q) v[q] = part == 0 ? (pw.x * bb[q].x - pw.y * bb[q].y) : (pw.x * bb[q].y + pw.y * bb[q].x);
                *(u32x4*)(ETAB + ((size_t)g * 128 + rowi) * 512 + k0) = pack8((f32x4){v[0], v[1], v[2], v[3]}, (f32x4){v[4], v[5], v[6], v[7]}); }
            } SUBSYNC(); }
        PH_END
        PH_BEGIN
            auto fox_pro = [&](const int b, const int h) {
                    const float bf = b_forget[l * 8 + h]; const int p0 = wave * 512 + lane * 8; float ls8[8]; float run = 0.f;
#pragma unroll
                    for (int q = 0; q < 8; ++q) { const float z = FLOG[((size_t)b * SEQ + p0 + q) * 8 + h] + bf; run += fminf(z, 0.f) - 0.6931471805599453f * __builtin_amdgcn_logf(1.0f + fexp2(-fabsf(z) * LOG2E)); ls8[q] = run; }
                    float incl = run;
#pragma unroll
                    for (int o = 1; o < 64; o <<= 1) { const float t = __shfl_up(incl, o); if (lane >= o) incl += t; }
                    LAS float* wtot = (LAS float*)(lds + 65536); LAS float* betaL = (LAS float*)lds;
                    if (lane == 63) wtot[wave] = incl;
                    const unsigned* nr_ = ctl + CW_NORM + l * 256 + (b * 8 + h) * 4;
                    float qm = __uint_as_float(__hip_atomic_load(nr_, RLX_AGENT)) + __uint_as_float(__hip_atomic_load(nr_ + 1, RLX_AGENT));
                    float km = __uint_as_float(__hip_atomic_load(nr_ + 2, RLX_AGENT)) + __uint_as_float(__hip_atomic_load(nr_ + 3, RLX_AGENT));
                    SUBSYNC();
                    float base = incl - run;
                    for (int w = 0; w < wave; ++w) base += wtot[w];
#pragma unroll
                    for (int q = 0; q < 8; ++q) { const float beta = -(base + ls8[q]) * LOG2E;
                        const unsigned b1 = cvt_pk_bf16(beta, 0.f) & 0xffffu; const float r1 = beta - bf_lo(b1); const unsigned b2 = cvt_pk_bf16(r1, 0.f) & 0xffffu; const float r2 = r1 - bf_lo(b2); const unsigned b3 = cvt_pk_bf16(r2, 0.f) & 0xffffu;
                        *(u32x4*)(KBIAS + (((size_t)b * SEQ + p0 + q) * 8 + h) * 8) = (u32x4){b1 | (b2 << 16), b3 | 0x3F800000u, 0x3F803F80u, 0u}; betaL[p0 + q] = beta; }
                    SUBSYNC();
                    { const float need_d = 2.0f * sqrtf(qm * km) + 36.0f;
#pragma unroll
                      for (int jj = 0; jj < 2; ++jj) { const int j = 2 * wave + jj; const bool cnd = (lane < 4 * j) && (betaL[256 * j] - betaL[64 * lane + 63] >= need_d);
                          const unsigned long long mk = __ballot(cnd); if (lane == 0) MISC[32 + j] = (unsigned)__popcll(mk); } }
                    SUBSYNC();
            };
            int prev_bh = -1;
            if (vcu < 1024) { const int bh0 = (vcu & 255) >> 2; fox_pro(bh0 >> 3, bh0 & 7); prev_bh = bh0; }
            for (int c0 = vcu; c0 < 256; c0 += G) { const int pq = c0 >> 1, g = pq >> 2, pm = pq & 3, pn = c0 & 1; const int lg = l * 32 + g;
                const char* Ag = (const char*)(UG + ((size_t)g * 1024 + pm * 256) * 640);
                { SchedOne S; S.u.A = Ag; S.u.B = (const char*)(ETAB + (size_t)g * 128 * 512); S.u.pm = pm; S.u.pn = 0; S.u.aux = g;
                  EpiS1 E{SLOC};
                  pg8::gemm_phase(lds, 640, 512, 512 / 64, S, E); }
                SUBSYNC();
                if (wave < 2) { const int b = 2 * pm + wave;
                    const f32x2 a = POW[((size_t)lg * 64 + lane) * 33 + 32]; float sr = 0.f, si = 0.f;
                    float lr[16], lim[16];
#pragma unroll
                    for (int q = 0; q < 16; ++q) { const float* sp = SLOC + ((size_t)g * 1024 + b * 128 + q) * 128; lr[q] = sp[lane]; lim[q] = sp[64 + lane]; }
                    for (int j0 = 0; j0 < 128; j0 += 16) { float nlr[16], nlim[16]; const int jn = j0 + 16 < 128 ? j0 + 16 : j0;
#pragma unroll
                        for (int q = 0; q < 16; ++q) { const float* sp = SLOC + ((size_t)g * 1024 + b * 128 + jn + q) * 128; nlr[q] = sp[lane]; nlim[q] = sp[64 + lane]; }
#pragma unroll
                        for (int q = 0; q < 16; ++q) { bf16_t* up = UG + ((size_t)g * 1024 + b * 128 + j0 + q) * 640 + 512;
                            up[lane] = (bf16_t)(cvt_pk_bf16(sr, 0.f) & 0xffffu); up[64 + lane] = (bf16_t)(cvt_pk_bf16(si, 0.f) & 0xffffu);
                            const float nr = a.x * sr - a.y * si + lr[q], ni = a.x * si + a.y * sr + lim[q]; sr = nr; si = ni; }
#pragma unroll
                        for (int q = 0; q < 16; ++q) { lr[q] = nlr[q]; lim[q] = nlim[q]; } } }
                SUBSYNC();
                { SchedOne S; S.u.A = Ag; S.u.B = (const char*)(TF + ((size_t)g * 512 + pn * 256) * 640); S.u.pm = pm; S.u.pn = pn; S.u.aux = g;
                  EpiS3 E{UG, ssm_d + l * 512, YSSM};
                  pg8::gemm_phase(lds, 640, 640, 640 / 64, S, E); }
            }
            {
              for (int k = vcu; k < 1024; k += G) { const int v8 = k & 255, i = k >> 8, bh = v8 >> 2, s = v8 & 3, b = bh >> 3, h = bh & 7; const int qb = (i == 0) ? s : (i == 1) ? 7 - s : (i == 2) ? 8 + s : 15 - s;
                if (bh != prev_bh) { prev_bh = bh; fox_pro(b, h); }
                const int tlo_u = (int)MISC[32 + qb];
                const size_t row0 = (size_t)b * SEQ;
                att::fox_unit(lds, wsf_all, QKV + row0 * NQKV + 1536 + h * 64, QKV + row0 * NQKV + 2048 + h * 64, QKV + row0 * NQKV + 2560 + h * 64, (long)NQKV, qb * 256, tlo_u, (qb * 256 + 256) >> 6,
                                    KBIAS + ((size_t)b * SEQ * 8 + h) * 8, YFOX + row0 * 512 + h * 64, 512); } }
            { unsigned* qctr = ctl + CW_QUEUE + l * 64; unsigned kn = 0u;
              if (tid == 0) MISC[48] = __hip_atomic_fetch_add(qctr, 1u, RLX_AGENT);
              SUBSYNC();
              int k = (int)MISC[48];
              while (k < 960) {
                if (tid == 0) kn = __hip_atomic_fetch_add(qctr, 1u, RLX_AGENT);
                {
                  if (k < 256) { const int bh = k >> 2, j = k & 3, b = bh >> 3, h = bh & 7; const size_t row0 = (size_t)b * SEQ;
                      att::dil_sweep<false>(lds, wsf_all, QKV + row0 * NQKV + h * 64, QKV + row0 * NQKV + 512 + h * 64, QKV + row0 * NQKV + 1024 + h * 64, (long)NQKV, 4 * j, 4,
                                            O1 + row0 * 512 + h * 64, 512L, LSE + row0 * 8 + h, 8L, 0L, 0L, 0L); }
                  else if (k < 512) { const int bh = (k - 256) >> 2, j = k & 3, b = bh >> 3, h = bh & 7; const size_t row0 = (size_t)b * SEQ + j;
                      att::dil_sweep<false>(lds, wsf_all, QKV + row0 * NQKV + h * 64, QKV + row0 * NQKV + 512 + h * 64, QKV + row0 * NQKV + 1024 + h * 64, 4L * NQKV, 0, 4,
                                            O2 + row0 * 512 + h * 64, 4L * 512, LSE + (size_t)T * 8 + row0 * 8 + h, 4L * 8, 0L, 0L, 0L); }
                  else { int bh, b0, nb; if (k < 704) { bh = (k - 512) / 3; b0 = 4 * ((k - 512) % 3); nb = 4; } else { bh = (k - 704) >> 2; b0 = 12 + ((k - 704) & 3); nb = 1; }
                      const int b = bh >> 3, h = bh & 7; const size_t row0 = (size_t)b * SEQ;
                      att::dil_sweep<true>(lds, wsf_all, QKV + row0 * NQKV + h * 64, QKV + row0 * NQKV + 512 + h * 64, QKV + row0 * NQKV + 1024 + h * 64, 16L * NQKV, b0, nb,
                                           O3 + row0 * 512 + h * 64, 16L * 512, LSE + (size_t)2 * T * 8 + row0 * 8 + h, 16L * 8, (long)NQKV, 512L, 8L); } }
                if (tid == 0) MISC[48] = kn;
                SUBSYNC();
                k = (int)MISC[48];
              } }
        PH_END
        PH_BEGIN
            for (int step = 0; step < 2; ++step) { if ((step == 0) != ((vcu & 1) != 0)) {
            { SchedBatched S{(const char*)XB, (const char*)(WIN_T + (size_t)3584 * D), 0, 0, D, D, 128, 12, 1, G, bx};
              EpiGates E{GATES};
              pg8::gemm_phase(lds, D, D, D / 64, S, E); }
            } else {
            { SchedBatched S{(const char*)YSSM, (const char*)WGLU_T, 0, 0, 512, 512, 128, 2, 1, G, bx};
              EpiGlu E{YSSM, YSSM2};
              pg8::gemm_phase(lds, 512, 512, 512 / 64, S, E); }
            { const int h = lane >> 3; float l0n, l1n, l2n; u32x4 q1n, q2n, q3n;
#define MIX_LOAD(r_) do { const size_t off_ = (size_t)(r_) * 512 + lane * 8; l0n = LSE[(size_t)(r_) * 8 + h]; l1n = LSE[(size_t)T * 8 + (size_t)(r_) * 8 + h]; l2n = LSE[(size_t)2 * T * 8 + (size_t)(r_) * 8 + h]; \
        q1n = *(const u32x4*)(O1 + off_); q2n = *(const u32x4*)(O2 + off_); q3n = *(const u32x4*)(O3 + off_); } while (0)
              MIX_LOAD(gw);
              for (int row = gw; row < T; row += NGW) { const size_t off = (size_t)row * 512 + lane * 8;
                const float l0 = l0n, l1 = l1n, l2 = l2n; const u32x4 q1 = q1n, q2 = q2n, q3 = q3n;
                const int nrow = row + NGW < T ? row + NGW : row; MIX_LOAD(nrow);
                const float mx = fmaxf(l0, fmaxf(l1, l2)); float e0 = fexp2(l0 - mx), e1 = fexp2(l1 - mx), e2 = fexp2(l2 - mx); const float rs = frcp(e0 + e1 + e2); e0 *= rs; e1 *= rs; e2 *= rs;
                f32x4 a0, b0, a1, b1, a2, b2; unpack8(q1, a0, b0); unpack8(q2, a1, b1); unpack8(q3, a2, b2);
                *(u32x4*)(O1 + off) = pack8(a0 * e0 + a1 * e1 + a2 * e2, b0 * e0 + b1 * e1 + b2 * e2); }
#undef MIX_LOAD
            }
            } SUBSYNC(); }
        PH_END
        PH_BEGIN
            { SchedMerge S{(const char*)YSSM2, (const char*)O1, (const char*)YFOX, (const char*)WB_T, G, bx};
              EpiMerge E{GATES, MERGED};
              pg8::gemm_phase(lds, 512, 512, 512 / 64, S, E); }
        PH_END
        PH_BEGIN
            { SchedBatched S{(const char*)MERGED, (const char*)WOUT_T, 0, 0, D, D, 128, 4, 1, G, bx};
              if (l == 0) { EpiResT<true> E{ZHP, x_in, STATS, ONESV, ZEROSV}; pg8::gemm_phase(lds, D, D, D / 64, S, E); }
              else { EpiResT<false> E{ZHP, nullptr, STATS, ln_ffn_g + (l - 1) * D, ln_ffn_b + (l - 1) * D}; pg8::gemm_phase(lds, D, D, D / 64, S, E); } }
        PH_END
        PH_BEGIN
            ln_pass<0, false, false, false>(gw, NGW, lane, ZHP, OUTF, nullptr, XB, STATS, ln_mix_g + l * D, ln_mix_b + l * D, nullptr, nullptr, nullptr, nullptr, nullptr, nullptr, 0, nullptr, nullptr, nullptr, hist, nullptr);
        PH_END
        PH_BEGIN
            { SchedBatched S{(const char*)XB, (const char*)XQ_T, 0, 0, D, D, 128, 4, 1, G, bx};
              EpiScale E{XQ, D, C2_256, 0};
              pg8::gemm_phase(lds, D, D, D / 64, S, E); }
        PH_END
        PH_BEGIN
            for (int k = vcu; k < 512; k += G) { const int b = k >> 6, h = (k >> 4) & 3, qb = k & 15; const size_t qrow = (size_t)b * SEQ + qb * 256;
                const bf16_t* Kx = XKV + (size_t)(2 * l) * NB * NMEM * D + (size_t)b * NMEM * D + h * 256; const bf16_t* Vx = Kx + (size_t)NB * NMEM * D;
                att::xattn_unit(lds, wsf_all, XQ + qrow * D + h * 256, Kx, Vx, XQ + qrow * D + h * 256); }
        PH_END
        PH_BEGIN
            { SchedBatched S{(const char*)XQ, (const char*)XO_T, 0, 0, D, D, 128, 4, 1, G, bx};
              EpiResT<false> E{ZHP, nullptr, STATS, ln_mix_g + l * D, ln_mix_b + l * D};
              pg8::gemm_phase(lds, D, D, D / 64, S, E); }
        PH_END
        PH_BEGIN
            if (!moe) ln_pass<0, false, false, false>(gw, NGW, lane, ZHP, OUTF, nullptr, XB, STATS, ln_x_g + l * D, ln_x_b + l * D, nullptr, nullptr, nullptr, nullptr, nullptr, nullptr, 0, nullptr, nullptr, nullptr, hist, nullptr);
            else {
                ln_pass<0, true, false, false>(gw, NGW, lane, ZHP, OUTF, nullptr, XB, STATS, ln_x_g + l * D, ln_x_b + l * D, nullptr, nullptr, nullptr, nullptr, nullptr, moe_wr + (size_t)li2 * D * NEXP, NEXP, moe_br + li2 * NEXP, TOKE, TOKW, hist, nullptr);
                SUBSYNC();
                if (tid < NEXP) { const unsigned c = hist[tid]; if (c) __hip_atomic_fetch_add(ctl + CW_CNT + (li2 * 8 + tid) * 64, c, RLX_AGENT); hist[tid] = 0u; }
                { int stp_ = NGT; asm volatile("" : "+s"(stp_));
                  unsigned z_ = 0u; asm volatile("" : "+v"(z_));
                  for (int it = gt; it < 264 * 256 / 2; it += stp_) ((unsigned*)INV16)[it] = z_; }
            }
        PH_END
        if (!moe) {
            PH_BEGIN
                for (int step = 0; step < 2; ++step) { if ((step == 0) != ((vcu & 1) != 0)) {
                { SchedBatched S{(const char*)XB, (const char*)FFN_GU, 0, 0, D, D, 128, 22, 1, G, bx};
                  EpiSwiglu E{HBUF, DFF};
                  pg8::gemm_phase(lds, D, D, D / 64, S, E); }
                } else { if (l + 1 < DEPTH) CONVERT_MIXER(l + 1); } SUBSYNC(); }
            PH_END
            PH_BEGIN
                { SchedBatched S{(const char*)HBUF, (const char*)FFN_D_DENSE, 0, 0, DFF, DFF, 128, 4, 1, G, bx};
                  EpiResT<false> E{ZHP, nullptr, STATS, ln_x_g + l * D, ln_x_b + l * D};
                  pg8::gemm_phase(lds, DFF, DFF, DFF / 64, S, E); }
            PH_END
            PH_BEGIN
                if (l + 1 < DEPTH) ln_pass<0, false, true, false>(gw, NGW, lane, ZHP, OUTF, nullptr, XB, STATS, ln_ffn_g + l * D, ln_ffn_b + l * D, nullptr, nullptr, nullptr, nullptr, nullptr, w_in + (size_t)(l + 1) * D * NIN + 3584, NIN, nullptr, nullptr, nullptr, hist, FLOG);
                else ln_pass<0, false, false, true>(gw, NGW, lane, ZHP, OUTF, nullptr, XB, STATS, ln_ffn_g + l * D, ln_ffn_b + l * D, nullptr, nullptr, nullptr, nullptr, nullptr, nullptr, 0, nullptr, nullptr, nullptr, hist, nullptr);
                if (l + 1 < DEPTH) { SUBSYNC(); { int tq_ = threadIdx.x; asm volatile("" : "+v"(tq_)); const int lane = tq_ & 63; CONVERT_FFN(l + 1); } }
            PH_END
        } else {
            PH_BEGIN
                LOAD_TOFF();
                for (int t0 = gw * 64; t0 < T; t0 += NGW * 64) { const int t = t0 + lane; const int e0 = TOKE[2 * t], e1 = TOKE[2 * t + 1];
                    int r0 = 0, r1 = 0, tb0 = 0, tb1 = 0; unsigned cme = 0u; const unsigned long long lt = (1ull << lane) - 1ull;
#pragma unroll
                    for (int e = 0; e < 8; ++e) { const unsigned long long m0 = __ballot(e0 == e), m1 = __ballot(e1 == e); const int n0 = __popcll(m0), n1 = __popcll(m1);
                        if (lane == e) cme = (unsigned)(n0 + n1);
                        if (e0 == e) { r0 = __popcll(m0 & lt); tb0 = toff[e] * 256; }
                        if (e1 == e) { r1 = n0 + __popcll(m1 & lt); tb1 = toff[e] * 256; } }
                    unsigned base = 0u; if (lane < 8 && cme) base = __hip_atomic_fetch_add(ctl + CW_FILL + (li2 * 8 + lane) * 64, cme, RLX_AGENT);
                    const int pos0 = tb0 + (int)__shfl(base, e0) + r0, pos1 = tb1 + (int)__shfl(base, e1) + r1;
                    TOKP[2 * t] = pos0; TOKP[2 * t + 1] = pos1; INV16[pos0] = (unsigned short)t; INV16[pos1] = (unsigned short)t; }
            PH_END
            PH_BEGIN
                for (int step = 0; step < 2; ++step) { if ((step == 0) != ((vcu & 1) != 0)) {
                LOAD_TOFF();
                { LAS unsigned short* linv = (LAS unsigned short*)(lds + 135168);
                  { int tq = tid; asm volatile("" : "+v"(tq));
#pragma unroll 1
                    for (int q = tq; q < 12 * 256; q += NWAVES * 64) { const int i = q >> 8; const int L = i * G + bx; if (L < toff[8] * 11) linv[q] = INV16[(L / 11) * 256 + (q & 255)]; } }
                  SUBSYNC(); }
                { SchedMoeG S; S.Abase = (const char*)XB; S.linv = (const LAS unsigned short*)(lds + 135168); S.Bbase = (const char*)FFN_GU; S.strideB = (size_t)2 * DFFE * D * 2; S.lda = D; S.ldb = D; S.G = G; S.c = bx;
#pragma unroll
                  for (int e = 0; e < 9; ++e) S.toff[e] = toff[e];
                  EpiSwiglu E{HBUF, DFFE};
                  pg8::gemm_phase(lds, D, D, D / 64, S, E); }
                } else { if (l + 1 < DEPTH) CONVERT_MIXER(l + 1); } SUBSYNC(); }
            PH_END
            PH_BEGIN
                LOAD_TOFF();
                { SchedMoe S; S.Abase = (const char*)HBUF; S.Bbase = (const char*)FFN_D_MOE; S.strideB = (size_t)D * DFFE * 2; S.lda = DFFE; S.ldb = DFFE; S.nN = 4; S.G = G; S.c = bx;
#pragma unroll
                  for (int e = 0; e < 9; ++e) S.toff[e] = toff[e];
                  EpiScale E{Y2, D, 1.0f, 0};
                  pg8::gemm_phase(lds, DFFE, DFFE, DFFE / 64, S, E); }
            PH_END
            PH_BEGIN
                if (l + 1 < DEPTH) ln_pass<1, false, true, false>(gw, NGW, lane, ZHP, OUTF, nullptr, XB, STATS, ln_ffn_g + l * D, ln_ffn_b + l * D, ln_x_g + l * D, ln_x_b + l * D, Y2, TOKP, TOKW, w_in + (size_t)(l + 1) * D * NIN + 3584, NIN, nullptr, nullptr, nullptr, hist, FLOG);
                else ln_pass<1, false, false, true>(gw, NGW, lane, ZHP, OUTF, nullptr, XB, STATS, ln_ffn_g + l * D, ln_ffn_b + l * D, ln_x_g + l * D, ln_x_b + l * D, Y2, TOKP, TOKW, nullptr, 0, nullptr, nullptr, nullptr, hist, nullptr);
                if (l + 1 < DEPTH) { SUBSYNC(); { int tq_ = threadIdx.x; asm volatile("" : "+v"(tq_)); const int lane = tq_ & 63; CONVERT_FFN(l + 1); } }
            PH_END
        }
    }
}

#ifndef SPLIT_LAUNCH
#define SPLIT_LAUNCH 0
#endif
extern "C" void kernel_launch(void* const* d_in, const int* in_sizes, int n_in, void* d_out, int out_size, void* d_ws, size_t ws_size, hipStream_t stream) {
    static int grid = 0;
    if (grid == 0) {
        if (n_in != 34 || out_size != T * D || ws_size < WS_END) { fprintf(stderr, "kernel_launch: unexpected shapes (n_in %d out %d ws %zu)\n", n_in, out_size, ws_size); grid = -1; return; }
        int dev = 0, cus = 0;
        if (hipGetDevice(&dev) != hipSuccess || hipDeviceGetAttribute(&cus, hipDeviceAttributeMultiprocessorCount, dev) != hipSuccess) { grid = -1; return; }
        if (hipFuncSetAttribute((const void*)hybrid_fwd, hipFuncAttributeMaxDynamicSharedMemorySize, LDS_BYTES) != hipSuccess) { grid = -1; return; }
        int per_cu = 0;
        if (hipOccupancyMaxActiveBlocksPerMultiprocessor(&per_cu, (const void*)hybrid_fwd, NWAVES * 64, LDS_BYTES) != hipSuccess || per_cu < 1) { fprintf(stderr, "kernel_launch: occupancy query says %d\n", per_cu); }
        (void)hipGetLastError();
        grid = cus;
    }
    if (grid < 0) return;
    if (hipMemsetAsync((char*)d_ws + WS_CTL, 0, CTL_ZERO_BYTES, stream) != hipSuccess) return;
    Args a{};
    for (int i = 0; i < 34; ++i) a.in[i] = d_in[i];
    a.out = (float*)d_out; a.ws = (unsigned char*)d_ws;
#if SPLIT_LAUNCH
    for (int ph = 0; ph < NPH_TOTAL; ++ph) { a.ph_lo = ph; a.ph_hi = ph + 1; hipLaunchKernelGGL(hybrid_fwd, dim3(grid), dim3(NWAVES * 64), LDS_BYTES, stream, a); }
#else
    a.ph_lo = 0; a.ph_hi = NPH_TOTAL;
    hipLaunchKernelGGL(hybrid_fwd, dim3(grid), dim3(NWAVES * 64), LDS_BYTES, stream, a);
#endif
}
```
